# Optimizing an MI355X kernel written in HIP

```python
import math
import jax
import jax.numpy as jnp
from jax import lax
import numpy as np

D_MODEL = 1024
BATCH = 8
SEQ = 4096
DEPTH = 4

GRID_W = 64
CTX_LEN = 256

HY_W = 256
N_HEADS = 8
N_KV_HEADS = 2
N_GROUPS = N_HEADS // N_KV_HEADS
HEAD_DIM = 64
ATT_W = N_HEADS * HEAD_DIM
KV_W = N_KV_HEADS * HEAD_DIM
RG_W = 256
RG_BLOCKS = 4
RG_BW = RG_W // RG_BLOCKS
MIX_W = HY_W + ATT_W + RG_W

HY_END = 3 * HY_W
Q_END = HY_END + ATT_W
K_END = Q_END + KV_W
V_END = K_END + KV_W
RGX_END = V_END + RG_W
PROJ_W = RGX_END + RG_W

HY_ORDER = 2
HY_SHORT = 3
HY_BANDS = 8
HY_EMB = 1 + 2 * HY_BANDS
HY_FILTER_W = 64
HY_DECAY_TARGET = 1e-2
HY_SHORT_DECAY_PCT = 0.3
HY_LONG_DECAY_PCT = 1.5
HY_MAX_DECAY = math.log(HY_DECAY_TARGET) / HY_SHORT_DECAY_PCT
HY_MIN_DECAY = math.log(HY_DECAY_TARGET) / HY_LONG_DECAY_PCT

ROPE_THETA = 10000.0
Q_BLOCK = 128
QK_EPS = 1e-6

RG_CONV = 4
RG_C = 8.0

N_EXPERTS = 64
TOP_K = 8
EXPERT_FF = 256
SHARED_FF = 256
ROUTED_SCALE = 2.5
MOE_CHUNK = 1024

LN_EPS = 1e-6
DN_ALPHA = (2 * DEPTH) ** 0.25
DN_BETA = (8 * DEPTH) ** -0.25

kernel_name = 'hybrid_dit_hyena_gqa_rglru_moe'


def layer_norm(u, g, b):
    u32 = u.astype(jnp.float32)
    mu = jnp.mean(u32, axis=-1, keepdims=True)
    var = jnp.mean(jnp.square(u32 - mu), axis=-1, keepdims=True)
    return ((u32 - mu) * lax.rsqrt(var + LN_EPS) * g + b).astype(u.dtype)


def rms_norm(u, g):
    u32 = u.astype(jnp.float32)
    return (u32 * lax.rsqrt(jnp.mean(jnp.square(u32), axis=-1, keepdims=True) + QK_EPS) * g).astype(u.dtype)


def depthwise_conv(u, w, b):
    width = w.shape[0]
    L = u.shape[1]
    left = (width - 1) // 2
    up = jnp.pad(u, ((0, 0), (left, width - 1 - left), (0, 0)))
    return sum(up[:, j:j + L] * w[j] for j in range(width)) + b


def split_proj(p):
    return (p[..., :HY_END], p[..., HY_END:Q_END], p[..., Q_END:K_END],
            p[..., K_END:V_END], p[..., V_END:RGX_END], p[..., RGX_END:])


def hyena_filter_spectra(L, w1, b1, freq, w2, b2, w3):
    t = jnp.linspace(0.0, 1.0, L, dtype=jnp.float32)[:, None]
    w = 2.0 * math.pi * jnp.arange(L, dtype=jnp.float32)[:, None] / L
    bands = jnp.linspace(1e-4, HY_BANDS - 1, HY_BANDS, dtype=jnp.float32)
    z = jnp.concatenate([t, jnp.cos(bands * w), -jnp.sin(bands * w)], axis=-1)
    f = jnp.sin(freq * (z @ w1 + b1))
    f = jnp.sin(freq * (f @ w2 + b2))
    f = (f @ w3).astype(jnp.float32).reshape(L, 2, HY_ORDER, HY_W)
    deltas = jnp.abs(jnp.linspace(HY_MIN_DECAY, HY_MAX_DECAY, HY_W, dtype=jnp.float32))
    f = f * jnp.exp(-t * deltas)[:, None, None, :]
    fwd, bwd = f[:, 0], f[:, 1]
    k = jnp.concatenate([fwd, jnp.zeros_like(fwd[:1]), bwd[:0:-1]], axis=0)
    return jnp.fft.rfft(k, axis=0)


def fft_long_conv(u, k_f, skip):
    L = u.shape[1]
    u32 = u.astype(jnp.float32)
    y = jnp.fft.irfft(jnp.fft.rfft(u32, n=2 * L, axis=1) * k_f, n=2 * L, axis=1)[:, :L]
    return (y + u32 * skip.astype(jnp.float32)).astype(u.dtype)


def hyena_mixer(u, short_w, short_b, w1, b1, freq, w2, b2, w3, skip):
    L = u.shape[1]
    x1, x2, z = jnp.split(depthwise_conv(u, short_w, short_b), 3, axis=-1)
    k_f = hyena_filter_spectra(L, w1, b1, freq, w2, b2, w3)
    for n, gate in enumerate((x1, x2)):
        z = gate * fft_long_conv(z, k_f[:, n], skip[n])
    return z


def axial_rope(n_tokens):
    n_rows = n_tokens // GRID_W
    row = jnp.repeat(jnp.arange(n_rows, dtype=jnp.float32), GRID_W)
    col = jnp.tile(jnp.arange(GRID_W, dtype=jnp.float32), n_rows)
    axis_dim = HEAD_DIM // 2
    inv_freq = ROPE_THETA ** (-jnp.arange(0, axis_dim, 2, dtype=jnp.float32) / axis_dim)
    ang = jnp.concatenate([row[:, None] * inv_freq, col[:, None] * inv_freq], axis=-1)
    return jnp.cos(ang), jnp.sin(ang)


def apply_rope(u, cos, sin):
    u32 = u.astype(jnp.float32).reshape(*u.shape[:-1], HEAD_DIM // 2, 2)
    u1, u2 = u32[..., 0], u32[..., 1]
    out = jnp.stack([u1 * cos - u2 * sin, u1 * sin + u2 * cos], axis=-1)
    return out.reshape(u.shape).astype(u.dtype)


def gqa_q(q, gain):
    B, L, _ = q.shape
    q = rms_norm(q.reshape(B, L, N_KV_HEADS, N_GROUPS, HEAD_DIM), gain)
    return q.transpose(0, 2, 3, 1, 4)


def gqa_kv(k, gain=None):
    B, L, _ = k.shape
    k = k.reshape(B, L, N_KV_HEADS, HEAD_DIM)
    if gain is not None:
        k = rms_norm(k, gain)
    return k.transpose(0, 2, 1, 3)


def sdpa(q, k, v):
    s = jnp.einsum('bkgqd,bksd->bkgqs', q, k, preferred_element_type=jnp.float32) * HEAD_DIM ** -0.5
    p = jax.nn.softmax(s, axis=-1).astype(v.dtype)
    return jnp.einsum('bkgqs,bksd->bkgqd', p, v)


def attention_mixer(q_l, k_l, v_l, q_c, k_c, v_c, q_gain, k_gain, cos, sin):
    B, T, _ = q_l.shape
    kc = gqa_kv(k_c, k_gain)
    vc = gqa_kv(v_c)
    ql = apply_rope(gqa_q(q_l, q_gain), cos, sin)
    k_all = jnp.concatenate([apply_rope(gqa_kv(k_l, k_gain), cos, sin), kc], axis=2)
    v_all = jnp.concatenate([gqa_kv(v_l), vc], axis=2)
    n_blk = T // Q_BLOCK
    q_blocks = ql.reshape(B, N_KV_HEADS, N_GROUPS, n_blk, Q_BLOCK, HEAD_DIM).transpose(3, 0, 1, 2, 4, 5)
    o = lax.map(lambda qb: sdpa(qb, k_all, v_all), q_blocks)
    y_l = o.transpose(1, 0, 4, 2, 3, 5).reshape(B, T, ATT_W)
    if q_c is None:
        return y_l, None
    o_c = sdpa(gqa_q(q_c, q_gain), kc, vc)
    y_c = o_c.transpose(0, 3, 1, 2, 4).reshape(B, q_c.shape[1], ATT_W)
    return y_l, y_c


def _linear_combine(e1, e2):
    a1, b1 = e1
    a2, b2 = e2
    return a1 * a2, a2 * b1 + b2


def rg_lru_scan(u, lam, w_a, b_a, w_x, b_x, h0, reverse):
    B, L, _ = u.shape
    ub = u.reshape(B, L, RG_BLOCKS, RG_BW)
    r = jax.nn.sigmoid(jnp.einsum('blhi,hij->blhj', ub, w_a).reshape(B, L, RG_W) + b_a).astype(jnp.float32)
    i = jax.nn.sigmoid(jnp.einsum('blhi,hij->blhj', ub, w_x).reshape(B, L, RG_W) + b_x)
    log_a = -RG_C * r * jax.nn.softplus(-lam.astype(jnp.float32))
    a = jnp.exp(log_a)
    b = jnp.sqrt(-jnp.expm1(2.0 * log_a)) * (i * u).astype(jnp.float32)
    first = L - 1 if reverse else 0
    b = b.at[:, first].add(a[:, first] * h0)
    _, h = lax.associative_scan(_linear_combine, (a, b), axis=1, reverse=reverse)
    return h


def rglru_mixer(x_l, g_l, x_c, g_c, conv_w, conv_b, lam, w_a, b_a, w_x, b_x):
    u_l = depthwise_conv(x_l, conv_w, conv_b)
    u_c = depthwise_conv(x_c, conv_w, conv_b)
    zeros = jnp.zeros((x_c.shape[0], RG_W), jnp.float32)
    h_l_sum = 0.0
    h_c_sum = 0.0
    for d, rev in enumerate((False, True)):
        params = (lam[d], w_a[d], b_a[d], w_x[d], b_x[d])
        h_c = rg_lru_scan(u_c, *params, zeros, rev)
        h_end = h_c[:, 0] if rev else h_c[:, -1]
        h_l_sum = h_l_sum + rg_lru_scan(u_l, *params, h_end, rev)
        if g_c is not None:
            h_c_sum = h_c_sum + h_c
    y_l = h_l_sum.astype(x_l.dtype) * jax.nn.gelu(g_l)
    y_c = None if g_c is None else h_c_sum.astype(x_c.dtype) * jax.nn.gelu(g_c)
    return y_l, y_c


def moe_ffn(u, w_router, b_router, w_gate, w_up, w_down, ws_gate, ws_up, ws_down):
    n, d = u.shape
    scores = jax.nn.sigmoid(jnp.einsum('nd,de->ne', u, w_router, preferred_element_type=jnp.float32))
    _, idx = lax.top_k(scores + b_router.astype(jnp.float32), TOP_K)
    sel = jnp.take_along_axis(scores, idx, axis=-1)
    wts = sel / jnp.sum(sel, axis=-1, keepdims=True) * ROUTED_SCALE
    gates = jnp.zeros((n, N_EXPERTS), jnp.float32).at[jnp.arange(n)[:, None], idx].add(wts).astype(u.dtype)
    pad = (-n) % MOE_CHUNK
    u_blk = jnp.pad(u, ((0, pad), (0, 0))).reshape(-1, MOE_CHUNK, d)
    g_blk = jnp.pad(gates, ((0, pad), (0, 0))).reshape(-1, MOE_CHUNK, N_EXPERTS)

    def routed(args):
        ub, gb = args
        hid = jax.nn.silu(jnp.einsum('nd,edf->nef', ub, w_gate)) * jnp.einsum('nd,edf->nef', ub, w_up)
        return jnp.einsum('nef,efd->nd', hid * gb[..., None], w_down)

    y = lax.map(routed, (u_blk, g_blk)).reshape(-1, d)[:n]
    shared = (jax.nn.silu(u @ ws_gate) * (u @ ws_up)) @ ws_down
    return y + shared


def setup_inputs(seed: int = 0) -> dict:
    key = jax.random.key(seed)
    ks = iter(jax.random.split(key, 48))

    def nrm(shape, scale):
        return jax.random.normal(next(ks), shape, jnp.float32) * scale

    D = D_MODEL
    u = jax.random.uniform(next(ks), (DEPTH, 2, RG_W), jnp.float32, 0.9, 0.999)
    s = u ** (1.0 / RG_C)
    rg_lambda = jnp.log(s) - jnp.log1p(-s)
    return {
        'x': nrm((BATCH, SEQ, D), 1.0),
        'c': nrm((BATCH, D), 1.0),
        'ctx': nrm((BATCH, CTX_LEN, D), 1.0),
        'c_ctx': nrm((D,), 1.0),
        'w_mod': nrm((DEPTH, D, 6 * D), 0.5 * D ** -0.5),
        'b_mod': nrm((DEPTH, 6 * D), 0.02),
        'ln1_g': 1.0 + nrm((DEPTH, D), 0.02),
        'ln1_b': nrm((DEPTH, D), 0.02),
        'ln2_g': 1.0 + nrm((DEPTH, D), 0.02),
        'ln2_b': nrm((DEPTH, D), 0.02),
        'w_in': nrm((DEPTH, D, PROJ_W), D ** -0.5),
        'w_out': nrm((DEPTH, MIX_W, D), DN_BETA * MIX_W ** -0.5),
        'hy_short_w': nrm((DEPTH, HY_SHORT, 3 * HY_W), HY_SHORT ** -0.5),
        'hy_short_b': nrm((DEPTH, 3 * HY_W), 0.02),
        'hy_f_w1': nrm((DEPTH, HY_EMB, HY_FILTER_W), HY_EMB ** -0.5),
        'hy_f_b1': nrm((DEPTH, HY_FILTER_W), 0.02),
        'hy_f_freq': 1.0 + nrm((DEPTH, HY_FILTER_W), 0.1),
        'hy_f_w2': nrm((DEPTH, HY_FILTER_W, HY_FILTER_W), HY_FILTER_W ** -0.5),
        'hy_f_b2': nrm((DEPTH, HY_FILTER_W), 0.02),
        'hy_f_w3': nrm((DEPTH, HY_FILTER_W, 2 * HY_ORDER * HY_W), 0.04 * HY_FILTER_W ** -0.5),
        'hy_skip': nrm((DEPTH, HY_ORDER, HY_W), 1.0),
        'q_norm': 1.0 + nrm((DEPTH, HEAD_DIM), 0.02),
        'k_norm': 1.0 + nrm((DEPTH, HEAD_DIM), 0.02),
        'rg_conv_w': nrm((DEPTH, RG_CONV, RG_W), RG_CONV ** -0.5),
        'rg_conv_b': nrm((DEPTH, RG_W), 0.02),
        'rg_lambda': rg_lambda,
        'rg_w_a': nrm((DEPTH, 2, RG_BLOCKS, RG_BW, RG_BW), RG_BW ** -0.5),
        'rg_b_a': nrm((DEPTH, 2, RG_W), 0.02),
        'rg_w_x': nrm((DEPTH, 2, RG_BLOCKS, RG_BW, RG_BW), RG_BW ** -0.5),
        'rg_b_x': nrm((DEPTH, 2, RG_W), 0.02),
        'w_router': nrm((DEPTH, D, N_EXPERTS), D ** -0.5),
        'b_router': nrm((DEPTH, N_EXPERTS), 0.01),
        'w_gate': nrm((DEPTH, N_EXPERTS, D, EXPERT_FF), D ** -0.5),
        'w_up': nrm((DEPTH, N_EXPERTS, D, EXPERT_FF), D ** -0.5),
        'w_down': nrm((DEPTH, N_EXPERTS, EXPERT_FF, D), DN_BETA * EXPERT_FF ** -0.5),
        'ws_gate': nrm((DEPTH, D, SHARED_FF), D ** -0.5),
        'ws_up': nrm((DEPTH, D, SHARED_FF), D ** -0.5),
        'ws_down': nrm((DEPTH, SHARED_FF, D), DN_BETA * SHARED_FF ** -0.5),
    }


def reference(x, c, ctx, c_ctx, w_mod, b_mod, ln1_g, ln1_b, ln2_g, ln2_b, w_in, w_out,
              hy_short_w, hy_short_b, hy_f_w1, hy_f_b1, hy_f_freq, hy_f_w2, hy_f_b2, hy_f_w3, hy_skip,
              q_norm, k_norm, rg_conv_w, rg_conv_b, rg_lambda, rg_w_a, rg_b_a, rg_w_x, rg_b_x,
              w_router, b_router, w_gate, w_up, w_down, ws_gate, ws_up, ws_down):
    B, T, D = x.shape
    Lc = ctx.shape[1]
    cos, sin = axial_rope(T)
    s_c = jax.nn.silu(c)
    s_cc = jax.nn.silu(c_ctx)
    h, hc = x, ctx
    for l in range(DEPTH):
        last = l == DEPTH - 1
        sh1, sc1, g1, sh2, sc2, g2 = jnp.split((s_c @ w_mod[l] + b_mod[l])[:, None, :], 6, axis=-1)
        n_mod_c = 2 if last else 6
        mod_c = jnp.split(s_cc @ w_mod[l, :, :n_mod_c * D] + b_mod[l, :n_mod_c * D], n_mod_c)

        a_l = h * (1.0 + sc1) + sh1
        a_c = hc * (1.0 + mod_c[1]) + mod_c[0]
        hy_l, q_l, k_l, v_l, rgx_l, rgg_l = split_proj(a_l @ w_in[l])
        if last:
            k_c, v_c, rgx_c = jnp.split(a_c @ w_in[l, :, Q_END:RGX_END], [KV_W, 2 * KV_W], axis=-1)
            q_c = None
            rgg_c = None
        else:
            hy_c, q_c, k_c, v_c, rgx_c, rgg_c = split_proj(a_c @ w_in[l])
        hy_p = (hy_short_w[l], hy_short_b[l], hy_f_w1[l], hy_f_b1[l], hy_f_freq[l],
                hy_f_w2[l], hy_f_b2[l], hy_f_w3[l], hy_skip[l])
        att_l, att_c = attention_mixer(q_l, k_l, v_l, q_c, k_c, v_c, q_norm[l], k_norm[l], cos, sin)
        rg_l, rg_c = rglru_mixer(rgx_l, rgg_l, rgx_c, rgg_c, rg_conv_w[l], rg_conv_b[l],
                                 rg_lambda[l], rg_w_a[l], rg_b_a[l], rg_w_x[l], rg_b_x[l])
        y_l = jnp.concatenate([hyena_mixer(hy_l, *hy_p), att_l, rg_l], axis=-1) @ w_out[l]
        h = layer_norm(DN_ALPHA * h + g1 * y_l, ln1_g[l], ln1_b[l])

        moe_p = (w_router[l], b_router[l], w_gate[l], w_up[l], w_down[l], ws_gate[l], ws_up[l], ws_down[l])
        m_l = (h * (1.0 + sc2) + sh2).reshape(B * T, D)
        if last:
            f_l = moe_ffn(m_l, *moe_p)
        else:
            y_c = jnp.concatenate([hyena_mixer(hy_c, *hy_p), att_c, rg_c], axis=-1) @ w_out[l]
            hc = layer_norm(DN_ALPHA * hc + mod_c[2] * y_c, ln1_g[l], ln1_b[l])
            m_c = (hc * (1.0 + mod_c[4]) + mod_c[3]).reshape(B * Lc, D)
            f = moe_ffn(jnp.concatenate([m_l, m_c], axis=0), *moe_p)
            f_l = f[:B * T]
            hc = layer_norm(DN_ALPHA * hc + mod_c[5] * f[B * T:].reshape(B, Lc, D), ln2_g[l], ln2_b[l])
        h = layer_norm(DN_ALPHA * h + g2 * f_l.reshape(B, T, D), ln2_g[l], ln2_b[l])
    return h
```

```cpp
#include <hip/hip_runtime.h>
#include <hip/hip_bf16.h>
#include <cstdio>
#include <cstdint>
#include <cmath>
namespace pg8 {
#define PG8_LAS __attribute__((address_space(3)))
typedef unsigned short bf16_t;
typedef short bf16x8 __attribute__((ext_vector_type(8)));
typedef float f32x4 __attribute__((ext_vector_type(4)));
typedef unsigned u32x4 __attribute__((ext_vector_type(4)));
constexpr int BM = 256, BK = 64, HALF = 128, HTB = HALF * BK * 2  , STAGE_BYTES = 8 * HTB, NXCD = 8, WGM = 8;

__host__ __device__ __forceinline__ int lds_byte(int r, int c) { const int st = (r >> 4) * 2 + (c >> 5), rr = r & 15, cc = c & 31, ob = rr * 64 + cc * 2; return st * 1024 + (ob ^ (((ob >> 9) & 1) << 5)); }
__host__ __device__ __forceinline__ void stage_rc(int b, int& R, int& C) { const int st = b / 1024, sb = b % 1024, swz = sb ^ (((sb >> 9) & 1) << 5); R = (st >> 1) * 16 + swz / 64; C = (st & 1) * 32 + (swz % 64) / 2; }
__host__ __device__ __forceinline__ int perm32(int rho) { const int n = rho >> 4, i = rho & 15; return 8 * (i >> 2) + 4 * n + (i & 3); }

struct Unit { int pm, pn, e; };
struct Gemm { const bf16_t* A; const bf16_t* Bt; int M, N, K; size_t bstride; };

struct StaticOrder {
    int nM, nN, nwg, G, c;
    __host__ __device__ void init(int M, int N, int G_, int c_) { nM = M / BM; nN = N / BM; nwg = nM * nN; G = G_; c = c_; }
    __host__ __device__ bool next(int i, Unit& u) const {
        const long L = (long)i * G + c; if (L >= nwg) return false;
        int wgid = (int)L; { const int q = nwg / NXCD, r = nwg % NXCD, xcd = wgid % NXCD, off = wgid / NXCD; wgid = (xcd < r ? xcd * (q + 1) : r * (q + 1) + (xcd - r) * q) + off; }
        const int nig = WGM * nN, gid = wgid / nig, fm = gid * WGM, gsz = (nM - fm) < WGM ? (nM - fm) : WGM;
        u.pm = fm + ((wgid % nig) % gsz); u.pn = (wgid % nig) / gsz; u.e = 0; return true;
    }
    __device__ __forceinline__ void a_ready(const Unit&) const {}
    __device__ __forceinline__ void done(const Unit&) const {}
};

__device__ __forceinline__ unsigned cvt_pk_bf16(float lo, float hi) { unsigned r; asm volatile("v_cvt_pk_bf16_f32 %0, %1, %2" : "=v"(r) : "v"(lo), "v"(hi)); return r; }
typedef float f32x2 __attribute__((ext_vector_type(2)));

struct EpiBf16 {
    static constexpr bool PERM = true;
    bf16_t* O; int ldc; bf16_t* O2; int pm_split; int pm_off2;
    __device__ __forceinline__ void operator()(const f32x4 (&acc)[2][2][4][2], const Unit& u, int wr, int wc, int fr, int fq) const {
        bf16_t* base = O; int pm = u.pm; if (pm >= pm_split) { base = O2; pm -= pm_off2; }
        const int row0 = pm * BM + wr * 64 + fr; const int col0 = u.pn * BM + wc * 32 + 8 * fq;
#pragma unroll
        for (int ai = 0; ai < 2; ++ai)
#pragma unroll
            for (int m = 0; m < 4; ++m) { bf16_t* rowp = base + (size_t)(row0 + ai * HALF + m * 16) * ldc + col0;
#pragma unroll
                for (int bj = 0; bj < 2; ++bj) { const f32x4 v0 = acc[ai][bj][m][0], v1 = acc[ai][bj][m][1];
                    u32x4 w; w.x = cvt_pk_bf16(v0[0], v0[1]); w.y = cvt_pk_bf16(v0[2], v0[3]); w.z = cvt_pk_bf16(v1[0], v1[1]); w.w = cvt_pk_bf16(v1[2], v1[3]);
                    *(u32x4*)(rowp + bj * HALF) = w; } }
    }
};
struct EpiResid {
    static constexpr bool PERM = false;
    const float* hs_lat; const float* hs_ctx; float* vd_lat; float* vd_ctx; const float* gate; int gate_stride; int ml_tiles; float alpha;
    __device__ __forceinline__ void operator()(const f32x4 (&acc)[2][2][4][2], const Unit& u, int wr, int wc, int fr, int fq) const {
        const bool lat = u.pm < ml_tiles; const int pm = lat ? u.pm : u.pm - ml_tiles;
        const float* hs = lat ? hs_lat : hs_ctx; float* vd = lat ? vd_lat : vd_ctx;
        const int modrow = lat ? (u.pm >> 4) : 8;
        const int row0 = pm * BM + wr * 64 + fr; const int col0 = u.pn * BM + wc * 32 + 4 * fq;
        f32x4 gv[2][2];
#pragma unroll
        for (int bj = 0; bj < 2; ++bj)
#pragma unroll
            for (int n = 0; n < 2; ++n) gv[bj][n] = *(const f32x4*)(gate + (size_t)modrow * gate_stride + col0 + bj * HALF + n * 16);
#pragma unroll
        for (int ai = 0; ai < 2; ++ai)
#pragma unroll
            for (int m = 0; m < 4; ++m) { const size_t off = (size_t)(row0 + ai * HALF + m * 16) * 1024 + col0;
#pragma unroll
                for (int bj = 0; bj < 2; ++bj)
#pragma unroll
                    for (int n = 0; n < 2; ++n) { const f32x4 hv = *(const f32x4*)(hs + off + bj * HALF + n * 16);
                        *(f32x4*)(vd + off + bj * HALF + n * 16) = hv * alpha + gv[bj][n] * acc[ai][bj][m][n]; } }
    }
};
struct EpiGU {
    static constexpr bool PERM = true;
    bf16_t* H; const float* swt;
    __device__ __forceinline__ void operator()(const f32x4 (&acc)[2][2][4][2], const Unit& u, int wr, int wc, int fr, int fq) const {
        const int row0 = u.pm * BM + wr * 64 + fr; const int col0 = u.pn * HALF + wc * 32 + 8 * fq;
#pragma unroll
        for (int ai = 0; ai < 2; ++ai)
#pragma unroll
            for (int m = 0; m < 4; ++m) { const int row = row0 + ai * HALF + m * 16; const float w = swt[row];
                float h[8];
#pragma unroll
                for (int n = 0; n < 2; ++n)
#pragma unroll
                    for (int j = 0; j < 4; ++j) { const float g = acc[ai][0][m][n][j], up = acc[ai][1][m][n][j];
                        const float s = g * __builtin_amdgcn_rcpf(1.0f + __builtin_amdgcn_exp2f(-1.4426950408889634f * g)); h[n * 4 + j] = s * up * w; }
                u32x4 o; o.x = cvt_pk_bf16(h[0], h[1]); o.y = cvt_pk_bf16(h[2], h[3]); o.z = cvt_pk_bf16(h[4], h[5]); o.w = cvt_pk_bf16(h[6], h[7]);
                *(u32x4*)(H + (size_t)row * 256 + col0) = o; }
    }
};
struct MoeOrder {
    const PG8_LAS unsigned* tiles; int ntiles, nN, G, c; const int* stok; int sh_pm0;
    __device__ __forceinline__ bool next(int i, Unit& u) const {
        const long L = (long)i * G + c; if (L >= (long)ntiles * nN) return false;
        const int t = (int)(L / nN); u.pn = (int)(L % nN); const unsigned pk = (unsigned)__builtin_amdgcn_readfirstlane((int)tiles[t]); u.e = (int)(pk >> 16); u.pm = (int)(pk & 0xffffu); return true;
    }
    __device__ __forceinline__ int arow(const Unit& u, int r) const { return u.e >= 64 ? (u.pm - sh_pm0) * BM + r : stok[u.pm * BM + r]; }
    __device__ __forceinline__ void a_ready(const Unit&) const {}
    __device__ __forceinline__ void done(const Unit&) const {}
};

__device__ __forceinline__ const char* uptr(const char* p) { const unsigned long long v = (unsigned long long)p; const unsigned lo = (unsigned)__builtin_amdgcn_readfirstlane((int)(unsigned)v), hi = (unsigned)__builtin_amdgcn_readfirstlane((int)(unsigned)(v >> 32)); return (const char*)(((unsigned long long)hi << 32) | lo); }
template <class Epi, class Sched, bool ALIGN_EPI, bool GATHER, int KC>
__device__ __forceinline__ void gemm_phase(PG8_LAS unsigned char* lds, const Gemm g, const Sched& S, const Epi& E) {
    int tid_ = threadIdx.x; asm volatile("" : "+v"(tid_));
    const int tid = tid_, wid = __builtin_amdgcn_readfirstlane(tid >> 6), lane = tid & 63, wr = wid >> 2, wc = wid & 3, fr = lane & 15, fq = lane >> 4;
    constexpr int K = KC, nt = K / BK;
    unsigned voffB[2]; int RA[2], CA[2];
    unsigned oc[2][2], on[2][2];
    const size_t hstep = (size_t)HALF * K * 2;
#pragma unroll
    for (int i = 0; i < 2; ++i) { int R, C; stage_rc(tid * 16 + i * 8192, R, C); const int Rb = Epi::PERM ? ((R & ~31) + perm32(R & 31)) : R;
        RA[i] = R; CA[i] = C; voffB[i] = (unsigned)(Rb * K + C) * 2u;
        oc[0][i] = (unsigned)(R * K + C) * 2u; oc[1][i] = oc[0][i] + (unsigned)hstep; on[0][i] = oc[0][i]; on[1][i] = oc[1][i]; }
    const size_t kstep = (size_t)(BK * 2);
    const size_t tstep = 2 * hstep;
    const unsigned ldsw = (unsigned)wid * 1024u;
    const int aoff = lds_byte(wr * 64 + fr, fq * 8), boff = lds_byte(wc * 32 + fr, fq * 8);
#define PG8_SA(b, h) (((b) * 2 + (h)) * HTB)
#define PG8_SB(b, h) ((4 + (b) * 2 + (h)) * HTB)
#define PG8_STAGE(bufoff, gbase, voff) do { _Pragma("unroll") for (int _i = 0; _i < 2; ++_i) \
        __builtin_amdgcn_global_load_lds((const unsigned*)((const char*)(gbase) + (voff)[_i]), (PG8_LAS unsigned*)(lds + (bufoff) + ldsw + _i * 8192), 16, 0, 0); } while (0)
#define PG8_STAGE_A(bufoff, gbase, OA, h) do { _Pragma("unroll") for (int _i = 0; _i < 2; ++_i) \
        __builtin_amdgcn_global_load_lds((const unsigned*)((const char*)(gbase) + (OA)[h][_i]), (PG8_LAS unsigned*)(lds + (bufoff) + ldsw + _i * 8192), 16, 0, 0); } while (0)
#define PG8_LDA(dst, b, h) do { _Pragma("unroll") for (int m = 0; m < 4; ++m) _Pragma("unroll") for (int k = 0; k < 2; ++k) dst[m][k] = *(const PG8_LAS bf16x8*)(lds + PG8_SA(b, h) + aoff + m * 2048 + k * 1024); } while (0)
#define PG8_LDB(dst, b, h) do { _Pragma("unroll") for (int n = 0; n < 2; ++n) _Pragma("unroll") for (int k = 0; k < 2; ++k) dst[n][k] = *(const PG8_LAS bf16x8*)(lds + PG8_SB(b, h) + boff + n * 2048 + k * 1024); } while (0)
#define PG8_MMA(ai, bj, At, Bt) do { __builtin_amdgcn_s_setprio(1); _Pragma("unroll") for (int m = 0; m < 4; ++m) _Pragma("unroll") for (int n = 0; n < 2; ++n) _Pragma("unroll") for (int k = 0; k < 2; ++k) \
        acc[ai][bj][m][n] = __builtin_amdgcn_mfma_f32_16x16x32_bf16(Bt[n][k], At[m][k], acc[ai][bj][m][n], 0, 0, 0); __builtin_amdgcn_s_setprio(0); } while (0)
#define PG8_WAIT_V(n) asm volatile("s_waitcnt vmcnt(" #n ")" ::: "memory")
#define PG8_WAIT_L(n) asm volatile("s_waitcnt lgkmcnt(" #n ")" ::: "memory")
#define PG8_BAR __builtin_amdgcn_s_barrier()
#define PG8_SCHED __builtin_amdgcn_sched_barrier(0)
    Unit cur, nxt; int ui = 0;
    if (!S.next(0, cur)) return;
    f32x4 acc[2][2][4][2];
#pragma unroll
    for (int a = 0; a < 2; ++a)
#pragma unroll
        for (int b = 0; b < 2; ++b)
#pragma unroll
            for (int m = 0; m < 4; ++m)
#pragma unroll
                for (int n = 0; n < 2; ++n) acc[a][b][m][n] = (f32x4){0.f, 0.f, 0.f, 0.f};
    bf16x8 At[4][2], B0[2][2], B1[2][2];
    const char* cA; const char* cB = uptr((const char*)g.Bt + (size_t)cur.e * g.bstride + (size_t)cur.pn * tstep);
    if constexpr (GATHER) { cA = (const char*)g.A;
#pragma unroll
        for (int h = 0; h < 2; ++h)
#pragma unroll
            for (int i = 0; i < 2; ++i) oc[h][i] = (unsigned)(S.arow(cur, h * HALF + RA[i]) * K + CA[i]) * 2u;
    } else cA = uptr((const char*)g.A + (size_t)cur.pm * tstep);
    S.a_ready(cur);
    PG8_STAGE(PG8_SB(0, 0), cB, voffB); PG8_STAGE(PG8_SB(0, 1), cB + hstep, voffB); PG8_STAGE_A(PG8_SA(0, 0), cA, oc, 0); PG8_STAGE_A(PG8_SA(0, 1), cA, oc, 1);
    if (wr == 1) PG8_BAR;
    PG8_WAIT_V(2); PG8_BAR;
    PG8_STAGE(PG8_SB(1, 0), cB + kstep, voffB); PG8_STAGE_A(PG8_SA(1, 0), cA + kstep, oc, 0); PG8_STAGE(PG8_SB(1, 1), cB + hstep + kstep, voffB);
    PG8_WAIT_V(6); PG8_BAR;
    for (;;) {
        const bool has_next = S.next(ui + 1, nxt);
        const char* nA = cA; const char* nB = has_next ? uptr((const char*)g.Bt + (size_t)nxt.e * g.bstride + (size_t)nxt.pn * tstep) : cB;
        if constexpr (GATHER) {
            if (has_next) {
#pragma unroll
                for (int h = 0; h < 2; ++h)
#pragma unroll
                    for (int i = 0; i < 2; ++i) on[h][i] = (unsigned)(S.arow(nxt, h * HALF + RA[i]) * K + CA[i]) * 2u;
            } else {
#pragma unroll
                for (int h = 0; h < 2; ++h)
#pragma unroll
                    for (int i = 0; i < 2; ++i) on[h][i] = oc[h][i];
            }
        } else { if (has_next) nA = uptr((const char*)g.A + (size_t)nxt.pm * tstep); }
#pragma unroll 1
        for (int t = 0; t < nt; t += 2) {
            const bool last = (t == nt - 2);
            const char* a1 = cA + (size_t)(t + 1) * kstep;
            const char* a2 = last ? nA : cA + (size_t)(t + 2) * kstep; const char* b2 = last ? nB : cB + (size_t)(t + 2) * kstep;
            const char* a3 = a2 + kstep; const char* b3 = b2 + kstep;
            unsigned o2[2][2];
#pragma unroll
            for (int h = 0; h < 2; ++h)
#pragma unroll
                for (int i = 0; i < 2; ++i) o2[h][i] = (GATHER && last) ? on[h][i] : oc[h][i];
            if (last && has_next) S.a_ready(nxt);
            PG8_LDB(B0, 0, 0); PG8_LDB(B1, 0, 1); PG8_SCHED; PG8_LDA(At, 0, 0); PG8_STAGE_A(PG8_SA(1, 1), a1, oc, 1);
            PG8_WAIT_V(8); PG8_WAIT_L(0); PG8_BAR; PG8_MMA(0, 0, At, B0); PG8_MMA(0, 1, At, B1); PG8_BAR; PG8_SCHED;
            PG8_LDA(At, 0, 1); PG8_STAGE(PG8_SB(0, 0), b2, voffB); PG8_STAGE(PG8_SB(0, 1), b2 + hstep, voffB); PG8_STAGE_A(PG8_SA(0, 0), a2, o2, 0);
            PG8_WAIT_V(8); PG8_WAIT_L(0); PG8_BAR; PG8_MMA(1, 0, At, B0); PG8_MMA(1, 1, At, B1); PG8_BAR; PG8_SCHED;
            PG8_LDB(B0, 1, 0); PG8_LDB(B1, 1, 1); PG8_SCHED; PG8_LDA(At, 1, 0); PG8_STAGE_A(PG8_SA(0, 1), a2, o2, 1);
            PG8_WAIT_V(8); PG8_WAIT_L(0); PG8_BAR; PG8_MMA(0, 0, At, B0); PG8_MMA(0, 1, At, B1); PG8_BAR; PG8_SCHED;
            PG8_LDA(At, 1, 1); PG8_STAGE(PG8_SB(1, 0), b3, voffB); PG8_STAGE(PG8_SB(1, 1), b3 + hstep, voffB); PG8_STAGE_A(PG8_SA(1, 0), a3, o2, 0);
            PG8_WAIT_V(8); PG8_WAIT_L(0); PG8_BAR; PG8_MMA(1, 0, At, B0); PG8_MMA(1, 1, At, B1); PG8_BAR; PG8_SCHED;
        }
        if constexpr (ALIGN_EPI) { if (wr == 0) PG8_BAR; }
        E(acc, cur, wr, wc, fr, fq); S.done(cur);
        if (!has_next) break;
#pragma unroll
        for (int a = 0; a < 2; ++a)
#pragma unroll
            for (int b = 0; b < 2; ++b)
#pragma unroll
                for (int m = 0; m < 4; ++m)
#pragma unroll
                    for (int n = 0; n < 2; ++n) acc[a][b][m][n] = (f32x4){0.f, 0.f, 0.f, 0.f};
        cur = nxt; cA = nA; cB = nB; ++ui;
#pragma unroll
        for (int h = 0; h < 2; ++h)
#pragma unroll
            for (int i = 0; i < 2; ++i) oc[h][i] = on[h][i];
        if constexpr (ALIGN_EPI) { if (wr == 1) PG8_BAR; }
    }
    PG8_WAIT_V(0);
    if constexpr (!ALIGN_EPI) { if (wr == 0) PG8_BAR; }
    PG8_BAR;
#undef PG8_SA
#undef PG8_SB
#undef PG8_STAGE
#undef PG8_STAGE_A
#undef PG8_LDA
#undef PG8_LDB
#undef PG8_MMA
#undef PG8_WAIT_V
#undef PG8_WAIT_L
#undef PG8_BAR
#undef PG8_SCHED
}
}
namespace attn_body {
using bf16=__hip_bfloat16;
using bf16x8=__attribute__((ext_vector_type(8)))short;
using s16x4=__attribute__((ext_vector_type(4)))short;
using f32x16=__attribute__((ext_vector_type(16)))float;
using u32x4=__attribute__((ext_vector_type(4)))unsigned;
constexpr int D=64,QP=512,KP=128,OP=1024;
constexpr int NW=8,QBLK=32,QB=QBLK*NW,KVBLK=64;
constexpr int ATTN_UNIT_ROWS=QB;
__device__ __forceinline__ int crow(int r,int hi){return (r&3)+8*(r>>2)+4*hi;}
#define SBAR() __builtin_amdgcn_sched_barrier(0)
__device__ __forceinline__ void cmask(f32x16&p0,f32x16&p1,int jb,int qrel,int hi){
  const float NEG=-INFINITY; int kb=64*jb+4*hi;
  #pragma unroll
  for(int r=0;r<16;++r){int kv=kb+(r&3)+8*(r>>2); if(kv>qrel)p0[r]=NEG; if(kv+32>qrel)p1[r]=NEG;}
}

constexpr int NSLOT=3, SLOTB=8192;
constexpr int LDS_K=0, LDS_V=NSLOT*SLOTB, LDS_WS=2*NSLOT*SLOTB, LDS_OST=LDS_WS+NW*64*4, LDS_BYTES=LDS_OST+NW*4096;
constexpr float C2=0.125f*1.4426950408889634f;
__device__ __forceinline__ void glds16(const void*gsrc,unsigned lds_dst){unsigned keep;
  asm volatile("s_mov_b32 %0, m0\n\ts_mov_b32 m0, %2\n\ts_nop 0\n\tglobal_load_lds_dwordx4 %1, off\n\ts_mov_b32 m0, %0":"=&s"(keep):"v"(gsrc),"s"(lds_dst):"memory");}
__device__ __forceinline__ float max3f(float a,float b,float c){float r;asm("v_max3_f32 %0, %1, %2, %3":"=v"(r):"v"(a),"v"(b),"v"(c));return r;}
__device__ __forceinline__ float max2f(float a,float b){float r;asm("v_max_f32_e32 %0, %1, %2":"=v"(r):"v"(a),"v"(b));return r;}
__device__ __forceinline__ float fadd_s(float a,float b){float r;asm("v_add_f32_e32 %0, %1, %2":"=v"(r):"v"(a),"v"(b));return r;}
__device__ __forceinline__ float fsub_s(float a,float b){float r;asm("v_sub_f32_e32 %0, %1, %2":"=v"(r):"v"(a),"v"(b));return r;}
typedef float f32x2_t __attribute__((ext_vector_type(2))); typedef __bf16 bf16x2_t __attribute__((ext_vector_type(2)));
__device__ __forceinline__ unsigned cvtpk_s(float lo,float hi){f32x2_t v={lo,hi};bf16x2_t b=__builtin_convertvector(v,bf16x2_t);return __builtin_bit_cast(unsigned,b);}
#define WAIT_BAR(N) asm volatile("s_waitcnt vmcnt(" #N ") lgkmcnt(0)\n\ts_barrier":::"memory")

__device__ __forceinline__ void qkt(f32x16&p0,f32x16&p1,const char*Kslot,const bf16x8*qr,const f32x16&negm,int r32,int hi){
  const char*kb=Kslot+hi*1024+r32*16;
  #pragma unroll
  for(int d0=0;d0<4;++d0){
    const bf16x8 b0=*reinterpret_cast<const bf16x8*>(kb+d0*2048);
    const bf16x8 b1=*reinterpret_cast<const bf16x8*>(kb+d0*2048+512);
    if(d0==0){p0=__builtin_amdgcn_mfma_f32_32x32x16_bf16(b0,qr[0],negm,0,0,0);p1=__builtin_amdgcn_mfma_f32_32x32x16_bf16(b1,qr[0],negm,0,0,0);}
    else{p0=__builtin_amdgcn_mfma_f32_32x32x16_bf16(b0,qr[d0],p0,0,0,0);p1=__builtin_amdgcn_mfma_f32_32x32x16_bf16(b1,qr[d0],p1,0,0,0);}}
}
typedef __attribute__((address_space(3))) const char* lds_cptr;
typedef short v4i16_t __attribute__((ext_vector_type(4)));
__device__ __forceinline__ void kload8(bf16x8*kf,lds_cptr kp){
  kf[0]=*(const __attribute__((address_space(3))) bf16x8*)(kp);      kf[1]=*(const __attribute__((address_space(3))) bf16x8*)(kp+512);
  kf[2]=*(const __attribute__((address_space(3))) bf16x8*)(kp+2048); kf[3]=*(const __attribute__((address_space(3))) bf16x8*)(kp+2560);
  kf[4]=*(const __attribute__((address_space(3))) bf16x8*)(kp+4096); kf[5]=*(const __attribute__((address_space(3))) bf16x8*)(kp+4608);
  kf[6]=*(const __attribute__((address_space(3))) bf16x8*)(kp+6144); kf[7]=*(const __attribute__((address_space(3))) bf16x8*)(kp+6656);
}
__device__ __forceinline__ void kload2(bf16x8*kf,lds_cptr kp,int j){ kf[2*j]=*(const __attribute__((address_space(3))) bf16x8*)(kp+j*2048); kf[2*j+1]=*(const __attribute__((address_space(3))) bf16x8*)(kp+j*2048+512); }
__device__ __forceinline__ s16x4 vtr(lds_cptr p){ return __builtin_bit_cast(s16x4,__builtin_amdgcn_ds_read_tr16_b64_v4i16((__attribute__((address_space(3))) v4i16_t*)p)); }
__device__ __forceinline__ float rowmax(const f32x16&p0,const f32x16&p1){
  float a=max3f(p0[0],p0[1],p1[0]),b=max3f(p0[2],p0[3],p1[1]);a=max3f(a,p1[2],p1[3]);
  #pragma unroll
  for(int r=4;r<16;r+=4){a=max3f(a,p0[r],p0[r+1]);b=max3f(b,p0[r+2],p0[r+3]);a=max3f(a,p1[r],p1[r+1]);b=max3f(b,p1[r+2],p1[r+3]);}
  const float m=max2f(a,b);
  auto rr=__builtin_amdgcn_permlane32_swap(__float_as_uint(m),__float_as_uint(m),false,false);
  return max2f(__uint_as_float(rr[0]),__uint_as_float(rr[1]));
}
__device__ __forceinline__ void pv(f32x16*o,int vb,bf16x8 pa0,bf16x8 pa1,bf16x8 pa2,bf16x8 pa3){
  #pragma unroll
  for(int d0=0;d0<2;++d0){s16x4 lo[4],hi[4];
    #pragma unroll
    for(int ks=0;ks<4;++ks){
      asm volatile("ds_read_b64_tr_b16 %0,%1 offset:%c2":"=&v"(lo[ks]):"v"(vb),"i"(d0*4096+ks*1024):"memory");
      asm volatile("ds_read_b64_tr_b16 %0,%1 offset:%c2":"=&v"(hi[ks]):"v"(vb),"i"(d0*4096+ks*1024+512):"memory");}
    asm volatile("s_waitcnt lgkmcnt(0)":::"memory");SBAR();
    #define PK(k) (bf16x8){lo[k][0],lo[k][1],lo[k][2],lo[k][3],hi[k][0],hi[k][1],hi[k][2],hi[k][3]}
    o[d0]=__builtin_amdgcn_mfma_f32_32x32x16_bf16(pa0,PK(0),o[d0],0,0,0);
    o[d0]=__builtin_amdgcn_mfma_f32_32x32x16_bf16(pa1,PK(1),o[d0],0,0,0);
    o[d0]=__builtin_amdgcn_mfma_f32_32x32x16_bf16(pa2,PK(2),o[d0],0,0,0);
    o[d0]=__builtin_amdgcn_mfma_f32_32x32x16_bf16(pa3,PK(3),o[d0],0,0,0);
    #undef PK
  }
}

#ifndef ATTN_STORE16
#define ATTN_STORE16(p,v) (*(u32x4*)(p)=(v))
#endif
template<int THRL> __device__ __forceinline__ void attn_unit(long qrow0,int qcol,long kvrow0,int kvcol,int NT,long orow0,int ocol,const bf16*Q,const bf16* K,const bf16* V,bf16*O,char*shm){
  int tid_=threadIdx.x; asm volatile("":"+v"(tid_)); const int tid=tid_,lane=tid&63,r32=lane&31,hi=lane>>5; const int wid=__builtin_amdgcn_readfirstlane(tid>>6);
  const bf16*Qw=Q+(qrow0+wid*QBLK)*QP+qcol;
  const bf16*Kh=K+kvrow0*KP+kvcol,*Vh=V+kvrow0*KP+kvcol;
  const unsigned lds0=(unsigned)(uintptr_t)shm;
  float*wsf=(float*)(shm+LDS_WS)+wid*64;
  const bf16*ksrc=Kh+(long)lane*KP+wid*8;
  const bf16*vsrc=Vh+(long)(16*(wid&3)+(lane>>2))*KP+(wid>>2)*32+(lane&3)*8;
  const unsigned kdst=lds0+LDS_K+wid*1024, vdst=lds0+LDS_V+wid*1024;
  #define DMA_K(t,slot) glds16(ksrc+(long)(t)*KVBLK*KP,(unsigned)__builtin_amdgcn_readfirstlane(kdst+(slot)))
  #define DMA_V(t,slot) glds16(vsrc+(long)(t)*KVBLK*KP,(unsigned)__builtin_amdgcn_readfirstlane(vdst+(slot)))
  const int vb0=(int)(lds0+LDS_V)+((lane>>4)&1)*32+(lane&3)*8+(4*hi+((lane&15)>>2))*64;
  const char*Kbase=shm+LDS_K; bf16x8 kf[8];
  const lds_cptr shm3=(lds_cptr)shm; const lds_cptr kp0=shm3+LDS_K+hi*1024+r32*16; const lds_cptr vp0=shm3+LDS_V+((lane>>4)&1)*32+(lane&3)*8+(4*hi+((lane&15)>>2))*64;
  DMA_K(0,0);DMA_V(0,0);DMA_K(1,SLOTB);
  bf16x8 qr[4];
  #pragma unroll
  for(int d0=0;d0<4;++d0)qr[d0]=*reinterpret_cast<const bf16x8*>(&Qw[(long)r32*QP+d0*16+hi*8]);
  float mhat=0.f,l_reg=0.f;f32x16 o[2];o[0]=f32x16{};o[1]=f32x16{};f32x16 negm=f32x16{};asm volatile("":"+v"(negm));
  #define CMASK(P0,P1,t) do{}while(0)
  bool resc=false;
  #define START(P0,P1) do{ const float rm=rowmax(P0,P1); resc=false; \
    { const float dl=rm; mhat=fadd_s(mhat,dl); \
      _Pragma("unroll") for(int r=0;r<16;++r){P0[r]=fsub_s(P0[r],dl);P1[r]=fsub_s(P1[r],dl);} \
      _Pragma("unroll") for(int r=0;r<16;++r)negm[r]=-mhat; asm volatile("":"+v"(negm)); } \
    _Pragma("unroll") for(int r=0;r<16;++r)P0[r]=__builtin_amdgcn_exp2f(P0[r]); }while(0)
  #define RESC() do{ if(resc){ asm volatile("s_waitcnt lgkmcnt(0)":::"memory"); \
      _Pragma("unroll") for(int d_=0;d_<2;++d_) _Pragma("unroll") for(int r=0;r<16;++r)o[d_][r]*=wsf[crow(r,hi)]; } }while(0)
  f32x16 pA0,pA1,pB0,pB1;
  int sl_prev=0,sl_cur=0,sl_next=SLOTB;
  #define ROT() do{sl_prev=sl_cur;sl_cur=sl_next;sl_next=(sl_next==(NSLOT-1)*SLOTB)?0:sl_next+SLOTB;}while(0)
  DMA_K(2,2*SLOTB);
  WAIT_BAR(3);
  qkt(pA0,pA1,Kbase,qr,negm,r32,hi);asm volatile("s_nop 15\n\ts_nop 7":"+v"(pA0),"+v"(pA1));CMASK(pA0,pA1,0);
  START(pA0,pA1);
  _Pragma("unroll") for(int r=0;r<16;++r)pA1[r]=__builtin_amdgcn_exp2f(pA1[r]);
  WAIT_BAR(0);
  DMA_K(3,0);DMA_V(1,SLOTB);
  ROT();
  kload8(kf,kp0+sl_cur);
  WAIT_BAR(2);
  s16x4 vlo[8],vhi[8]; u32x4 pw0,pw1,pw2,pw3;
  #define PKW(P,B) cvtpk_s(P[B],P[B+1])
  #define PAF(k) __builtin_bit_cast(bf16x8,pw##k)
  #define VFR(i) (bf16x8){vlo[i][0],vlo[i][1],vlo[i][2],vlo[i][3],vhi[i][0],vhi[i][1],vhi[i][2],vhi[i][3]}
  #define PIN(x) asm volatile("":"+v"(x))
  #define MX3(a,b,c) __builtin_fmaxf(__builtin_fmaxf((a),(b)),(c))
  #define GAPA(MF,A0,A1,A2,A3,W0,W1,PW) do{ MF; sacc+=A0; sacc+=A1; sacc+=A2; sacc+=A3; PIN(sacc); W0; W1; PIN(PW); SBAR(); }while(0)
  #define EX(v) __builtin_amdgcn_exp2f(v)
  #define GAPB(MF,X,B) do{ MF; X[B]=EX(X[B]); X[B+1]=EX(X[B+1]); X[B+2]=EX(X[B+2]); X[B+3]=EX(X[B+3]); PIN(X); SBAR(); }while(0)
  #define VRD(i) do{ vlo[i]=vtr(vp_+(((i)>>2)*4096+((i)&3)*1024)); vhi[i]=vtr(vp_+(((i)>>2)*4096+((i)&3)*1024+512)); }while(0)
  #define KRD(G,j) do{ if(G){ kload2(kf,kp0+sl_next,j); SBAR(); } }while(0)
  #define STEP(C0,C1,P0,P1,t,GK,GV,GL) do{ SBAR(); \
    const lds_cptr vp_=vp0+sl_prev; \
    VRD(0); SBAR(); float sacc=(P0[0]+P0[1]); \
    GAPA(C0=__builtin_amdgcn_mfma_f32_32x32x16_bf16(kf[0],qr[0],negm,0,0,0), P0[2],P0[3],P0[4],P0[5],     pw0[0]=PKW(P0,0), pw0[1]=PKW(P0,2), pw0); \
    VRD(4); SBAR(); GAPA(C1=__builtin_amdgcn_mfma_f32_32x32x16_bf16(kf[1],qr[0],negm,0,0,0), P0[6],P0[7],P0[8],P0[9],     pw0[2]=PKW(P0,4), pw0[3]=PKW(P0,6), pw0); \
    VRD(1); SBAR(); GAPA(C0=__builtin_amdgcn_mfma_f32_32x32x16_bf16(kf[2],qr[1],C0,0,0,0),   P0[10],P0[11],P0[12],P0[13], pw1[0]=PKW(P0,8), pw1[1]=PKW(P0,10), pw1); \
    VRD(5); SBAR(); GAPA(C1=__builtin_amdgcn_mfma_f32_32x32x16_bf16(kf[3],qr[1],C1,0,0,0),   P0[14],P0[15],P1[0],P1[1],   pw1[2]=PKW(P0,12),pw1[3]=PKW(P0,14), pw1); \
    VRD(2); SBAR(); GAPA(C0=__builtin_amdgcn_mfma_f32_32x32x16_bf16(kf[4],qr[2],C0,0,0,0),   P1[2],P1[3],P1[4],P1[5],     pw2[0]=PKW(P1,0), pw2[1]=PKW(P1,2), pw2); \
    VRD(6); SBAR(); GAPA(C1=__builtin_amdgcn_mfma_f32_32x32x16_bf16(kf[5],qr[2],C1,0,0,0),   P1[6],P1[7],P1[8],P1[9],     pw2[2]=PKW(P1,4), pw2[3]=PKW(P1,6), pw2); \
    VRD(3); SBAR(); GAPA(C0=__builtin_amdgcn_mfma_f32_32x32x16_bf16(kf[6],qr[3],C0,0,0,0),   P1[10],P1[11],P1[12],P1[13], pw3[0]=PKW(P1,8), pw3[1]=PKW(P1,10), pw3); \
    VRD(7); SBAR(); GAPA(C1=__builtin_amdgcn_mfma_f32_32x32x16_bf16(kf[7],qr[3],C1,0,0,0),   P1[14],P1[15],0.f,0.f,       pw3[2]=PKW(P1,12),pw3[3]=PKW(P1,14), pw3); \
    l_reg+=sacc; \
    if(GK){DMA_K((t)+3,sl_cur);} if(GV){DMA_V((t)+1,sl_next);} \
    CMASK(C0,C1,t); \
    { float a=MX3(C0[0],C0[1],C1[0]),b=MX3(C0[2],C0[3],C1[1]); a=MX3(a,C1[2],C1[3]); \
      _Pragma("unroll") for(int r=4;r<16;r+=4){a=MX3(a,C0[r],C0[r+1]);b=MX3(b,C0[r+2],C0[r+3]);a=MX3(a,C1[r],C1[r+1]);b=MX3(b,C1[r+2],C1[r+3]);} \
      float rm=__builtin_fmaxf(a,b); { auto rr=__builtin_amdgcn_permlane32_swap(__float_as_uint(rm),__float_as_uint(rm),false,false); rm=__builtin_fmaxf(__uint_as_float(rr[0]),__uint_as_float(rr[1])); } \
      resc=false; \
      if(__builtin_expect(__any(rm>(float)THRL),0)){ const float dl=__builtin_fmaxf(rm,0.f); mhat+=dl; \
        _Pragma("unroll") for(int r=0;r<16;++r){C0[r]-=dl;C1[r]-=dl;} \
        _Pragma("unroll") for(int r=0;r<16;++r)negm[r]=-mhat; asm volatile("":"+v"(negm)); \
        const float f=__builtin_amdgcn_exp2f(-dl); l_reg*=f; if(hi==0)wsf[r32]=f; resc=true; } } \
    SBAR(); \
    GAPB(o[0]=__builtin_amdgcn_mfma_f32_32x32x16_bf16(PAF(0),VFR(0),o[0],0,0,0), C0,0); \
    GAPB(o[1]=__builtin_amdgcn_mfma_f32_32x32x16_bf16(PAF(0),VFR(4),o[1],0,0,0), C0,4); \
    KRD(GL,0); GAPB(o[0]=__builtin_amdgcn_mfma_f32_32x32x16_bf16(PAF(1),VFR(1),o[0],0,0,0), C0,8); \
    KRD(GL,1); GAPB(o[1]=__builtin_amdgcn_mfma_f32_32x32x16_bf16(PAF(1),VFR(5),o[1],0,0,0), C0,12); \
    KRD(GL,2); GAPB(o[0]=__builtin_amdgcn_mfma_f32_32x32x16_bf16(PAF(2),VFR(2),o[0],0,0,0), C1,0); \
    KRD(GL,3); GAPB(o[1]=__builtin_amdgcn_mfma_f32_32x32x16_bf16(PAF(2),VFR(6),o[1],0,0,0), C1,4); \
    GAPB(o[0]=__builtin_amdgcn_mfma_f32_32x32x16_bf16(PAF(3),VFR(3),o[0],0,0,0), C1,8); \
    GAPB(o[1]=__builtin_amdgcn_mfma_f32_32x32x16_bf16(PAF(3),VFR(7),o[1],0,0,0), C1,12); \
    }while(0)
  int t=1;
  for(;t+5<NT;t+=2){
    STEP(pB0,pB1,pA0,pA1,t,true,true,true);     WAIT_BAR(2); RESC(); ROT();
    STEP(pA0,pA1,pB0,pB1,t+1,true,true,true);   WAIT_BAR(2); RESC(); ROT();
  }
  #define ENDW(tt) do{ if((tt)+3<NT){WAIT_BAR(2);} else if((tt)+2<NT){WAIT_BAR(1);} else {WAIT_BAR(0);} }while(0)
  for(;t+1<NT;t+=2){
    STEP(pB0,pB1,pA0,pA1,t,(t+3<NT),(t+1<NT),(t+1<NT));       ENDW(t);   RESC(); ROT();
    STEP(pA0,pA1,pB0,pB1,t+1,(t+4<NT),(t+2<NT),(t+2<NT));     ENDW(t+1); RESC(); ROT();
  }
  STEP(pB0,pB1,pA0,pA1,NT-1,false,false,false); RESC();
  { float sacc=pB0[0]+pB0[1]; _Pragma("unroll") for(int r=2;r<16;++r)sacc+=pB0[r]; _Pragma("unroll") for(int r=0;r<16;++r)sacc+=pB1[r]; l_reg+=sacc;
    pw0=(u32x4){PKW(pB0,0),PKW(pB0,2),PKW(pB0,4),PKW(pB0,6)};pw1=(u32x4){PKW(pB0,8),PKW(pB0,10),PKW(pB0,12),PKW(pB0,14)};pw2=(u32x4){PKW(pB1,0),PKW(pB1,2),PKW(pB1,4),PKW(pB1,6)};pw3=(u32x4){PKW(pB1,8),PKW(pB1,10),PKW(pB1,12),PKW(pB1,14)};
    SBAR(); pv(o,vb0+sl_cur,PAF(0),PAF(1),PAF(2),PAF(3)); }
  #undef PKW
  #undef PAF
  #undef VFR
  #undef PIN
  #undef MX3
  #undef GAPA
  #undef GAPB
  #undef EX
  #undef VRD
  #undef KRD
  #undef STEP
  #undef ENDW
  {auto rr=__builtin_amdgcn_permlane32_swap(__float_as_uint(l_reg),__float_as_uint(l_reg),false,false);l_reg=__uint_as_float(rr[0])+__uint_as_float(rr[1]);}
  if(hi==0)wsf[32+r32]=l_reg;asm volatile("s_waitcnt lgkmcnt(0)":::"memory");
  float rli[16];
  #pragma unroll
  for(int r=0;r<16;++r)rli[r]=__builtin_amdgcn_rcpf(wsf[32+crow(r,hi)]);
  bf16*Ow=O+(orow0+wid*QBLK)*OP+ocol;
  { bf16*stg=(bf16*)(shm+LDS_OST)+wid*2048;
    #pragma unroll
    for(int r=0;r<16;++r){const int orow=crow(r,hi);
      #pragma unroll
      for(int d0=0;d0<2;++d0)stg[orow*64+d0*32+r32]=__float2bfloat16(o[d0][r]*rli[r]);}
    asm volatile("s_waitcnt lgkmcnt(0)":::"memory");
    #pragma unroll
    for(int i=0;i<4;++i){const int row=i*8+(lane>>3),ch=lane&7; const u32x4 v=*(const u32x4*)(stg+row*64+ch*8); ATTN_STORE16(Ow+(long)row*OP+ch*8,v);} }
  asm volatile("s_waitcnt lgkmcnt(0)\n\ts_barrier":::"memory");
  #undef DMA_K
  #undef DMA_V
  #undef CMASK
  #undef START
  #undef RESC
  #undef ROT
}
constexpr int ATTN_LDS_BYTES=LDS_BYTES;
#undef SBAR
#undef WAIT_BAR
}
constexpr int NB = 8, T = 4096, D = 1024, DEPTH = 4, LC = 256;
constexpr int ML = NB * T, MC = NB * LC, M = ML + MC;
constexpr int PROJ = 2048, SKV = T + LC;
constexpr int C_HY = 0, C_Q = 768, C_K = 1280, C_V = 1408, C_RGX = 1536, C_RGG = 1792;
constexpr int NEXP = 64, TOPK = 8, FF = 256;
constexpr int SH0 = M * TOPK + NEXP * 256;
constexpr int HIDROWS = SH0 + M;
constexpr float LN_EPS = 1e-6f, QK_EPS = 1e-6f;
constexpr float DN_ALPHA = 1.681792830507429f;
constexpr float ROUTED_SCALE = 2.5f;
constexpr int NWAVES = 8;
enum { I_X = 0, I_C, I_CTX, I_CCTX, I_WMOD, I_BMOD, I_LN1G, I_LN1B, I_LN2G, I_LN2B, I_WIN, I_WOUT, I_HYSW, I_HYSB, I_HYW1, I_HYB1, I_HYFREQ, I_HYW2, I_HYB2, I_HYW3, I_HYSKIP,
       I_QN, I_KN, I_RGCW, I_RGCB, I_RGLAM, I_RGWA, I_RGBA, I_RGWX, I_RGBX, I_WR, I_BR, I_WG, I_WU, I_WD, I_WSG, I_WSU, I_WSD, N_IN };

constexpr size_t MiB = 1u << 20;
constexpr size_t WS_CTL = 0, CTL_ZERO_BYTES = 1 * MiB;
constexpr size_t WS_MODV = 1 * MiB;
constexpr size_t WS_TW = 2 * MiB;
constexpr size_t WS_ROPE = 3 * MiB;
constexpr size_t WS_RTHI = 4 * MiB, WS_RTLO = 4 * MiB + 512 * 1024;
constexpr size_t WS_RGW = 5 * MiB;
constexpr size_t WS_IDX = 6 * MiB, WS_WT = 8 * MiB, WS_POS = 10 * MiB;
constexpr size_t WS_HIST = 12 * MiB;
constexpr size_t WS_TILES = 12 * MiB + 512 * 1024;
constexpr size_t WS_STOK = 13 * MiB;
constexpr size_t WS_SWT = 15 * MiB;
constexpr size_t WS_HC = 18 * MiB;
constexpr size_t WS_WIN = 26 * MiB;
constexpr size_t WS_WOUT = 42 * MiB;
constexpr size_t WS_WGU = 50 * MiB;
constexpr size_t WS_WDN = 115 * MiB;
constexpr size_t WS_ABUF = 148 * MiB;
constexpr size_t WS_FILT = 216 * MiB;
constexpr size_t WS_FILTC = WS_FILT + 16 * MiB;
constexpr size_t WS_BIG = 234 * MiB;
constexpr size_t WS_HID = WS_BIG;
constexpr size_t WS_Y2 = WS_BIG + 162 * MiB;
constexpr size_t WS_END_MOE = WS_Y2 + (size_t)SH0 * 2048;
constexpr size_t WS_P = WS_BIG;
constexpr size_t WS_QB = WS_BIG + 136 * MiB;
constexpr size_t WS_KB = WS_BIG + 170 * MiB;
constexpr size_t WS_VB = WS_BIG + 179 * MiB;
constexpr size_t WS_HT = WS_BIG + 188 * MiB;
constexpr size_t WS_HTC = WS_BIG + 284 * MiB;
constexpr size_t WS_SPEC = WS_BIG + 290 * MiB;
constexpr size_t WS_SPECC = WS_BIG + 322 * MiB;
constexpr size_t WS_RGA = WS_BIG + 324 * MiB;
constexpr size_t WS_RGB = WS_BIG + 392 * MiB;
constexpr size_t WS_MIX = WS_BIG + 460 * MiB;
constexpr size_t WS_END = WS_END_MOE;
static_assert(WS_MIX + (size_t)M * 2048 <= WS_END && WS_HID + (size_t)HIDROWS * 512 <= WS_Y2, "ws map");
constexpr int CW_BAR = 4096;
constexpr int RING_OFF = 0, RING_BYTES = 131072;
constexpr int LDSCTL_OFF = RING_BYTES, MISC_OFF = LDSCTL_OFF + 320;
constexpr int LTILES_OFF = RING_BYTES + 1024;
constexpr int LDS_BYTES = 147456;
static_assert(LTILES_OFF + 1536 * 4 <= LDS_BYTES, "LDS map");

#define GAS __attribute__((address_space(1)))
#define LAS __attribute__((address_space(3)))
typedef unsigned short bf16;
typedef unsigned v4u __attribute__((ext_vector_type(4)));
typedef unsigned v2u __attribute__((ext_vector_type(2)));
typedef float f32x4 __attribute__((ext_vector_type(4)));
typedef float f32x2v __attribute__((ext_vector_type(2)));
typedef short bf16x8 __attribute__((ext_vector_type(8)));
typedef GAS unsigned gu32;
#define RLX_AGENT __ATOMIC_RELAXED, __HIP_MEMORY_SCOPE_AGENT
#define LDS_WAIT() asm volatile("s_waitcnt lgkmcnt(0)" ::: "memory")
#define VM_WAIT() asm volatile("s_waitcnt vmcnt(0)" ::: "memory")
__device__ __forceinline__ unsigned f2bf(float f) { unsigned u = __builtin_bit_cast(unsigned, f); return (u + 0x7fffu + ((u >> 16) & 1u)) >> 16; }
__device__ __forceinline__ unsigned pk2(float lo, float hi) { return f2bf(lo) | (f2bf(hi) << 16); }
__device__ __forceinline__ float bf2f(unsigned b) { return __builtin_bit_cast(float, b << 16); }
__device__ __forceinline__ float bflo(unsigned w) { return __builtin_bit_cast(float, w << 16); }
__device__ __forceinline__ float bfhi(unsigned w) { return __builtin_bit_cast(float, w & 0xffff0000u); }

#define XB_TMO      128
#define XB_XCNT(j)  (256  + 64 * (j))
#define XB_XSUB(j)  (1280 + 64 * (j))
#define XB_XGEN(j)  (2304 + 64 * (j))
#define XB_TOP      3328
#define XB_TOPGEN   3392
#define XCD_BAR_WORDS 3456
#define XB_SPIN_CAP (1u << 20)
__device__ __forceinline__ unsigned xb_ld(unsigned* p)              { return __hip_atomic_load(p, __ATOMIC_RELAXED, __HIP_MEMORY_SCOPE_AGENT); }
__device__ __forceinline__ unsigned xb_add(unsigned* p, unsigned v) { return __hip_atomic_fetch_add(p, v, __ATOMIC_RELAXED, __HIP_MEMORY_SCOPE_AGENT); }
__device__ __forceinline__ unsigned xb_xcc_id() { return (unsigned)__builtin_amdgcn_s_getreg((3 << 11) | 20) & 0xFu; }
#define XB_SPIN(cond, bar) do { unsigned _sp = 0; while (cond) { __builtin_amdgcn_s_sleep(1); \
    if ((++_sp & 255u) == 0u) { if (xb_ld(&(bar)[XB_TMO])) break; if (_sp > XB_SPIN_CAP) { atomicAdd(&(bar)[XB_TMO], 1u); break; } } } } while (0)
struct XcdBarrier { unsigned* bar; unsigned x; volatile LAS unsigned* st; };
__device__ __forceinline__ XcdBarrier xcd_barrier_post(unsigned* bar, volatile LAS unsigned* st) {
    XcdBarrier b; b.bar = bar; b.x = xb_xcc_id(); b.st = st;
    if (threadIdx.x == 0) (void)xb_add(&bar[XB_XCNT(b.x)], 1u);
    return b;
}
__device__ __forceinline__ void xcd_barrier_complete(unsigned* bar, unsigned x, unsigned& nloc, unsigned& nx) {
    const unsigned G = gridDim.x * gridDim.y * gridDim.z;
    unsigned sum, cnt, mine, sp = 0u;
    for (;;) {
        sum = 0u; cnt = 0u; mine = 0u;
#pragma unroll
        for (unsigned j = 0; j < 16; ++j) { const unsigned c = xb_ld(&bar[XB_XCNT(j)]); sum += c; cnt += (c > 0u) ? 1u : 0u; mine = (j == x) ? c : mine; }
        if (sum == G) break;
        __builtin_amdgcn_s_sleep(1);
        if ((++sp & 255u) == 0u) { if (xb_ld(&bar[XB_TMO])) break; if (sp > XB_SPIN_CAP) { atomicAdd(&bar[XB_TMO], 1u); break; } }
    }
    nloc = mine > 0u ? mine : 1u; nx = cnt > 0u ? cnt : 1u;
}
__device__ __forceinline__ void xcd_barrier(const XcdBarrier& b) {
    asm volatile("s_waitcnt vmcnt(0)" ::: "memory");
    __syncthreads();
    if (threadIdx.x == 0) {
        unsigned* bar = b.bar;
        __builtin_amdgcn_s_waitcnt(0);
        unsigned nloc = b.st[0], nx = b.st[1];
        if (nloc == 0u) { xcd_barrier_complete(bar, b.x, nloc, nx); b.st[0] = nloc; b.st[1] = nx; }
        const unsigned old = xb_add(&bar[XB_XSUB(b.x)], 1u);
        const unsigned gen = old / nloc;
        if (old + 1u == (gen + 1u) * nloc) {
            __builtin_amdgcn_fence(__ATOMIC_RELEASE, "agent");
            asm volatile("s_waitcnt vmcnt(0)" ::: "memory");
            const unsigned og = xb_add(&bar[XB_TOP], 1u);
            const unsigned tg = og / nx;
            if (og + 1u == (tg + 1u) * nx) xb_add(&bar[XB_TOPGEN], 1u);
            else XB_SPIN(xb_ld(&bar[XB_TOPGEN]) == tg, bar);
            __builtin_amdgcn_fence(__ATOMIC_ACQUIRE, "agent");
            xb_add(&bar[XB_XGEN(b.x)], 1u);
            asm volatile("s_waitcnt vmcnt(0)" ::: "memory");
        } else {
            XB_SPIN(xb_ld(&bar[XB_XGEN(b.x)]) == gen, bar);
            __builtin_amdgcn_fence(__ATOMIC_ACQUIRE, "agent");
            asm volatile("s_waitcnt vmcnt(0)" ::: "memory");
        }
    }
    __syncthreads();
}

struct Args { const float* in[N_IN]; float* out; unsigned char* ws; };
struct Frame {
    LAS unsigned char* lds; char* ldsg; volatile LAS unsigned* MISC; gu32* ctl; unsigned char* ws; float* out;
    int tid, lane, wave, vcu, G;
};
__device__ __forceinline__ Frame fresh(const Frame& F0) {
    Frame F = F0; int t = F0.tid; asm volatile("" : "+v"(t)); F.tid = t; F.lane = t & 63; F.wave = __builtin_amdgcn_readfirstlane(t >> 6);
    unsigned long long z = 0; asm volatile("" : "+s"(z)); F.ws = F0.ws + z; F.out = F0.out + z; return F;
}
__device__ __forceinline__ float wave_sum(float v) {
#pragma unroll
    for (int o = 1; o < 64; o <<= 1) v += __shfl_xor(v, o);
    return v;
}
__device__ __forceinline__ float sigmoidf_(float x) { return 1.0f / (1.0f + __expf(-x)); }
__device__ __forceinline__ float siluf_(float x) { return x / (1.0f + __expf(-x)); }
__device__ __forceinline__ const float* modv(const Frame& F, int l, int r, int k) { return (const float*)(F.ws + WS_MODV) + ((size_t)(l * 9 + r) * 6 + k) * 1024; }
__device__ __forceinline__ int modrow_of(int R) { return R < ML ? (R >> 12) : 8; }
__device__ __forceinline__ void transpose_item(const float* W, int N, bf16* WT, int Kdst, int k0, int n0, int drow0, LAS float* scr, int lane) {
#pragma unroll 8
    for (int i = 0; i < 32; ++i) { const int kk = 2 * i + (lane >> 5); scr[kk * 33 + (lane & 31)] = W[(size_t)(k0 + kk) * N + n0 + (lane & 31)]; }
    LDS_WAIT(); asm volatile("" ::: "memory");
    const int c = lane & 7;
#pragma unroll
    for (int j = 0; j < 4; ++j) { const int n = (lane >> 3) + 8 * j; const LAS float* s = scr + (8 * c) * 33 + n;
        v4u o; o.x = pk2(s[0 * 33], s[1 * 33]); o.y = pk2(s[2 * 33], s[3 * 33]); o.z = pk2(s[4 * 33], s[5 * 33]); o.w = pk2(s[6 * 33], s[7 * 33]);
        *(GAS v4u*)(WT + (size_t)(drow0 + n) * Kdst + k0 + 8 * c) = o; }
    LDS_WAIT(); asm volatile("" ::: "memory");
}

__device__ __forceinline__ void phase_prologue_a(Frame& F0, const Args& A) {
    Frame F = fresh(F0);
    const int gw = F.vcu * NWAVES + F.wave, NGW = F.G * NWAVES;
    const int gt = F.vcu * 512 + F.tid, NGT = F.G * 512;
    {
        LAS float* sc = (LAS float*)(F.lds);
        LAS float* red = (LAS float*)(F.lds + 40960);
        for (int i = F.tid; i < 9 * 1024; i += 512) { const int r = i >> 10, k = i & 1023; const float v = r < 8 ? A.in[I_C][r * 1024 + k] : A.in[I_CCTX][k]; sc[i] = siluf_(v); }
        __syncthreads();
        const int col = F.tid & 31, ks = F.tid >> 5;
        for (int u = F.vcu; u < 4 * 192; u += F.G) {
            const int l = u / 192, j0 = (u % 192) * 32;
            const float* W = A.in[I_WMOD] + (size_t)l * 1024 * 6144 + j0 + col;
            float acc[9];
#pragma unroll
            for (int r = 0; r < 9; ++r) acc[r] = 0.f;
#pragma unroll 4
            for (int kk = 0; kk < 64; ++kk) { const int k = ks * 64 + kk; const float w = W[(size_t)k * 6144];
#pragma unroll
                for (int r = 0; r < 9; ++r) acc[r] += sc[r * 1024 + k] * w; }
#pragma unroll
            for (int r = 0; r < 9; ++r) red[(ks * 9 + r) * 32 + col] = acc[r];
            __syncthreads();
            if (F.tid < 288) { const int r = F.tid >> 5, c = F.tid & 31; float s = A.in[I_BMOD][l * 6144 + j0 + c];
#pragma unroll
                for (int q = 0; q < 16; ++q) s += red[(q * 9 + r) * 32 + c];
                ((float*)(F.ws + WS_MODV))[((size_t)(l * 9 + r)) * 6144 + j0 + c] = s; }
            __syncthreads();
        }
    }
    {
        LAS float* scr = (LAS float*)(F.lds + F.wave * 16384);
        constexpr int I_IN = (D / 64) * (PROJ / 32), I_OUT = (D / 64) * (D / 32);
        for (int it = gw; it < DEPTH * (I_IN + I_OUT); it += NGW) {
            const int l = it / (I_IN + I_OUT); int r = it % (I_IN + I_OUT);
            if (r < I_IN) { const int kb = r / (PROJ / 32), nb = r % (PROJ / 32);
                transpose_item(A.in[I_WIN] + (size_t)l * D * PROJ, PROJ, (bf16*)(F.ws + WS_WIN) + (size_t)l * PROJ * D, D, kb * 64, nb * 32, nb * 32, scr, F.lane); }
            else { r -= I_IN; const int kb = r / (D / 32), nb = r % (D / 32);
                transpose_item(A.in[I_WOUT] + (size_t)l * D * D, D, (bf16*)(F.ws + WS_WOUT) + (size_t)l * D * D, D, kb * 64, nb * 32, nb * 32, scr, F.lane); }
        }
    }
    for (int i = gt; i < DEPTH * NEXP * D; i += NGT) { const int l = i >> 16, e = (i >> 10) & 63, k = i & 1023;
        const float v = A.in[I_WR][((size_t)l * D + k) * NEXP + e]; const unsigned h = f2bf(v); const float lo = v - bf2f(h);
        ((bf16*)(F.ws + WS_RTHI))[i] = (bf16)h; ((bf16*)(F.ws + WS_RTLO))[i] = (bf16)f2bf(lo); }
    for (int i = gt; i < DEPTH * 2 * 2 * 4 * 64 * 64; i += NGT) { const int k = i & 63, n = (i >> 6) & 63, blk = (i >> 12) & 3, gate = (i >> 14) & 1, d = (i >> 15) & 1, l = i >> 16;
        const float* src = gate ? A.in[I_RGWX] : A.in[I_RGWA];
        ((bf16*)(F.ws + WS_RGW))[i] = (bf16)f2bf(src[((((size_t)l * 2 + d) * 4 + blk) * 64 + k) * 64 + n]); }
    for (int i = gt; i < 4096; i += NGT) { float s, c; sincospif(-(float)i * (1.0f / 4096.0f), &s, &c); ((f32x2v*)(F.ws + WS_TW))[i] = (f32x2v){c, s}; }
    for (int i = gt; i < T * 32; i += NGT) { const int t = i >> 5, p = i & 31; const float pos = (float)(p < 16 ? (t >> 6) : (t & 63));
        const float invf = powf(10000.0f, -(float)(p & 15) * (1.0f / 16.0f)); const float ang = pos * invf; float s, c; sincosf(ang, &s, &c); ((f32x2v*)(F.ws + WS_ROPE))[i] = (f32x2v){c, s}; }
}

__device__ __forceinline__ void modulate_row_bf16(const Frame& F, const float* hrow, const float* sh, const float* sc, bf16* orow) {
    const GAS f32x4* xr = (const GAS f32x4*)hrow + F.lane; const f32x4* shv = (const f32x4*)sh + F.lane; const f32x4* scv = (const f32x4*)sc + F.lane;
    GAS v2u* o8 = (GAS v2u*)orow + F.lane;
#pragma unroll
    for (int j = 0; j < 4; ++j) { const f32x4 v = xr[64 * j], a = shv[64 * j], b = scv[64 * j]; const f32x4 y = v * (b + 1.0f) + a; v2u o; o.x = pk2(y.x, y.y); o.y = pk2(y.z, y.w); o8[64 * j] = o; }
}
__device__ __forceinline__ void phase_prologue_b(Frame& F0, const Args& A) {
    Frame F = fresh(F0);
    const int gw = F.vcu * NWAVES + F.wave, NGW = F.G * NWAVES;
    for (int R = gw; R < M; R += NGW) { const int mr = modrow_of(R);
        const float* src = R < ML ? A.in[I_X] + (size_t)R * D : A.in[I_CTX] + (size_t)(R - ML) * D;
        modulate_row_bf16(F, src, modv(F, 0, mr, 0), modv(F, 0, mr, 1), (bf16*)(F.ws + WS_ABUF) + (size_t)R * D); }
}

__device__ __forceinline__ void phase_prep(Frame& F0, const Args& A, int l, bool do_moe, bool do_hy) {
    Frame F = fresh(F0);
    const int gw = F.vcu * NWAVES + F.wave, NGW = F.G * NWAVES;
    if (do_moe) {
        LAS float* scr = (LAS float*)(F.lds + F.wave * 16384);
        bf16* WGU = (bf16*)(F.ws + WS_WGU); bf16* WDN = (bf16*)(F.ws + WS_WDN);
        for (int it = gw; it < 65 * 384; it += NGW) {
            const int e = it / 384; int r = it % 384;
            const int which = r >> 7; r &= 127;
            if (which < 2) { const float* W = e < 64 ? (which == 0 ? A.in[I_WG] : A.in[I_WU]) + ((size_t)l * 64 + e) * (D * FF) : (which == 0 ? A.in[I_WSG] : A.in[I_WSU]) + (size_t)l * (D * FF);
                const int kb = r >> 3, nb = r & 7, n0 = nb * 32;
                transpose_item(W, FF, WGU + (size_t)e * 512 * D, D, kb * 64, n0, (n0 >> 7) * 256 + which * 128 + (n0 & 127), scr, F.lane); }
            else { const float* W = e < 64 ? A.in[I_WD] + ((size_t)l * 64 + e) * (FF * D) : A.in[I_WSD] + (size_t)l * (FF * D);
                const int kb = r >> 5, nb = r & 31;
                transpose_item(W, D, WDN + (size_t)e * D * FF, FF, kb * 64, nb * 32, nb * 32, scr, F.lane); }
        }
    }
    if (do_hy) {
        __syncthreads();
        LAS float* zb = (LAS float*)F.lds;
        LAS float* f1 = (LAS float*)(F.lds + 2048);
        LAS float* f2 = (LAS float*)(F.lds + 8192);
        const float* w1 = A.in[I_HYW1] + (size_t)l * 17 * 64; const float* b1 = A.in[I_HYB1] + l * 64; const float* fq = A.in[I_HYFREQ] + l * 64;
        const float* w2 = A.in[I_HYW2] + (size_t)l * 64 * 64; const float* b2 = A.in[I_HYB2] + l * 64; const float* w3 = A.in[I_HYW3] + (size_t)l * 64 * 1024;
        const int nun = 256 + (l < DEPTH - 1 ? 16 : 0);
        for (int u = F.vcu; u < nun; u += F.G) {
            const bool lat = u < 256; const int L = lat ? T : LC; const int n0 = (lat ? u : u - 256) * 16;
            float* FT = (float*)(F.ws + (lat ? WS_FILT : WS_FILTC));
            if (F.tid < 16 * 17) { const int p = F.tid / 17, i = F.tid % 17; const int n = n0 + p; float z;
                if (i == 0) z = (float)n / (float)(L - 1);
                else { const int bi = (i - 1) & 7; const float band = 1e-4f + (float)bi * ((7.0f - 1e-4f) / 7.0f); const float w = 6.283185307179586f * (float)n / (float)L; const float a = band * w;
                    z = (i <= 8) ? cosf(a) : -sinf(a); }
                zb[p * 17 + i] = z; }
            __syncthreads();
            for (int o = F.tid; o < 16 * 64; o += 512) { const int p = o >> 6, j = o & 63; float s = b1[j];
#pragma unroll
                for (int i = 0; i < 17; ++i) s += zb[p * 17 + i] * w1[i * 64 + j];
                f1[o] = sinf(fq[j] * s); }
            __syncthreads();
            for (int o = F.tid; o < 16 * 64; o += 512) { const int p = o >> 6, j = o & 63; float s = b2[j];
#pragma unroll 8
                for (int i = 0; i < 64; ++i) s += f1[p * 64 + i] * w2[i * 64 + j];
                f2[o] = sinf(fq[j] * s); }
            __syncthreads();
#pragma unroll
            for (int cc = 0; cc < 2; ++cc) { const int col = F.tid + cc * 512; float acc[16];
#pragma unroll
                for (int p = 0; p < 16; ++p) acc[p] = 0.f;
                for (int k = 0; k < 64; ++k) { const float w = w3[k * 1024 + col];
#pragma unroll
                    for (int p = 0; p < 16; ++p) acc[p] += f2[p * 64 + k] * w; }
                const int c = col & 255; const float delta = 3.0701134573253945f + (float)c * ((15.350567286626973f - 3.0701134573253945f) / 255.0f);
#pragma unroll
                for (int p4 = 0; p4 < 4; ++p4) { f32x4 o;
#pragma unroll
                    for (int q = 0; q < 4; ++q) { const int n = n0 + p4 * 4 + q; const float tt = (float)n / (float)(L - 1); o[q] = acc[p4 * 4 + q] * __expf(-tt * delta); }
                    *(f32x4*)(FT + (size_t)col * L + n0 + p4 * 4) = o; } }
            __syncthreads();
        }
    }
}
__device__ __forceinline__ void fft_dif(LAS f32x2v* X, const LAS f32x2v* tw, int s0, int tid) {
    for (int s = s0; s < 13; ++s) {
        const int lh = 12 - s, half = 1 << lh;
#pragma unroll
        for (int r = 0; r < 8; ++r) { const int u = tid + 512 * r, j = u & (half - 1), i0 = ((u >> lh) << (lh + 1)) + j, i1 = i0 + half;
            const f32x2v a = X[i0], b = X[i1], w = tw[j << s]; const f32x2v d = a - b;
            X[i0] = a + b; X[i1] = (f32x2v){d.x * w.x - d.y * w.y, d.x * w.y + d.y * w.x}; }
        __syncthreads();
    }
}
__device__ __forceinline__ void fft_dit_inv(LAS f32x2v* X, const LAS f32x2v* tw, int s0, int tid) {
    for (int s = 12; s >= s0; --s) {
        const int lh = 12 - s, half = 1 << lh;
#pragma unroll
        for (int r = 0; r < 8; ++r) { const int u = tid + 512 * r, j = u & (half - 1), i0 = ((u >> lh) << (lh + 1)) + j, i1 = i0 + half;
            const f32x2v a = X[i0], q = X[i1], w = tw[j << s]; const f32x2v b = (f32x2v){q.x * w.x + q.y * w.y, q.y * w.x - q.x * w.y};
            X[i0] = a + b; X[i1] = a - b; }
        __syncthreads();
    }
}
__device__ __forceinline__ void load_tw(Frame& F, LAS f32x2v* tw) { const f32x2v* g = (const f32x2v*)(F.ws + WS_TW); for (int i = F.tid; i < 4096; i += 512) tw[i] = g[i]; }

__device__ __forceinline__ void phase_spectra(Frame& F0, int l) {
    Frame F = fresh(F0);
    LAS f32x2v* X = (LAS f32x2v*)F.lds; LAS f32x2v* tw = (LAS f32x2v*)(F.lds + 65536);
    __syncthreads(); load_tw(F, tw);
    const int nun = 512 + (l < DEPTH - 1 ? 32 : 0);
    for (int u = F.vcu; u < nun; u += F.G) {
        const bool lat = u < 512; const int L = lat ? T : LC, lgN = lat ? 13 : 9, N = 2 * L; const int col0 = lat ? u : (u - 512) * 16;
        const float* FT = (const float*)(F.ws + (lat ? WS_FILT : WS_FILTC));
        __syncthreads();
#pragma unroll 4
        for (int r = 0; r < 16; ++r) { const int e = F.tid + 512 * r, seg = e >> lgN, n = e & (N - 1); const int oc = col0 + seg;
            float v = 0.f;
            if (n < L) v = FT[(size_t)oc * L + n]; else if (n > L) v = FT[(size_t)(512 + oc) * L + (N - n)];
            X[e] = (f32x2v){v, 0.f}; }
        __syncthreads();
        fft_dif(X, tw, 13 - lgN, F.tid);
        f32x2v* SP = (f32x2v*)(F.ws + (lat ? WS_SPEC : WS_SPECC)) + (size_t)col0 * N; const float sc = 1.0f / (float)N;
#pragma unroll 4
        for (int r = 0; r < 16; ++r) { const int e = F.tid + 512 * r; SP[e] = X[e] * sc; }
    }
    __syncthreads();
}

__device__ __forceinline__ void phase_hyconv(Frame& F0, const Args& A, int l) {
    Frame F = fresh(F0);
    LAS f32x2v* X = (LAS f32x2v*)F.lds; LAS f32x2v* tw = (LAS f32x2v*)(F.lds + 65536);
    __syncthreads(); load_tw(F, tw);
    const int nun = 1024 + (l < DEPTH - 1 ? 64 : 0);
    const float* skip = A.in[I_HYSKIP] + (size_t)l * 512;
    bf16* MIX = (bf16*)(F.ws + WS_MIX);
    for (int u = F.vcu; u < nun; u += F.G) {
        const bool lat = u < 1024; const int L = lat ? T : LC, lgN = lat ? 13 : 9, N = 2 * L;
        const int bp = lat ? (u >> 8) : ((u - 1024) >> 4), c0 = lat ? (u & 255) : ((u - 1024) & 15) * 16;
        float* H0 = (float*)(F.ws + (lat ? WS_HT : WS_HTC)) + (size_t)(2 * bp) * 768 * L; float* H1 = H0 + (size_t)768 * L;
        const f32x2v* SPb = (const f32x2v*)(F.ws + (lat ? WS_SPEC : WS_SPECC)) + (size_t)c0 * N;
        const int rowb = lat ? (2 * bp) * T : ML + (2 * bp) * LC;
        __syncthreads();
#pragma unroll 2
        for (int r = 0; r < 16; ++r) { const int e = F.tid + 512 * r, seg = e >> lgN, n = e & (N - 1); f32x2v v = (f32x2v){0.f, 0.f};
            if (n < L) { const size_t o = (size_t)(512 + c0 + seg) * L + n; v = (f32x2v){H0[o], H1[o]}; }
            X[e] = v; }
        __syncthreads();
#pragma unroll 1
        for (int ord = 0; ord < 2; ++ord) {
            fft_dif(X, tw, 13 - lgN, F.tid);
            const f32x2v* SP = SPb + (size_t)ord * 256 * N;
#pragma unroll 4
            for (int r = 0; r < 16; ++r) { const int e = F.tid + 512 * r; const f32x2v x = X[e], k = SP[e]; X[e] = (f32x2v){x.x * k.x - x.y * k.y, x.x * k.y + x.y * k.x}; }
            __syncthreads();
            fft_dit_inv(X, tw, 13 - lgN, F.tid);
#pragma unroll 2
            for (int r = 0; r < 16; ++r) { const int e = F.tid + 512 * r, seg = e >> lgN, n = e & (N - 1);
                f32x2v z = (f32x2v){0.f, 0.f};
                if (n < L) { const int c = c0 + seg; const size_t og = (size_t)(ord * 256 + c) * L + n, ov = (size_t)(512 + c) * L + n;
                    const f32x2v g = (f32x2v){H0[og], H1[og]}, zp = (f32x2v){H0[ov], H1[ov]}; const float sk = skip[ord * 256 + c];
                    z = g * (X[e] + zp * sk);
                    if (ord == 0) { H0[ov] = z.x; H1[ov] = z.y; }
                    else { const size_t row0 = (size_t)(rowb + n); MIX[row0 * 1024 + c] = (bf16)f2bf(z.x); MIX[(row0 + L) * 1024 + c] = (bf16)f2bf(z.y); } }
                if (ord == 0) X[e] = z; }
            __syncthreads();
        }
    }
}
__device__ __forceinline__ void phase_qkv_rows(Frame& F0, const Args& A, int l) {
    Frame F = fresh(F0);
    const int gw = F.vcu * NWAVES + F.wave, NGW = F.G * NWAVES, lane = F.lane;
    const bf16* P = (const bf16*)(F.ws + WS_P); bf16* QB = (bf16*)(F.ws + WS_QB); bf16* KB = (bf16*)(F.ws + WS_KB); bf16* VB = (bf16*)(F.ws + WS_VB);
    const float* qg = A.in[I_QN] + l * 64; const float* kg = A.in[I_KN] + l * 64; const f32x2v* rope = (const f32x2v*)(F.ws + WS_ROPE);
    const bool last = (l == DEPTH - 1);
    float qgl[8]; { const int d0 = (8 * lane) & 63;
#pragma unroll
        for (int j = 0; j < 8; ++j) qgl[j] = qg[d0 + j]; }
    const float kg0 = kg[(2 * lane) & 63], kg1 = kg[((2 * lane) & 63) + 1];
    for (int R = gw; R < M; R += NGW) {
        const bool lat = R < ML; const int b = lat ? (R >> 12) : ((R - ML) >> 8); const int t = lat ? (R & 4095) : ((R - ML) & 255);
        const bf16* pr = P + (size_t)R * PROJ;
        const long kvrow = (long)b * SKV + (lat ? t : T + t);
        { const unsigned kw = *(const unsigned*)(pr + C_K + 2 * lane), vw = *(const unsigned*)(pr + C_V + 2 * lane);
            float k0 = bflo(kw), k1 = bfhi(kw); float ss = k0 * k0 + k1 * k1;
#pragma unroll
            for (int o = 1; o < 32; o <<= 1) ss += __shfl_xor(ss, o);
            const float rs = 1.0f / sqrtf(ss * (1.0f / 64.0f) + QK_EPS); k0 = k0 * rs * kg0; k1 = k1 * rs * kg1;
            if (lat) { const f32x2v cs = rope[t * 32 + (lane & 31)]; const float r0 = k0 * cs.x - k1 * cs.y, r1 = k0 * cs.y + k1 * cs.x; k0 = r0; k1 = r1; }
            *(unsigned*)(KB + kvrow * 128 + 2 * lane) = pk2(k0, k1); *(unsigned*)(VB + kvrow * 128 + 2 * lane) = vw; }
        if (lat || !last) { const v4u qw = *(const v4u*)(pr + C_Q + 8 * lane); float q[8];
            q[0] = bflo(qw.x); q[1] = bfhi(qw.x); q[2] = bflo(qw.y); q[3] = bfhi(qw.y); q[4] = bflo(qw.z); q[5] = bfhi(qw.z); q[6] = bflo(qw.w); q[7] = bfhi(qw.w);
            float ss = 0.f;
#pragma unroll
            for (int j = 0; j < 8; ++j) ss += q[j] * q[j];
            ss += __shfl_xor(ss, 1); ss += __shfl_xor(ss, 2); ss += __shfl_xor(ss, 4);
            const float rs = 1.0f / sqrtf(ss * (1.0f / 64.0f) + QK_EPS);
#pragma unroll
            for (int j = 0; j < 8; ++j) q[j] = q[j] * rs * qgl[j];
            if (lat) { const int p0 = (4 * lane) & 31;
#pragma unroll
                for (int j = 0; j < 4; ++j) { const f32x2v cs = rope[t * 32 + p0 + j]; const float r0 = q[2 * j] * cs.x - q[2 * j + 1] * cs.y, r1 = q[2 * j] * cs.y + q[2 * j + 1] * cs.x; q[2 * j] = r0; q[2 * j + 1] = r1; } }
            constexpr float C2 = 0.125f * 1.4426950408889634f;
            v4u o; o.x = pk2(q[0] * C2, q[1] * C2); o.y = pk2(q[2] * C2, q[3] * C2); o.z = pk2(q[4] * C2, q[5] * C2); o.w = pk2(q[6] * C2, q[7] * C2);
            *(v4u*)(QB + (size_t)R * 512 + 8 * lane) = o; }
    }
}

__device__ __forceinline__ void phase_hy_short(Frame& F0, const Args& A, int l) {
    Frame F = fresh(F0);
    const int gw = F.vcu * NWAVES + F.wave, NGW = F.G * NWAVES, lane = F.lane;
    LAS float* scr = (LAS float*)(F.lds + F.wave * 16384);
    const bf16* P = (const bf16*)(F.ws + WS_P);
    const float* sw = A.in[I_HYSW] + (size_t)l * 3 * 768; const float* sb = A.in[I_HYSB] + (size_t)l * 768;
    const int nlat = NB * 64 * 24, nctx = (l < DEPTH - 1) ? NB * 4 * 24 : 0;
    __syncthreads();
    for (int it = gw; it < nlat + nctx; it += NGW) {
        const bool lat = it < nlat; const int r = lat ? it : it - nlat; const int cb = r % 24; const int tb = (r / 24) % (lat ? 64 : 4); const int b = r / (24 * (lat ? 64 : 4));
        const int L = lat ? T : LC, t0 = tb * 64, c0 = cb * 32; const size_t row0 = lat ? (size_t)b * T : (size_t)ML + (size_t)b * LC;
        for (int rr = lane >> 4; rr < 66; rr += 4) { const int t = t0 - 1 + rr; float v0 = 0.f, v1 = 0.f;
            if (t >= 0 && t < L) { const unsigned w = *(const unsigned*)(P + (row0 + t) * PROJ + C_HY + c0 + 2 * (lane & 15)); v0 = bflo(w); v1 = bfhi(w); }
            scr[rr * 33 + 2 * (lane & 15)] = v0; scr[rr * 33 + 2 * (lane & 15) + 1] = v1; }
        LDS_WAIT(); asm volatile("" ::: "memory");
        float* HT = (float*)(F.ws + (lat ? WS_HT : WS_HTC)) + ((size_t)b * 768 + c0) * L + t0 + lane;
#pragma unroll 4
        for (int c = 0; c < 32; ++c) { const int ch = c0 + c; const float w0 = sw[ch], w1 = sw[768 + ch], w2 = sw[1536 + ch], bb = sb[ch];
            HT[(size_t)c * L] = scr[lane * 33 + c] * w0 + scr[(lane + 1) * 33 + c] * w1 + scr[(lane + 2) * 33 + c] * w2 + bb; }
        LDS_WAIT(); asm volatile("" ::: "memory");
    }
}

__device__ __forceinline__ void phase_rg_gates(Frame& F0, const Args& A, int l) {
    Frame F = fresh(F0);
    LAS float* U32 = (LAS float*)F.lds;
    LAS bf16* UB = (LAS bf16*)(F.lds + 65536);
    const bf16* P = (const bf16*)(F.ws + WS_P);
    const float* cw = A.in[I_RGCW] + (size_t)l * 4 * 256; const float* cb = A.in[I_RGCB] + (size_t)l * 256;
    const int lane = F.lane, wave = F.wave, d = wave >> 2, blk = wave & 3;
    const bf16* Wg = (const bf16*)(F.ws + WS_RGW) + ((size_t)(l * 2 + d) * 2) * 4 * 4096;
    const float* lam = A.in[I_RGLAM] + (size_t)(l * 2 + d) * 256; const float* ba = A.in[I_RGBA] + (size_t)(l * 2 + d) * 256; const float* bx = A.in[I_RGBX] + (size_t)(l * 2 + d) * 256;
    float* RGA = (float*)(F.ws + WS_RGA) + (size_t)d * M * 256; float* RGB = (float*)(F.ws + WS_RGB) + (size_t)d * M * 256;
    const int fr = lane & 15, fq = lane >> 4;
    for (int u = F.vcu; u < M / 64; u += F.G) {
        const int R0 = u * 64; const bool lat = R0 < ML; const int L = lat ? T : LC; const int t0 = lat ? (R0 & 4095) : ((R0 - ML) & 255);
        __syncthreads();
        { const int tok = F.tid >> 3, cg = (F.tid & 7) * 32; const int t = t0 + tok;
#pragma unroll
            for (int c8 = 0; c8 < 4; ++c8) { const int ch = cg + c8 * 8; float acc[8];
#pragma unroll
                for (int j = 0; j < 8; ++j) acc[j] = cb[ch + j];
#pragma unroll
                for (int tap = 0; tap < 4; ++tap) { const int tt = t - 1 + tap;
                    if (tt >= 0 && tt < L) { const v4u w = *(const v4u*)(P + (size_t)(R0 + tok - 1 + tap) * PROJ + C_RGX + ch); const float* cwp = cw + tap * 256 + ch;
                        acc[0] += bflo(w.x) * cwp[0]; acc[1] += bfhi(w.x) * cwp[1]; acc[2] += bflo(w.y) * cwp[2]; acc[3] += bfhi(w.y) * cwp[3];
                        acc[4] += bflo(w.z) * cwp[4]; acc[5] += bfhi(w.z) * cwp[5]; acc[6] += bflo(w.w) * cwp[6]; acc[7] += bfhi(w.w) * cwp[7]; } }
                *(LAS f32x4*)(U32 + tok * 256 + ch) = (f32x4){acc[0], acc[1], acc[2], acc[3]}; *(LAS f32x4*)(U32 + tok * 256 + ch + 4) = (f32x4){acc[4], acc[5], acc[6], acc[7]};
                v4u o; o.x = pk2(acc[0], acc[1]); o.y = pk2(acc[2], acc[3]); o.z = pk2(acc[4], acc[5]); o.w = pk2(acc[6], acc[7]);
                *(LAS v4u*)(UB + tok * 264 + ch) = o; } }
        __syncthreads();
#pragma unroll 1
        for (int tgp = 0; tgp < 2; ++tgp) {
            f32x4 aa[2][4], ax[2][4];
#pragma unroll
            for (int tg = 0; tg < 2; ++tg)
#pragma unroll
                for (int ng = 0; ng < 4; ++ng) { aa[tg][ng] = (f32x4){0.f, 0.f, 0.f, 0.f}; ax[tg][ng] = (f32x4){0.f, 0.f, 0.f, 0.f}; }
#pragma unroll
            for (int kk = 0; kk < 2; ++kk) { bf16x8 uf[2];
#pragma unroll
                for (int tg = 0; tg < 2; ++tg) uf[tg] = *(const LAS bf16x8*)(UB + ((tgp * 2 + tg) * 16 + fr) * 264 + blk * 64 + kk * 32 + fq * 8);
#pragma unroll
                for (int ng = 0; ng < 4; ++ng) { const bf16x8 wa = *(const bf16x8*)(Wg + ((size_t)(0 * 4 + blk) * 64 + ng * 16 + fr) * 64 + kk * 32 + fq * 8);
                    const bf16x8 wx = *(const bf16x8*)(Wg + ((size_t)(1 * 4 + blk) * 64 + ng * 16 + fr) * 64 + kk * 32 + fq * 8);
#pragma unroll
                    for (int tg = 0; tg < 2; ++tg) { aa[tg][ng] = __builtin_amdgcn_mfma_f32_16x16x32_bf16(wa, uf[tg], aa[tg][ng], 0, 0, 0); ax[tg][ng] = __builtin_amdgcn_mfma_f32_16x16x32_bf16(wx, uf[tg], ax[tg][ng], 0, 0, 0); } } }
#pragma unroll
            for (int ng = 0; ng < 4; ++ng) { const int ch = blk * 64 + ng * 16 + fq * 4; const f32x4 lv = *(const f32x4*)(lam + ch), bav = *(const f32x4*)(ba + ch), bxv = *(const f32x4*)(bx + ch);
                f32x4 sp;
#pragma unroll
                for (int j = 0; j < 4; ++j) { const float x = -lv[j]; sp[j] = fmaxf(x, 0.f) + log1pf(__expf(-fabsf(x))); }
#pragma unroll
                for (int tg = 0; tg < 2; ++tg) { const int tok = (tgp * 2 + tg) * 16 + fr; const f32x4 uv = *(const LAS f32x4*)(U32 + tok * 256 + ch); f32x4 av, bv;
#pragma unroll
                    for (int j = 0; j < 4; ++j) { const float r = sigmoidf_(aa[tg][ng][j] + bav[j]), ig = sigmoidf_(ax[tg][ng][j] + bxv[j]); const float la = -8.0f * r * sp[j];
                        av[j] = __expf(la); bv[j] = sqrtf(-expm1f(2.0f * la)) * (ig * uv[j]); }
                    *(f32x4*)(RGA + (size_t)(R0 + tok) * 256 + ch) = av; *(f32x4*)(RGB + (size_t)(R0 + tok) * 256 + ch) = bv; } }
        }
    }
    __syncthreads();
}

__device__ __forceinline__ int rg_row(int b, int dir, int q) { return q < LC ? ML + b * LC + (dir ? (LC - 1 - q) : q) : b * T + (dir ? (T - 1 - (q - LC)) : (q - LC)); }
__device__ __forceinline__ void phase_rg_scan(Frame& F0, int l) {
    Frame F = fresh(F0);
    LAS f32x2v* carry = (LAS f32x2v*)F.lds;
    const bool last = (l == DEPTH - 1);
    const int dir = F.tid >> 8, seg = (F.tid >> 3) & 31, chl = F.tid & 7;
    const bf16* P = (const bf16*)(F.ws + WS_P); bf16* MIX = (bf16*)(F.ws + WS_MIX);
    for (int u = F.vcu; u < NB * 32; u += F.G) {
        const int b = u >> 5, ch = (u & 31) * 8 + chl;
        float* RA = (float*)(F.ws + WS_RGA) + (size_t)dir * M * 256 + ch; const float* RB = (const float*)(F.ws + WS_RGB) + (size_t)dir * M * 256 + ch;
        __syncthreads();
        float Ap = 1.f, Bv = 0.f; const int q0 = seg * 136;
        for (int i = 0; i < 136; i += 8) { float av[8], bv[8];
#pragma unroll
            for (int j = 0; j < 8; ++j) { const size_t o = (size_t)rg_row(b, dir, q0 + i + j) * 256; av[j] = RA[o]; bv[j] = RB[o]; }
#pragma unroll
            for (int j = 0; j < 8; ++j) { Bv = av[j] * Bv + bv[j]; Ap *= av[j]; } }
        carry[(dir * 32 + seg) * 8 + chl] = (f32x2v){Ap, Bv};
        __syncthreads();
        float h = 0.f;
        for (int s = 0; s < seg; ++s) { const f32x2v cv = carry[(dir * 32 + s) * 8 + chl]; h = cv.x * h + cv.y; }
        for (int i = 0; i < 136; i += 8) { float av[8], bv[8]; size_t o[8];
#pragma unroll
            for (int j = 0; j < 8; ++j) { o[j] = (size_t)rg_row(b, dir, q0 + i + j) * 256; av[j] = RA[o[j]]; bv[j] = RB[o[j]]; }
#pragma unroll
            for (int j = 0; j < 8; ++j) { h = av[j] * h + bv[j]; RA[o[j]] = h; } }
        VM_WAIT(); __syncthreads();
        const float* H0 = (const float*)(F.ws + WS_RGA); const float* H1 = H0 + (size_t)M * 256; const int c8 = (u & 31) * 8;
        for (int q = F.tid >> 1; q < SKV; q += 256) { if (last && q < LC) continue;
            const int R = rg_row(b, 0, q); const int c4 = c8 + (F.tid & 1) * 4; const f32x4 hf = *(const f32x4*)(H0 + (size_t)R * 256 + c4), hr = *(const f32x4*)(H1 + (size_t)R * 256 + c4);
            const v2u gw = *(const v2u*)(P + (size_t)R * PROJ + C_RGG + c4); float g[4] = {bflo(gw.x), bfhi(gw.x), bflo(gw.y), bfhi(gw.y)}; float y[4];
#pragma unroll
            for (int j = 0; j < 4; ++j) { const float x = g[j]; const float tt = tanhf(0.7978845608028654f * (x + 0.044715f * x * x * x)); y[j] = (hf[j] + hr[j]) * 0.5f * x * (1.0f + tt); }
            v2u o; o.x = pk2(y[0], y[1]); o.y = pk2(y[2], y[3]); *(v2u*)(MIX + (size_t)R * 1024 + 768 + c4) = o; }
    }
    __syncthreads();
}

__device__ __forceinline__ void phase_attention(Frame& F0, int l) {
    Frame F = fresh(F0);
    const attn_body::bf16* Q = (const attn_body::bf16*)(F.ws + WS_QB); const attn_body::bf16* K = (const attn_body::bf16*)(F.ws + WS_KB); const attn_body::bf16* V = (const attn_body::bf16*)(F.ws + WS_VB);
    attn_body::bf16* O = (attn_body::bf16*)(F.ws + WS_MIX);
    char* shm = F.ldsg;
    for (int v = F.vcu; v < 256; v += F.G) { const int pair = v >> 4, qb = v & 15, b = pair >> 1, kvh = pair & 1;
        for (int g = 0; g < 4; ++g) { const int h = kvh * 4 + g;
            attn_body::attn_unit<8>((long)b * T + qb * 256, h * 64, (long)b * SKV, kvh * 64, SKV / 64, (long)b * T + qb * 256, 256 + h * 64, Q, K, V, O, shm); } }
    if (l < DEPTH - 1) for (int v = F.vcu; v < 64; v += F.G) { const int b = v >> 3, h = v & 7;
        attn_body::attn_unit<8>((long)ML + b * LC, h * 64, (long)b * SKV + T, (h >> 2) * 64, LC / 64, (long)ML + b * LC, 256 + h * 64, Q, K, V, O, shm); }
}
__device__ __forceinline__ float* hrow_ptr(const Frame& F, int R) { return R < ML ? F.out + (size_t)R * D : (float*)(F.ws + WS_HC) + (size_t)(R - ML) * D; }

__device__ __forceinline__ void phase_ln1(Frame& F0, const Args& A, int l, bool v_from_h) {
    Frame F = fresh(F0);
    const bool last = (l == DEPTH - 1); const int ngroups = (last ? ML : M) / 16;
    LAS bf16* MH = (LAS bf16*)F.lds;
    LAS bf16* MLo = (LAS bf16*)(F.lds + 33024);
    LAS float* PL = (LAS float*)(F.lds + 66048);
    LAS float* LOG = (LAS float*)(F.lds + 66048 + 32768);
    LAS int* lhist = (LAS int*)(F.lds + 66048 + 32768 + 4096);
    const int lane = F.lane, wave = F.wave, fr = lane & 15, fq = lane >> 4;
    const float* lg = A.in[I_LN1G] + l * D; const float* lb = A.in[I_LN1B] + l * D; const float* brt = A.in[I_BR] + l * NEXP;
    const bf16* RH = (const bf16*)(F.ws + WS_RTHI) + (size_t)l * NEXP * D; const bf16* RL = (const bf16*)(F.ws + WS_RTLO) + (size_t)l * NEXP * D;
    int* IDX = (int*)(F.ws + WS_IDX); float* WT = (float*)(F.ws + WS_WT); bf16* ABUF = (bf16*)(F.ws + WS_ABUF);
    __syncthreads();
    if (F.tid < 64) lhist[F.tid] = 0;
    f32x4 gv[4], bv[4];
#pragma unroll
    for (int j = 0; j < 4; ++j) { gv[j] = *(const f32x4*)(lg + 4 * lane + 256 * j); bv[j] = *(const f32x4*)(lb + 4 * lane + 256 * j); }
    for (int g = F.vcu; g < ngroups; g += F.G) {
        __syncthreads();
#pragma unroll
        for (int rr = 0; rr < 2; ++rr) { const int tok = 2 * wave + rr, R = g * 16 + tok; const int mr = modrow_of(R);
            float* hp = hrow_ptr(F, R); const float* vp = hp; float vs = 1.0f;
            if (v_from_h) { vs = DN_ALPHA; if (l == 0) vp = R < ML ? A.in[I_X] + (size_t)R * D : A.in[I_CTX] + (size_t)(R - ML) * D; }
            f32x4 v[4]; float s = 0.f;
#pragma unroll
            for (int j = 0; j < 4; ++j) { v[j] = *(const f32x4*)(vp + 4 * lane + 256 * j) * vs; s += (v[j].x + v[j].y) + (v[j].z + v[j].w); }
            const float mean = wave_sum(s) * (1.f / D); float s2 = 0.f;
#pragma unroll
            for (int j = 0; j < 4; ++j) { v[j] = v[j] - mean; s2 += (v[j].x * v[j].x + v[j].y * v[j].y) + (v[j].z * v[j].z + v[j].w * v[j].w); }
            const float rstd = 1.f / sqrtf(wave_sum(s2) * (1.f / D) + LN_EPS);
            const float* sh2 = modv(F, l, mr, 3); const float* sc2 = modv(F, l, mr, 4);
#pragma unroll
            for (int j = 0; j < 4; ++j) { const f32x4 h = v[j] * rstd * gv[j] + bv[j]; *(f32x4*)(hp + 4 * lane + 256 * j) = h;
                const f32x4 m = h * (*(const f32x4*)(sc2 + 4 * lane + 256 * j) + 1.0f) + *(const f32x4*)(sh2 + 4 * lane + 256 * j);
                const unsigned h0 = f2bf(m.x), h1 = f2bf(m.y), h2 = f2bf(m.z), h3 = f2bf(m.w);
                v2u hi; hi.x = h0 | (h1 << 16); hi.y = h2 | (h3 << 16);
                v2u lo; lo.x = pk2(m.x - bf2f(h0), m.y - bf2f(h1)); lo.y = pk2(m.z - bf2f(h2), m.w - bf2f(h3));
                *(v2u*)(ABUF + (size_t)R * D + 4 * lane + 256 * j) = hi;
                *(LAS v2u*)(MH + tok * 1032 + 4 * lane + 256 * j) = hi; *(LAS v2u*)(MLo + tok * 1032 + 4 * lane + 256 * j) = lo; } }
        __syncthreads();
        f32x4 acc[4];
#pragma unroll
        for (int eg = 0; eg < 4; ++eg) acc[eg] = (f32x4){0.f, 0.f, 0.f, 0.f};
#pragma unroll
        for (int kk = 0; kk < 4; ++kk) { const int k0 = wave * 128 + kk * 32 + fq * 8;
            const bf16x8 ah = *(const LAS bf16x8*)(MH + fr * 1032 + k0), al = *(const LAS bf16x8*)(MLo + fr * 1032 + k0);
#pragma unroll
            for (int eg = 0; eg < 4; ++eg) { const bf16x8 wh = *(const bf16x8*)(RH + (size_t)(eg * 16 + fr) * D + k0), wl = *(const bf16x8*)(RL + (size_t)(eg * 16 + fr) * D + k0);
                acc[eg] = __builtin_amdgcn_mfma_f32_16x16x32_bf16(wh, ah, acc[eg], 0, 0, 0);
                acc[eg] = __builtin_amdgcn_mfma_f32_16x16x32_bf16(wl, ah, acc[eg], 0, 0, 0);
                acc[eg] = __builtin_amdgcn_mfma_f32_16x16x32_bf16(wh, al, acc[eg], 0, 0, 0); } }
#pragma unroll
        for (int eg = 0; eg < 4; ++eg) *(LAS f32x4*)(PL + (wave * 16 + fr) * 64 + eg * 16 + fq * 4) = acc[eg];
        __syncthreads();
        { const int o = F.tid * 2; float s0 = 0.f, s1 = 0.f;
#pragma unroll
            for (int w = 0; w < 8; ++w) { const f32x2v p = *(const LAS f32x2v*)(PL + w * 1024 + o); s0 += p.x; s1 += p.y; }
            *(LAS f32x2v*)(LOG + o) = (f32x2v){s0, s1}; }
        __syncthreads();
#pragma unroll
        for (int rr = 0; rr < 2; ++rr) { const int tok = 2 * wave + rr, R = g * 16 + tok;
            const float score = 1.0f / (1.0f + expf(-LOG[tok * 64 + lane])); float key = score + brt[lane];
            int my_e = 0; float my_s = 0.f, ssum = 0.f;
#pragma unroll
            for (int r = 0; r < 8; ++r) { float bk = key; int bi = lane;
#pragma unroll
                for (int o = 1; o < 64; o <<= 1) { const float ok = __shfl_xor(bk, o); const int oi = __shfl_xor(bi, o); if (ok > bk || (ok == bk && oi < bi)) { bk = ok; bi = oi; } }
                const float ws = __shfl(score, bi); ssum += ws; if (lane == r) { my_e = bi; my_s = ws; } if (lane == bi) key = -INFINITY; }
            if (lane < 8) { IDX[(size_t)R * 8 + lane] = my_e; WT[(size_t)R * 8 + lane] = my_s / ssum * ROUTED_SCALE; atomicAdd((int*)&lhist[my_e], 1); } }
    }
    __syncthreads();
    if (F.tid < 64) ((int*)(F.ws + WS_HIST))[F.vcu * 64 + F.tid] = lhist[F.tid];
}

__device__ __forceinline__ void phase_sort(Frame& F0, int l) {
    Frame F = fresh(F0);
    const bool last = (l == DEPTH - 1); const int ngroups = (last ? ML : M) / 16;
    LAS int* pa = (LAS int*)F.lds;
    LAS int* pb = pa + 512;
    LAS int* tot = pb + 512;
    LAS int* mybase = tot + 64;
    LAS int* segbase = mybase + 64;
    LAS int* tpre = segbase + 80;
    LAS int* lcnt = tpre + 80;
    const int* HIST = (const int*)(F.ws + WS_HIST);
    __syncthreads();
    { const int e = F.tid & 63, part = F.tid >> 6; int sa = 0, sb = 0;
        for (int w = part * 32; w < part * 32 + 32; ++w) if (w < F.G) { const int h = HIST[w * 64 + e]; sa += h; if (w < F.vcu) sb += h; }
        pa[part * 64 + e] = sa; pb[part * 64 + e] = sb; }
    __syncthreads();
    if (F.tid < 64) { int sa = 0, sb = 0;
#pragma unroll
        for (int p = 0; p < 8; ++p) { sa += pa[p * 64 + F.tid]; sb += pb[p * 64 + F.tid]; }
        tot[F.tid] = sa; mybase[F.tid] = sb; lcnt[F.tid] = 0; }
    __syncthreads();
    if (F.tid == 0) { int s = 0, tp = 0; for (int e = 0; e < 64; ++e) { segbase[e] = s; tpre[e] = tp; const int nt = (tot[e] + 255) >> 8; s += nt * 256; tp += nt; }
        segbase[64] = s; tpre[64] = tp; tpre[65] = tp + (last ? ML : M) / 256; }
    __syncthreads();
    const int* IDX = (const int*)(F.ws + WS_IDX); const float* WT = (const float*)(F.ws + WS_WT);
    int* POS = (int*)(F.ws + WS_POS); int* STOK = (int*)(F.ws + WS_STOK); float* SWT = (float*)(F.ws + WS_SWT);
    const int mygroups = (ngroups - F.vcu + F.G - 1) / F.G;
    for (int idx = F.tid; idx < mygroups * 128; idx += 512) { const int gi = idx >> 7, w = idx & 127; const int R = (F.vcu + F.G * gi) * 16 + (w >> 3), k = w & 7;
        const int e = IDX[(size_t)R * 8 + k]; const int rank = atomicAdd((int*)&lcnt[e], 1); const int pos = segbase[e] + mybase[e] + rank;
        POS[(size_t)R * 8 + k] = pos; STOK[pos] = R; SWT[pos] = WT[(size_t)R * 8 + k]; }
    for (int e = F.vcu; e < 64; e += F.G) { const int lo = segbase[e] + tot[e], hi = segbase[e + 1]; for (int p = lo + F.tid; p < hi; p += 512) { STOK[p] = 0; SWT[p] = 0.f; } }
    if (F.vcu == 0) { unsigned* TL = (unsigned*)(F.ws + WS_TILES); const int ntot = tpre[65];
        for (int i = F.tid; i < ntot; i += 512) { int e = 0; while (e < 64 && i >= tpre[e + 1]) ++e;
            TL[i] = ((unsigned)e << 16) | (unsigned)(e < 64 ? (segbase[e] >> 8) + (i - tpre[e]) : (SH0 >> 8) + (i - tpre[64])); }
        if (F.tid == 0) TL[1536] = (unsigned)ntot; }
    __syncthreads();
}

__device__ __forceinline__ int load_tiles(Frame& F0) {
    Frame F = fresh(F0);
    const unsigned* TL = (const unsigned*)(F.ws + WS_TILES); LAS unsigned* LT = (LAS unsigned*)(F.lds + LTILES_OFF);
    __syncthreads();
    const int ntot = (int)__hip_atomic_load(TL + 1536, RLX_AGENT);
    for (int i = F.tid; i < ntot && i < 1536; i += 512) LT[i] = TL[i];
    __syncthreads();
    return __builtin_amdgcn_readfirstlane(ntot);
}

__device__ __forceinline__ void phase_ln2(Frame& F0, const Args& A, int l, bool have_moe) {
    Frame F = fresh(F0);
    const bool last = (l == DEPTH - 1); const int nrows = last ? ML : M;
    const int gw = F.vcu * NWAVES + F.wave, NGW = F.G * NWAVES, lane = F.lane;
    const float* lg = A.in[I_LN2G] + l * D; const float* lb = A.in[I_LN2B] + l * D;
    const bf16* Y2 = (const bf16*)(F.ws + WS_Y2); bf16* ABUF = (bf16*)(F.ws + WS_ABUF); const int* POS = (const int*)(F.ws + WS_POS);
    f32x4 gv[4], bv[4];
#pragma unroll
    for (int j = 0; j < 4; ++j) { gv[j] = *(const f32x4*)(lg + 4 * lane + 256 * j); bv[j] = *(const f32x4*)(lb + 4 * lane + 256 * j); }
    for (int R = gw; R < nrows; R += NGW) { const int mr = modrow_of(R);
        float* hp = hrow_ptr(F, R); const float* g2 = modv(F, l, mr, 5);
        f32x4 f[4];
#pragma unroll
        for (int j = 0; j < 4; ++j) f[j] = (f32x4){0.f, 0.f, 0.f, 0.f};
        if (have_moe) {
            { const bf16* yr = ABUF + (size_t)R * D;
#pragma unroll
                for (int j = 0; j < 4; ++j) { const v2u w = *(const v2u*)(yr + 4 * lane + 256 * j); f[j] += (f32x4){bflo(w.x), bfhi(w.x), bflo(w.y), bfhi(w.y)}; } }
            int pk = 0; if (lane < 8) pk = POS[(size_t)R * 8 + lane];
#pragma unroll
            for (int k = 0; k < 8; ++k) { const int p = __shfl(pk, k); const bf16* yr = Y2 + (size_t)p * D;
#pragma unroll
                for (int j = 0; j < 4; ++j) { const v2u w = *(const v2u*)(yr + 4 * lane + 256 * j); f[j] += (f32x4){bflo(w.x), bfhi(w.x), bflo(w.y), bfhi(w.y)}; } }
        }
        f32x4 v[4]; float s = 0.f;
#pragma unroll
        for (int j = 0; j < 4; ++j) { v[j] = *(const f32x4*)(hp + 4 * lane + 256 * j) * DN_ALPHA + *(const f32x4*)(g2 + 4 * lane + 256 * j) * f[j]; s += (v[j].x + v[j].y) + (v[j].z + v[j].w); }
        const float mean = wave_sum(s) * (1.f / D); float s2 = 0.f;
#pragma unroll
        for (int j = 0; j < 4; ++j) { v[j] = v[j] - mean; s2 += (v[j].x * v[j].x + v[j].y * v[j].y) + (v[j].z * v[j].z + v[j].w * v[j].w); }
        const float rstd = 1.f / sqrtf(wave_sum(s2) * (1.f / D) + LN_EPS);
        const float* sh1 = last ? nullptr : modv(F, l + 1, mr, 0); const float* sc1 = last ? nullptr : modv(F, l + 1, mr, 1);
#pragma unroll
        for (int j = 0; j < 4; ++j) { const f32x4 h = v[j] * rstd * gv[j] + bv[j]; *(f32x4*)(hp + 4 * lane + 256 * j) = h;
            if (!last) { const f32x4 a = h * (*(const f32x4*)(sc1 + 4 * lane + 256 * j) + 1.0f) + *(const f32x4*)(sh1 + 4 * lane + 256 * j);
                v2u o; o.x = pk2(a.x, a.y); o.y = pk2(a.z, a.w); *(v2u*)(ABUF + (size_t)R * D + 4 * lane + 256 * j) = o; } }
    }
}
#ifndef MK_MIXER
#define MK_MIXER 7
#endif
#ifndef MK_MOE
#define MK_MOE 1
#endif
#ifndef MK_PHASES
#define MK_PHASES 0xFFFFFFFFu
#endif
#define PH(n) ((MK_PHASES >> (n)) & 1u)
__device__ __forceinline__ void zero_mix_cols(Frame& F, int c0, int ncols) {
    bf16* MIX = (bf16*)(F.ws + WS_MIX); const int per = ncols / 8; const size_t tot = (size_t)M * per;
    for (size_t i = (size_t)F.vcu * 512 + F.tid; i < tot; i += (size_t)F.G * 512) { const size_t R = i / per; const int c = (int)(i % per) * 8; *(v4u*)(MIX + R * 1024 + c0 + c) = (v4u){0u, 0u, 0u, 0u}; }
}
__global__ void __launch_bounds__(NWAVES * 64, 2) mk_fwd(Args args) {
    extern __shared__ __attribute__((aligned(16))) unsigned char lds[];
    Frame F;
    F.lds = (LAS unsigned char*)lds; F.ldsg = (char*)lds;
    F.MISC = (volatile LAS unsigned*)(F.lds + MISC_OFF);
    F.tid = threadIdx.x; F.lane = F.tid & 63; F.wave = __builtin_amdgcn_readfirstlane(F.tid >> 6);
    F.G = gridDim.x; { const int bx = blockIdx.x; F.vcu = (F.G % 8 == 0) ? (bx % 8) * (F.G / 8) + bx / 8 : bx; }
    F.ws = args.ws; F.out = args.out; F.ctl = (gu32*)(args.ws + WS_CTL);
    for (int u = F.tid; u < (LDS_BYTES - LDSCTL_OFF) / 4; u += NWAVES * 64) ((LAS unsigned*)(F.lds + LDSCTL_OFF))[u] = 0u;
    __syncthreads();
    XcdBarrier bar = xcd_barrier_post((unsigned*)(F.ctl + CW_BAR), F.MISC + 8);
#define GRID_BAR() xcd_barrier(bar)
    const Args& A = args;
    if (PH(0)) phase_prologue_a(F, A);
    { float* SWT = (float*)(F.ws + WS_SWT); for (int i = F.vcu * 512 + F.tid; i < M; i += F.G * 512) SWT[SH0 + i] = 1.0f; }
    GRID_BAR();
    if (MK_MIXER && PH(1)) phase_prologue_b(F, A);
    for (int l = 0; l < DEPTH; ++l) {
        const bool last = (l == DEPTH - 1);
        if (l > 0 || MK_MIXER) GRID_BAR();
        if (MK_MIXER) {
            {
                pg8::Gemm g{(const pg8::bf16_t*)(F.ws + WS_ABUF), (const pg8::bf16_t*)(F.ws + WS_WIN) + (size_t)l * PROJ * D, M, PROJ, D, 0};
                pg8::StaticOrder S; S.init(M, PROJ, F.G, (int)blockIdx.x);
                pg8::EpiBf16 E{(pg8::bf16_t*)(F.ws + WS_P), PROJ, nullptr, 1 << 30, 0};
                if (PH(2)) pg8::gemm_phase<pg8::EpiBf16, pg8::StaticOrder, true, false, 1024>(F.lds + RING_OFF, g, S, E);
                if (PH(3)) phase_prep(F, A, l, MK_MOE != 0, (MK_MIXER & 2) != 0);
            }
            GRID_BAR();
            if ((MK_MIXER & 1) && PH(4)) phase_qkv_rows(F, A, l);
            if (MK_MIXER & 2) { if (PH(5)) phase_hy_short(F, A, l); if (PH(6)) phase_spectra(F, l); }
            if ((MK_MIXER & 4) && PH(7)) phase_rg_gates(F, A, l);
            GRID_BAR();
            if (MK_MIXER & 4) { if (PH(8)) phase_rg_scan(F, l); } else zero_mix_cols(F, 768, 256);
            if (MK_MIXER & 2) { if (PH(9)) phase_hyconv(F, A, l); } else zero_mix_cols(F, 0, 256);
            if (MK_MIXER & 1) { __syncthreads(); if (PH(10)) phase_attention(F, l); } else zero_mix_cols(F, 256, 512);
            GRID_BAR();
            {   pg8::Gemm g{(const pg8::bf16_t*)(F.ws + WS_MIX), (const pg8::bf16_t*)(F.ws + WS_WOUT) + (size_t)l * D * D, M, D, D, 0};
                pg8::StaticOrder S; S.init(M, D, F.G, (int)blockIdx.x);
                pg8::EpiResid E{l == 0 ? A.in[I_X] : F.out, l == 0 ? A.in[I_CTX] : (const float*)(F.ws + WS_HC), F.out, (float*)(F.ws + WS_HC), modv(F, l, 0, 2), 6144, ML / 256, DN_ALPHA};
                if (PH(11)) pg8::gemm_phase<pg8::EpiResid, pg8::StaticOrder, true, false, 1024>(F.lds + RING_OFF, g, S, E);
            }
            GRID_BAR();
        } else if (MK_MOE) {
            if (PH(3)) phase_prep(F, A, l, true, false);
        }
        if (PH(12)) phase_ln1(F, A, l, MK_MIXER == 0);
        GRID_BAR();
        if (MK_MOE) {
            if (PH(13)) phase_sort(F, l);
            GRID_BAR();
            {   const int ntiles = load_tiles(F);
                pg8::Gemm g{(const pg8::bf16_t*)(F.ws + WS_ABUF), (const pg8::bf16_t*)(F.ws + WS_WGU), M, 512, D, (size_t)512 * D * 2};
                pg8::MoeOrder S{(const LAS unsigned*)(F.lds + LTILES_OFF), ntiles, 2, F.G, F.vcu, (const int*)(F.ws + WS_STOK), SH0 / 256};
                pg8::EpiGU E{(pg8::bf16_t*)(F.ws + WS_HID), (const float*)(F.ws + WS_SWT)};
                if (PH(14)) pg8::gemm_phase<pg8::EpiGU, pg8::MoeOrder, true, true, 1024>(F.lds + RING_OFF, g, S, E);
            }
            GRID_BAR();
            {   const int ntiles = load_tiles(F);
                pg8::Gemm g{(const pg8::bf16_t*)(F.ws + WS_HID), (const pg8::bf16_t*)(F.ws + WS_WDN), HIDROWS, D, FF, (size_t)D * FF * 2};
                pg8::MoeOrder S{(const LAS unsigned*)(F.lds + LTILES_OFF), ntiles, 4, F.G, F.vcu, (const int*)(F.ws + WS_STOK), SH0 / 256};
                pg8::EpiBf16 E{(pg8::bf16_t*)(F.ws + WS_Y2), D, (pg8::bf16_t*)(F.ws + WS_ABUF), SH0 / 256, SH0 / 256};
                if (PH(15)) pg8::gemm_phase<pg8::EpiBf16, pg8::MoeOrder, true, false, 256>(F.lds + RING_OFF, g, S, E);
            }
            GRID_BAR();
        }
        if (PH(16)) phase_ln2(F, A, l, MK_MOE != 0);
    }
}

extern "C" void kernel_launch(void* const* d_in, const int* in_sizes, int n_in, void* d_out, int out_size, void* d_ws, size_t ws_size, hipStream_t stream) {
    static int grid = 0;
    if (grid == 0) {
        if (n_in != N_IN || in_sizes[0] != ML * D || out_size != ML * D || ws_size < WS_END) { fprintf(stderr, "kernel_launch: unexpected shapes (n_in %d in0 %d out %d ws %zu need %zu); nothing launched\n", n_in, n_in > 0 ? in_sizes[0] : -1, out_size, ws_size, (size_t)WS_END); grid = -1; return; }
        int dev = 0, cus = 0, per_cu = 0;
        if (hipGetDevice(&dev) != hipSuccess || hipDeviceGetAttribute(&cus, hipDeviceAttributeMultiprocessorCount, dev) != hipSuccess) { grid = -1; return; }
        if (hipFuncSetAttribute((const void*)mk_fwd, hipFuncAttributeMaxDynamicSharedMemorySize, LDS_BYTES) != hipSuccess) { fprintf(stderr, "kernel_launch: hipFuncSetAttribute failed\n"); grid = -1; return; }
        if (hipOccupancyMaxActiveBlocksPerMultiprocessor(&per_cu, (const void*)mk_fwd, NWAVES * 64, LDS_BYTES) != hipSuccess || per_cu < 1) { fprintf(stderr, "kernel_launch: occupancy query reports %d\n", per_cu); }
        (void)hipGetLastError();
        grid = cus;
    }
    if (grid < 0) return;
    if (hipMemsetAsync((char*)d_ws + WS_CTL, 0, CTL_ZERO_BYTES, stream) != hipSuccess) return;
    Args a{};
    for (int i = 0; i < N_IN; ++i) a.in[i] = (const float*)d_in[i];
    a.out = (float*)d_out; a.ws = (unsigned char*)d_ws;
    hipLaunchKernelGGL(mk_fwd, dim3(grid), dim3(NWAVES * 64), LDS_BYTES, stream, a);
}
```

```cpp
#include <hip/hip_runtime.h>
#include <hip/hip_bf16.h>
#include <cstdio>
#include <cstdint>
#include <cmath>
namespace pg8 {
#define PG8_LAS __attribute__((address_space(3)))
typedef unsigned short bf16_t;
typedef short bf16x8 __attribute__((ext_vector_type(8)));
typedef float f32x4 __attribute__((ext_vector_type(4)));
typedef unsigned u32x4 __attribute__((ext_vector_type(4)));
constexpr int BM = 256, BK = 64, HALF = 128, HTB = HALF * BK * 2  , STAGE_BYTES = 8 * HTB, NXCD = 8, WGM = 8;

__host__ __device__ __forceinline__ int lds_byte(int r, int c) { const int st = (r >> 4) * 2 + (c >> 5), rr = r & 15, cc = c & 31, ob = rr * 64 + cc * 2; return st * 1024 + (ob ^ (((ob >> 9) & 1) << 5)); }
__host__ __device__ __forceinline__ void stage_rc(int b, int& R, int& C) { const int st = b / 1024, sb = b % 1024, swz = sb ^ (((sb >> 9) & 1) << 5); R = (st >> 1) * 16 + swz / 64; C = (st & 1) * 32 + (swz % 64) / 2; }
__host__ __device__ __forceinline__ int perm32(int rho) { const int n = rho >> 4, i = rho & 15; return 8 * (i >> 2) + 4 * n + (i & 3); }

struct Unit { int pm, pn, e; };
struct Gemm { const bf16_t* A; const bf16_t* Bt; int M, N, K; size_t bstride; };

struct StaticOrder {
    int nM, nN, nwg, G, c;
    __host__ __device__ void init(int M, int N, int G_, int c_) { nM = M / BM; nN = N / BM; nwg = nM * nN; G = G_; c = c_; }
    __host__ __device__ bool next(int i, Unit& u) const {
        const long L = (long)i * G + c; if (L >= nwg) return false;
        int wgid = (int)L; { const int q = nwg / NXCD, r = nwg % NXCD, xcd = wgid % NXCD, off = wgid / NXCD; wgid = (xcd < r ? xcd * (q + 1) : r * (q + 1) + (xcd - r) * q) + off; }
        const int nig = WGM * nN, gid = wgid / nig, fm = gid * WGM, gsz = (nM - fm) < WGM ? (nM - fm) : WGM;
        u.pm = fm + ((wgid % nig) % gsz); u.pn = (wgid % nig) / gsz; u.e = 0; return true;
    }
    __device__ __forceinline__ void a_ready(const Unit&) const {}
    __device__ __forceinline__ void done(const Unit&) const {}
};

__device__ __forceinline__ unsigned cvt_pk_bf16(float lo, float hi) { unsigned r; asm volatile("v_cvt_pk_bf16_f32 %0, %1, %2" : "=v"(r) : "v"(lo), "v"(hi)); return r; }
typedef float f32x2 __attribute__((ext_vector_type(2)));

struct EpiBf16 {
    static constexpr bool PERM = true;
    bf16_t* O; int ldc; bf16_t* O2; int pm_split; int pm_off2;
    __device__ __forceinline__ void operator()(const f32x4 (&acc)[2][2][4][2], const Unit& u, int wr, int wc, int fr, int fq) const {
        bf16_t* base = O; int pm = u.pm; if (pm >= pm_split) { base = O2; pm -= pm_off2; }
        const int row0 = pm * BM + wr * 64 + fr; const int col0 = u.pn * BM + wc * 32 + 8 * fq;
#pragma unroll
        for (int ai = 0; ai < 2; ++ai)
#pragma unroll
            for (int m = 0; m < 4; ++m) { bf16_t* rowp = base + (size_t)(row0 + ai * HALF + m * 16) * ldc + col0;
#pragma unroll
                for (int bj = 0; bj < 2; ++bj) { const f32x4 v0 = acc[ai][bj][m][0], v1 = acc[ai][bj][m][1];
                    u32x4 w; w.x = cvt_pk_bf16(v0[0], v0[1]); w.y = cvt_pk_bf16(v0[2], v0[3]); w.z = cvt_pk_bf16(v1[0], v1[1]); w.w = cvt_pk_bf16(v1[2], v1[3]);
                    *(u32x4*)(rowp + bj * HALF) = w; } }
    }
};
struct EpiResid {
    static constexpr bool PERM = false;
    const float* hs_lat; const float* hs_ctx; float* vd_lat; float* vd_ctx; const float* gate; int gate_stride; int ml_tiles; float alpha;
    __device__ __forceinline__ void operator()(const f32x4 (&acc)[2][2][4][2], const Unit& u, int wr, int wc, int fr, int fq) const {
        const bool lat = u.pm < ml_tiles; const int pm = lat ? u.pm : u.pm - ml_tiles;
        const float* hs = lat ? hs_lat : hs_ctx; float* vd = lat ? vd_lat : vd_ctx;
        const int modrow = lat ? (u.pm >> 4) : 8;
        const int row0 = pm * BM + wr * 64 + fr; const int col0 = u.pn * BM + wc * 32 + 4 * fq;
        f32x4 gv[2][2];
#pragma unroll
        for (int bj = 0; bj < 2; ++bj)
#pragma unroll
            for (int n = 0; n < 2; ++n) gv[bj][n] = *(const f32x4*)(gate + (size_t)modrow * gate_stride + col0 + bj * HALF + n * 16);
#pragma unroll
        for (int ai = 0; ai < 2; ++ai)
#pragma unroll
            for (int m = 0; m < 4; ++m) { const size_t off = (size_t)(row0 + ai * HALF + m * 16) * 1024 + col0;
#pragma unroll
                for (int bj = 0; bj < 2; ++bj)
#pragma unroll
                    for (int n = 0; n < 2; ++n) { const f32x4 hv = *(const f32x4*)(hs + off + bj * HALF + n * 16);
                        *(f32x4*)(vd + off + bj * HALF + n * 16) = hv * alpha + gv[bj][n] * acc[ai][bj][m][n]; } }
    }
};
struct EpiGU {
    static constexpr bool PERM = true;
    bf16_t* H; const float* swt;
    __device__ __forceinline__ void operator()(const f32x4 (&acc)[2][2][4][2], const Unit& u, int wr, int wc, int fr, int fq) const {
        const int row0 = u.pm * BM + wr * 64 + fr; const int col0 = u.pn * HALF + wc * 32 + 8 * fq;
#pragma unroll
        for (int ai = 0; ai < 2; ++ai)
#pragma unroll
            for (int m = 0; m < 4; ++m) { const int row = row0 + ai * HALF + m * 16; const float w = swt[row];
                float h[8];
#pragma unroll
                for (int n = 0; n < 2; ++n)
#pragma unroll
                    for (int j = 0; j < 4; ++j) { const float g = acc[ai][0][m][n][j], up = acc[ai][1][m][n][j];
                        const float s = g * __builtin_amdgcn_rcpf(1.0f + __builtin_amdgcn_exp2f(-1.4426950408889634f * g)); h[n * 4 + j] = s * up * w; }
                u32x4 o; o.x = cvt_pk_bf16(h[0], h[1]); o.y = cvt_pk_bf16(h[2], h[3]); o.z = cvt_pk_bf16(h[4], h[5]); o.w = cvt_pk_bf16(h[6], h[7]);
                *(u32x4*)(H + (size_t)row * 256 + col0) = o; }
    }
};
struct MoeOrder {
    const PG8_LAS unsigned* tiles; int ntiles, nN, G, c; const int* stok; int sh_pm0;
    __device__ __forceinline__ bool next(int i, Unit& u) const {
        const long L = (long)i * G + c; if (L >= (long)ntiles * nN) return false;
        const int t = (int)(L / nN); u.pn = (int)(L % nN); const unsigned pk = (unsigned)__builtin_amdgcn_readfirstlane((int)tiles[t]); u.e = (int)(pk >> 16); u.pm = (int)(pk & 0xffffu); return true;
    }
    __device__ __forceinline__ int arow(const Unit& u, int r) const { return u.e >= 64 ? (u.pm - sh_pm0) * BM + r : stok[u.pm * BM + r]; }
    __device__ __forceinline__ void a_ready(const Unit&) const {}
    __device__ __forceinline__ void done(const Unit&) const {}
};

__device__ __forceinline__ const char* uptr(const char* p) { const unsigned long long v = (unsigned long long)p; const unsigned lo = (unsigned)__builtin_amdgcn_readfirstlane((int)(unsigned)v), hi = (unsigned)__builtin_amdgcn_readfirstlane((int)(unsigned)(v >> 32)); return (const char*)(((unsigned long long)hi << 32) | lo); }
template <class Epi, class Sched, bool ALIGN_EPI, bool GATHER, int KC>
__device__ __forceinline__ void gemm_phase(PG8_LAS unsigned char* lds, const Gemm g, const Sched& S, const Epi& E) {
    int tid_ = threadIdx.x; asm volatile("" : "+v"(tid_));
    const int tid = tid_, wid = __builtin_amdgcn_readfirstlane(tid >> 6), lane = tid & 63, wr = wid >> 2, wc = wid & 3, fr = lane & 15, fq = lane >> 4;
    constexpr int K = KC, nt = K / BK;
    unsigned voffB[2]; int RA[2], CA[2];
    unsigned oc[2][2], on[2][2];
    const size_t hstep = (size_t)HALF * K * 2;
#pragma unroll
    for (int i = 0; i < 2; ++i) { int R, C; stage_rc(tid * 16 + i * 8192, R, C); const int Rb = Epi::PERM ? ((R & ~31) + perm32(R & 31)) : R;
        RA[i] = R; CA[i] = C; voffB[i] = (unsigned)(Rb * K + C) * 2u;
        oc[0][i] = (unsigned)(R * K + C) * 2u; oc[1][i] = oc[0][i] + (unsigned)hstep; on[0][i] = oc[0][i]; on[1][i] = oc[1][i]; }
    const size_t kstep = (size_t)(BK * 2);
    const size_t tstep = 2 * hstep;
    const unsigned ldsw = (unsigned)wid * 1024u;
    const int aoff = lds_byte(wr * 64 + fr, fq * 8), boff = lds_byte(wc * 32 + fr, fq * 8);
#define PG8_SA(b, h) (((b) * 2 + (h)) * HTB)
#define PG8_SB(b, h) ((4 + (b) * 2 + (h)) * HTB)
#define PG8_STAGE(bufoff, gbase, voff) do { _Pragma("unroll") for (int _i = 0; _i < 2; ++_i) \
        __builtin_amdgcn_global_load_lds((const unsigned*)((const char*)(gbase) + (voff)[_i]), (PG8_LAS unsigned*)(lds + (bufoff) + ldsw + _i * 8192), 16, 0, 0); } while (0)
#define PG8_STAGE_A(bufoff, gbase, OA, h) do { _Pragma("unroll") for (int _i = 0; _i < 2; ++_i) \
        __builtin_amdgcn_global_load_lds((const unsigned*)((const char*)(gbase) + (OA)[h][_i]), (PG8_LAS unsigned*)(lds + (bufoff) + ldsw + _i * 8192), 16, 0, 0); } while (0)
#define PG8_LDA(dst, b, h) do { _Pragma("unroll") for (int m = 0; m < 4; ++m) _Pragma("unroll") for (int k = 0; k < 2; ++k) dst[m][k] = *(const PG8_LAS bf16x8*)(lds + PG8_SA(b, h) + aoff + m * 2048 + k * 1024); } while (0)
#define PG8_LDB(dst, b, h) do { _Pragma("unroll") for (int n = 0; n < 2; ++n) _Pragma("unroll") for (int k = 0; k < 2; ++k) dst[n][k] = *(const PG8_LAS bf16x8*)(lds + PG8_SB(b, h) + boff + n * 2048 + k * 1024); } while (0)
#define PG8_MMA(ai, bj, At, Bt) do { __builtin_amdgcn_s_setprio(1); _Pragma("unroll") for (int m = 0; m < 4; ++m) _Pragma("unroll") for (int n = 0; n < 2; ++n) _Pragma("unroll") for (int k = 0; k < 2; ++k) \
        acc[ai][bj][m][n] = __builtin_amdgcn_mfma_f32_16x16x32_bf16(Bt[n][k], At[m][k], acc[ai][bj][m][n], 0, 0, 0); __builtin_amdgcn_s_setprio(0); } while (0)
#define PG8_WAIT_V(n) asm volatile("s_waitcnt vmcnt(" #n ")" ::: "memory")
#define PG8_WAIT_L(n) asm volatile("s_waitcnt lgkmcnt(" #n ")" ::: "memory")
#define PG8_BAR __builtin_amdgcn_s_barrier()
#define PG8_SCHED __builtin_amdgcn_sched_barrier(0)
    Unit cur, nxt; int ui = 0;
    if (!S.next(0, cur)) return;
    f32x4 acc[2][2][4][2];
#pragma unroll
    for (int a = 0; a < 2; ++a)
#pragma unroll
        for (int b = 0; b < 2; ++b)
#pragma unroll
            for (int m = 0; m < 4; ++m)
#pragma unroll
                for (int n = 0; n < 2; ++n) acc[a][b][m][n] = (f32x4){0.f, 0.f, 0.f, 0.f};
    bf16x8 At[4][2], B0[2][2], B1[2][2];
    const char* cA; const char* cB = uptr((const char*)g.Bt + (size_t)cur.e * g.bstride + (size_t)cur.pn * tstep);
    if constexpr (GATHER) { cA = (const char*)g.A;
#pragma unroll
        for (int h = 0; h < 2; ++h)
#pragma unroll
            for (int i = 0; i < 2; ++i) oc[h][i] = (unsigned)(S.arow(cur, h * HALF + RA[i]) * K + CA[i]) * 2u;
    } else cA = uptr((const char*)g.A + (size_t)cur.pm * tstep);
    S.a_ready(cur);
    PG8_STAGE(PG8_SB(0, 0), cB, voffB); PG8_STAGE(PG8_SB(0, 1), cB + hstep, voffB); PG8_STAGE_A(PG8_SA(0, 0), cA, oc, 0); PG8_STAGE_A(PG8_SA(0, 1), cA, oc, 1);
    if (wr == 1) PG8_BAR;
    PG8_WAIT_V(2); PG8_BAR;
    PG8_STAGE(PG8_SB(1, 0), cB + kstep, voffB); PG8_STAGE_A(PG8_SA(1, 0), cA + kstep, oc, 0); PG8_STAGE(PG8_SB(1, 1), cB + hstep + kstep, voffB);
    PG8_WAIT_V(6); PG8_BAR;
    for (;;) {
        const bool has_next = S.next(ui + 1, nxt);
        const char* nA = cA; const char* nB = has_next ? uptr((const char*)g.Bt + (size_t)nxt.e * g.bstride + (size_t)nxt.pn * tstep) : cB;
        if constexpr (GATHER) {
            if (has_next) {
#pragma unroll
                for (int h = 0; h < 2; ++h)
#pragma unroll
                    for (int i = 0; i < 2; ++i) on[h][i] = (unsigned)(S.arow(nxt, h * HALF + RA[i]) * K + CA[i]) * 2u;
            } else {
#pragma unroll
                for (int h = 0; h < 2; ++h)
#pragma unroll
                    for (int i = 0; i < 2; ++i) on[h][i] = oc[h][i];
            }
        } else { if (has_next) nA = uptr((const char*)g.A + (size_t)nxt.pm * tstep); }
#pragma unroll 1
        for (int t = 0; t < nt; t += 2) {
            const bool last = (t == nt - 2);
            const char* a1 = cA + (size_t)(t + 1) * kstep;
            const char* a2 = last ? nA : cA + (size_t)(t + 2) * kstep; const char* b2 = last ? nB : cB + (size_t)(t + 2) * kstep;
            const char* a3 = a2 + kstep; const char* b3 = b2 + kstep;
            unsigned o2[2][2];
#pragma unroll
            for (int h = 0; h < 2; ++h)
#pragma unroll
                for (int i = 0; i < 2; ++i) o2[h][i] = (GATHER && last) ? on[h][i] : oc[h][i];
            if (last && has_next) S.a_ready(nxt);
            PG8_LDB(B0, 0, 0); PG8_LDB(B1, 0, 1); PG8_SCHED; PG8_LDA(At, 0, 0); PG8_STAGE_A(PG8_SA(1, 1), a1, oc, 1);
            PG8_WAIT_V(8); PG8_WAIT_L(0); PG8_BAR; PG8_MMA(0, 0, At, B0); PG8_MMA(0, 1, At, B1); PG8_BAR; PG8_SCHED;
            PG8_LDA(At, 0, 1); PG8_STAGE(PG8_SB(0, 0), b2, voffB); PG8_STAGE(PG8_SB(0, 1), b2 + hstep, voffB); PG8_STAGE_A(PG8_SA(0, 0), a2, o2, 0);
            PG8_WAIT_V(8); PG8_WAIT_L(0); PG8_BAR; PG8_MMA(1, 0, At, B0); PG8_MMA(1, 1, At, B1); PG8_BAR; PG8_SCHED;
            PG8_LDB(B0, 1, 0); PG8_LDB(B1, 1, 1); PG8_SCHED; PG8_LDA(At, 1, 0); PG8_STAGE_A(PG8_SA(0, 1), a2, o2, 1);
            PG8_WAIT_V(8); PG8_WAIT_L(0); PG8_BAR; PG8_MMA(0, 0, At, B0); PG8_MMA(0, 1, At, B1); PG8_BAR; PG8_SCHED;
            PG8_LDA(At, 1, 1); PG8_STAGE(PG8_SB(1, 0), b3, voffB); PG8_STAGE(PG8_SB(1, 1), b3 + hstep, voffB); PG8_STAGE_A(PG8_SA(1, 0), a3, o2, 0);
            PG8_WAIT_V(8); PG8_WAIT_L(0); PG8_BAR; PG8_MMA(1, 0, At, B0); PG8_MMA(1, 1, At, B1); PG8_BAR; PG8_SCHED;
        }
        if constexpr (ALIGN_EPI) { if (wr == 0) PG8_BAR; }
        E(acc, cur, wr, wc, fr, fq); S.done(cur);
        if (!has_next) break;
#pragma unroll
        for (int a = 0; a < 2; ++a)
#pragma unroll
            for (int b = 0; b < 2; ++b)
#pragma unroll
                for (int m = 0; m < 4; ++m)
#pragma unroll
                    for (int n = 0; n < 2; ++n) acc[a][b][m][n] = (f32x4){0.f, 0.f, 0.f, 0.f};
        cur = nxt; cA = nA; cB = nB; ++ui;
#pragma unroll
        for (int h = 0; h < 2; ++h)
#pragma unroll
            for (int i = 0; i < 2; ++i) oc[h][i] = on[h][i];
        if constexpr (ALIGN_EPI) { if (wr == 1) PG8_BAR; }
    }
    PG8_WAIT_V(0);
    if constexpr (!ALIGN_EPI) { if (wr == 0) PG8_BAR; }
    PG8_BAR;
#undef PG8_SA
#undef PG8_SB
#undef PG8_STAGE
#undef PG8_STAGE_A
#undef PG8_LDA
#undef PG8_LDB
#undef PG8_MMA
#undef PG8_WAIT_V
#undef PG8_WAIT_L
#undef PG8_BAR
#undef PG8_SCHED
}
}
namespace attn_body {
using bf16=__hip_bfloat16;
using bf16x8=__attribute__((ext_vector_type(8)))short;
using s16x4=__attribute__((ext_vector_type(4)))short;
using f32x16=__attribute__((ext_vector_type(16)))float;
using u32x4=__attribute__((ext_vector_type(4)))unsigned;
constexpr int D=64,QP=512,KP=128,OP=1024;
constexpr int NW=8,QBLK=32,QB=QBLK*NW,KVBLK=64;
constexpr int ATTN_UNIT_ROWS=QB;
__device__ __forceinline__ int crow(int r,int hi){return (r&3)+8*(r>>2)+4*hi;}
#define SBAR() __builtin_amdgcn_sched_barrier(0)
__device__ __forceinline__ void cmask(f32x16&p0,f32x16&p1,int jb,int qrel,int hi){
  const float NEG=-INFINITY; int kb=64*jb+4*hi;
  #pragma unroll
  for(int r=0;r<16;++r){int kv=kb+(r&3)+8*(r>>2); if(kv>qrel)p0[r]=NEG; if(kv+32>qrel)p1[r]=NEG;}
}

constexpr int NSLOT=3, SLOTB=8192;
constexpr int LDS_K=0, LDS_V=NSLOT*SLOTB, LDS_WS=2*NSLOT*SLOTB, LDS_OST=LDS_WS+NW*64*4, LDS_BYTES=LDS_OST+NW*4096;
constexpr float C2=0.125f*1.4426950408889634f;
__device__ __forceinline__ void glds16(const void*gsrc,unsigned lds_dst){unsigned keep;
  asm volatile("s_mov_b32 %0, m0\n\ts_mov_b32 m0, %2\n\ts_nop 0\n\tglobal_load_lds_dwordx4 %1, off\n\ts_mov_b32 m0, %0":"=&s"(keep):"v"(gsrc),"s"(lds_dst):"memory");}
__device__ __forceinline__ float max3f(float a,float b,float c){float r;asm("v_max3_f32 %0, %1, %2, %3":"=v"(r):"v"(a),"v"(b),"v"(c));return r;}
__device__ __forceinline__ float max2f(float a,float b){float r;asm("v_max_f32_e32 %0, %1, %2":"=v"(r):"v"(a),"v"(b));return r;}
__device__ __forceinline__ float fadd_s(float a,float b){float r;asm("v_add_f32_e32 %0, %1, %2":"=v"(r):"v"(a),"v"(b));return r;}
__device__ __forceinline__ float fsub_s(float a,float b){float r;asm("v_sub_f32_e32 %0, %1, %2":"=v"(r):"v"(a),"v"(b));return r;}
typedef float f32x2_t __attribute__((ext_vector_type(2))); typedef __bf16 bf16x2_t __attribute__((ext_vector_type(2)));
__device__ __forceinline__ unsigned cvtpk_s(float lo,float hi){f32x2_t v={lo,hi};bf16x2_t b=__builtin_convertvector(v,bf16x2_t);return __builtin_bit_cast(unsigned,b);}
#define WAIT_BAR(N) asm volatile("s_waitcnt vmcnt(" #N ") lgkmcnt(0)\n\ts_barrier":::"memory")

__device__ __forceinline__ void qkt(f32x16&p0,f32x16&p1,const char*Kslot,const bf16x8*qr,const f32x16&negm,int r32,int hi){
  const char*kb=Kslot+hi*1024+r32*16;
  #pragma unroll
  for(int d0=0;d0<4;++d0){
    const bf16x8 b0=*reinterpret_cast<const bf16x8*>(kb+d0*2048);
    const bf16x8 b1=*reinterpret_cast<const bf16x8*>(kb+d0*2048+512);
    if(d0==0){p0=__builtin_amdgcn_mfma_f32_32x32x16_bf16(b0,qr[0],negm,0,0,0);p1=__builtin_amdgcn_mfma_f32_32x32x16_bf16(b1,qr[0],negm,0,0,0);}
    else{p0=__builtin_amdgcn_mfma_f32_32x32x16_bf16(b0,qr[d0],p0,0,0,0);p1=__builtin_amdgcn_mfma_f32_32x32x16_bf16(b1,qr[d0],p1,0,0,0);}}
}
typedef __attribute__((address_space(3))) const char* lds_cptr;
typedef short v4i16_t __attribute__((ext_vector_type(4)));
__device__ __forceinline__ void kload8(bf16x8*kf,lds_cptr kp){
  kf[0]=*(const __attribute__((address_space(3))) bf16x8*)(kp);      kf[1]=*(const __attribute__((address_space(3))) bf16x8*)(kp+512);
  kf[2]=*(const __attribute__((address_space(3))) bf16x8*)(kp+2048); kf[3]=*(const __attribute__((address_space(3))) bf16x8*)(kp+2560);
  kf[4]=*(const __attribute__((address_space(3))) bf16x8*)(kp+4096); kf[5]=*(const __attribute__((address_space(3))) bf16x8*)(kp+4608);
  kf[6]=*(const __attribute__((address_space(3))) bf16x8*)(kp+6144); kf[7]=*(const __attribute__((address_space(3))) bf16x8*)(kp+6656);
}
__device__ __forceinline__ void kload2(bf16x8*kf,lds_cptr kp,int j){ kf[2*j]=*(const __attribute__((address_space(3))) bf16x8*)(kp+j*2048); kf[2*j+1]=*(const __attribute__((address_space(3))) bf16x8*)(kp+j*2048+512); }
__device__ __forceinline__ s16x4 vtr(lds_cptr p){ return __builtin_bit_cast(s16x4,__builtin_amdgcn_ds_read_tr16_b64_v4i16((__attribute__((address_space(3))) v4i16_t*)p)); }
__device__ __forceinline__ float rowmax(const f32x16&p0,const f32x16&p1){
  float a=max3f(p0[0],p0[1],p1[0]),b=max3f(p0[2],p0[3],p1[1]);a=max3f(a,p1[2],p1[3]);
  #pragma unroll
  for(int r=4;r<16;r+=4){a=max3f(a,p0[r],p0[r+1]);b=max3f(b,p0[r+2],p0[r+3]);a=max3f(a,p1[r],p1[r+1]);b=max3f(b,p1[r+2],p1[r+3]);}
  const float m=max2f(a,b);
  auto rr=__builtin_amdgcn_permlane32_swap(__float_as_uint(m),__float_as_uint(m),false,false);
  return max2f(__uint_as_float(rr[0]),__uint_as_float(rr[1]));
}
__device__ __forceinline__ void pv(f32x16*o,int vb,bf16x8 pa0,bf16x8 pa1,bf16x8 pa2,bf16x8 pa3){
  #pragma unroll
  for(int d0=0;d0<2;++d0){s16x4 lo[4],hi[4];
    #pragma unroll
    for(int ks=0;ks<4;++ks){
      asm volatile("ds_read_b64_tr_b16 %0,%1 offset:%c2":"=&v"(lo[ks]):"v"(vb),"i"(d0*4096+ks*1024):"memory");
      asm volatile("ds_read_b64_tr_b16 %0,%1 offset:%c2":"=&v"(hi[ks]):"v"(vb),"i"(d0*4096+ks*1024+512):"memory");}
    asm volatile("s_waitcnt lgkmcnt(0)":::"memory");SBAR();
    #define PK(k) (bf16x8){lo[k][0],lo[k][1],lo[k][2],lo[k][3],hi[k][0],hi[k][1],hi[k][2],hi[k][3]}
    o[d0]=__builtin_amdgcn_mfma_f32_32x32x16_bf16(pa0,PK(0),o[d0],0,0,0);
    o[d0]=__builtin_amdgcn_mfma_f32_32x32x16_bf16(pa1,PK(1),o[d0],0,0,0);
    o[d0]=__builtin_amdgcn_mfma_f32_32x32x16_bf16(pa2,PK(2),o[d0],0,0,0);
    o[d0]=__builtin_amdgcn_mfma_f32_32x32x16_bf16(pa3,PK(3),o[d0],0,0,0);
    #undef PK
  }
}

#ifndef ATTN_STORE16
#define ATTN_STORE16(p,v) (*(u32x4*)(p)=(v))
#endif
template<int THRL> __device__ __forceinline__ void attn_unit(long qrow0,int qcol,long kvrow0,int kvcol,int NT,long orow0,int ocol,const bf16*Q,const bf16* K,const bf16* V,bf16*O,char*shm){
  int tid_=threadIdx.x; asm volatile("":"+v"(tid_)); const int tid=tid_,lane=tid&63,r32=lane&31,hi=lane>>5; const int wid=__builtin_amdgcn_readfirstlane(tid>>6);
  const bf16*Qw=Q+(qrow0+wid*QBLK)*QP+qcol;
  const bf16*Kh=K+kvrow0*KP+kvcol,*Vh=V+kvrow0*KP+kvcol;
  const unsigned lds0=(unsigned)(uintptr_t)shm;
  float*wsf=(float*)(shm+LDS_WS)+wid*64;
  const bf16*ksrc=Kh+(long)lane*KP+wid*8;
  const bf16*vsrc=Vh+(long)(16*(wid&3)+(lane>>2))*KP+(wid>>2)*32+(lane&3)*8;
  const unsigned kdst=lds0+LDS_K+wid*1024, vdst=lds0+LDS_V+wid*1024;
  #define DMA_K(t,slot) glds16(ksrc+(long)(t)*KVBLK*KP,(unsigned)__builtin_amdgcn_readfirstlane(kdst+(slot)))
  #define DMA_V(t,slot) glds16(vsrc+(long)(t)*KVBLK*KP,(unsigned)__builtin_amdgcn_readfirstlane(vdst+(slot)))
  const int vb0=(int)(lds0+LDS_V)+((lane>>4)&1)*32+(lane&3)*8+(4*hi+((lane&15)>>2))*64;
  const char*Kbase=shm+LDS_K; bf16x8 kf[8];
  const lds_cptr shm3=(lds_cptr)shm; const lds_cptr kp0=shm3+LDS_K+hi*1024+r32*16; const lds_cptr vp0=shm3+LDS_V+((lane>>4)&1)*32+(lane&3)*8+(4*hi+((lane&15)>>2))*64;
  DMA_K(0,0);DMA_V(0,0);DMA_K(1,SLOTB);
  bf16x8 qr[4];
  #pragma unroll
  for(int d0=0;d0<4;++d0)qr[d0]=*reinterpret_cast<const bf16x8*>(&Qw[(long)r32*QP+d0*16+hi*8]);
  float mhat=0.f,l_reg=0.f;f32x16 o[2];o[0]=f32x16{};o[1]=f32x16{};f32x16 negm=f32x16{};asm volatile("":"+v"(negm));
  #define CMASK(P0,P1,t) do{}while(0)
  bool resc=false;
  #define START(P0,P1) do{ const float rm=rowmax(P0,P1); resc=false; \
    { const float dl=rm; mhat=fadd_s(mhat,dl); \
      _Pragma("unroll") for(int r=0;r<16;++r){P0[r]=fsub_s(P0[r],dl);P1[r]=fsub_s(P1[r],dl);} \
      _Pragma("unroll") for(int r=0;r<16;++r)negm[r]=-mhat; asm volatile("":"+v"(negm)); } \
    _Pragma("unroll") for(int r=0;r<16;++r)P0[r]=__builtin_amdgcn_exp2f(P0[r]); }while(0)
  #define RESC() do{ if(resc){ asm volatile("s_waitcnt lgkmcnt(0)":::"memory"); \
      _Pragma("unroll") for(int d_=0;d_<2;++d_) _Pragma("unroll") for(int r=0;r<16;++r)o[d_][r]*=wsf[crow(r,hi)]; } }while(0)
  f32x16 pA0,pA1,pB0,pB1;
  int sl_prev=0,sl_cur=0,sl_next=SLOTB;
  #define ROT() do{sl_prev=sl_cur;sl_cur=sl_next;sl_next=(sl_next==(NSLOT-1)*SLOTB)?0:sl_next+SLOTB;}while(0)
  DMA_K(2,2*SLOTB);
  WAIT_BAR(3);
  qkt(pA0,pA1,Kbase,qr,negm,r32,hi);asm volatile("s_nop 15\n\ts_nop 7":"+v"(pA0),"+v"(pA1));CMASK(pA0,pA1,0);
  START(pA0,pA1);
  _Pragma("unroll") for(int r=0;r<16;++r)pA1[r]=__builtin_amdgcn_exp2f(pA1[r]);
  WAIT_BAR(0);
  DMA_K(3,0);DMA_V(1,SLOTB);
  ROT();
  kload8(kf,kp0+sl_cur);
  WAIT_BAR(2);
  s16x4 vlo[8],vhi[8]; u32x4 pw0,pw1,pw2,pw3;
  #define PKW(P,B) cvtpk_s(P[B],P[B+1])
  #define PAF(k) __builtin_bit_cast(bf16x8,pw##k)
  #define VFR(i) (bf16x8){vlo[i][0],vlo[i][1],vlo[i][2],vlo[i][3],vhi[i][0],vhi[i][1],vhi[i][2],vhi[i][3]}
  #define PIN(x) asm volatile("":"+v"(x))
  #define MX3(a,b,c) __builtin_fmaxf(__builtin_fmaxf((a),(b)),(c))
  #define GAPA(MF,A0,A1,A2,A3,W0,W1,PW) do{ MF; sacc+=A0; sacc+=A1; sacc+=A2; sacc+=A3; PIN(sacc); W0; W1; PIN(PW); SBAR(); }while(0)
  #define EX(v) __builtin_amdgcn_exp2f(v)
  #define GAPB(MF,X,B) do{ MF; X[B]=EX(X[B]); X[B+1]=EX(X[B+1]); X[B+2]=EX(X[B+2]); X[B+3]=EX(X[B+3]); PIN(X); SBAR(); }while(0)
  #define VRD(i) do{ vlo[i]=vtr(vp_+(((i)>>2)*4096+((i)&3)*1024)); vhi[i]=vtr(vp_+(((i)>>2)*4096+((i)&3)*1024+512)); }while(0)
  #define KRD(G,j) do{ if(G){ kload2(kf,kp0+sl_next,j); SBAR(); } }while(0)
  #define STEP(C0,C1,P0,P1,t,GK,GV,GL) do{ SBAR(); \
    const lds_cptr vp_=vp0+sl_prev; \
    VRD(0); SBAR(); float sacc=(P0[0]+P0[1]); \
    GAPA(C0=__builtin_amdgcn_mfma_f32_32x32x16_bf16(kf[0],qr[0],negm,0,0,0), P0[2],P0[3],P0[4],P0[5],     pw0[0]=PKW(P0,0), pw0[1]=PKW(P0,2), pw0); \
    VRD(4); SBAR(); GAPA(C1=__builtin_amdgcn_mfma_f32_32x32x16_bf16(kf[1],qr[0],negm,0,0,0), P0[6],P0[7],P0[8],P0[9],     pw0[2]=PKW(P0,4), pw0[3]=PKW(P0,6), pw0); \
    VRD(1); SBAR(); GAPA(C0=__builtin_amdgcn_mfma_f32_32x32x16_bf16(kf[2],qr[1],C0,0,0,0),   P0[10],P0[11],P0[12],P0[13], pw1[0]=PKW(P0,8), pw1[1]=PKW(P0,10), pw1); \
    VRD(5); SBAR(); GAPA(C1=__builtin_amdgcn_mfma_f32_32x32x16_bf16(kf[3],qr[1],C1,0,0,0),   P0[14],P0[15],P1[0],P1[1],   pw1[2]=PKW(P0,12),pw1[3]=PKW(P0,14), pw1); \
    VRD(2); SBAR(); GAPA(C0=__builtin_amdgcn_mfma_f32_32x32x16_bf16(kf[4],qr[2],C0,0,0,0),   P1[2],P1[3],P1[4],P1[5],     pw2[0]=PKW(P1,0), pw2[1]=PKW(P1,2), pw2); \
    VRD(6); SBAR(); GAPA(C1=__builtin_amdgcn_mfma_f32_32x32x16_bf16(kf[5],qr[2],C1,0,0,0),   P1[6],P1[7],P1[8],P1[9],     pw2[2]=PKW(P1,4), pw2[3]=PKW(P1,6), pw2); \
    VRD(3); SBAR(); GAPA(C0=__builtin_amdgcn_mfma_f32_32x32x16_bf16(kf[6],qr[3],C0,0,0,0),   P1[10],P1[11],P1[12],P1[13], pw3[0]=PKW(P1,8), pw3[1]=PKW(P1,10), pw3); \
    VRD(7); SBAR(); GAPA(C1=__builtin_amdgcn_mfma_f32_32x32x16_bf16(kf[7],qr[3],C1,0,0,0),   P1[14],P1[15],0.f,0.f,       pw3[2]=PKW(P1,12),pw3[3]=PKW(P1,14), pw3); \
    l_reg+=sacc; \
    if(GK){DMA_K((t)+3,sl_cur);} if(GV){DMA_V((t)+1,sl_next);} \
    CMASK(C0,C1,t); \
    { float a=MX3(C0[0],C0[1],C1[0]),b=MX3(C0[2],C0[3],C1[1]); a=MX3(a,C1[2],C1[3]); \
      _Pragma("unroll") for(int r=4;r<16;r+=4){a=MX3(a,C0[r],C0[r+1]);b=MX3(b,C0[r+2],C0[r+3]);a=MX3(a,C1[r],C1[r+1]);b=MX3(b,C1[r+2],C1[r+3]);} \
      float rm=__builtin_fmaxf(a,b); { auto rr=__builtin_amdgcn_permlane32_swap(__float_as_uint(rm),__float_as_uint(rm),false,false); rm=__builtin_fmaxf(__uint_as_float(rr[0]),__uint_as_float(rr[1])); } \
      resc=false; \
      if(__builtin_expect(__any(rm>(float)THRL),0)){ const float dl=__builtin_fmaxf(rm,0.f); mhat+=dl; \
        _Pragma("unroll") for(int r=0;r<16;++r){C0[r]-=dl;C1[r]-=dl;} \
        _Pragma("unroll") for(int r=0;r<16;++r)negm[r]=-mhat; asm volatile("":"+v"(negm)); \
        const float f=__builtin_amdgcn_exp2f(-dl); l_reg*=f; if(hi==0)wsf[r32]=f; resc=true; } } \
    SBAR(); \
    GAPB(o[0]=__builtin_amdgcn_mfma_f32_32x32x16_bf16(PAF(0),VFR(0),o[0],0,0,0), C0,0); \
    GAPB(o[1]=__builtin_amdgcn_mfma_f32_32x32x16_bf16(PAF(0),VFR(4),o[1],0,0,0), C0,4); \
    KRD(GL,0); GAPB(o[0]=__builtin_amdgcn_mfma_f32_32x32x16_bf16(PAF(1),VFR(1),o[0],0,0,0), C0,8); \
    KRD(GL,1); GAPB(o[1]=__builtin_amdgcn_mfma_f32_32x32x16_bf16(PAF(1),VFR(5),o[1],0,0,0), C0,12); \
    KRD(GL,2); GAPB(o[0]=__builtin_amdgcn_mfma_f32_32x32x16_bf16(PAF(2),VFR(2),o[0],0,0,0), C1,0); \
    KRD(GL,3); GAPB(o[1]=__builtin_amdgcn_mfma_f32_32x32x16_bf16(PAF(2),VFR(6),o[1],0,0,0), C1,4); \
    GAPB(o[0]=__builtin_amdgcn_mfma_f32_32x32x16_bf16(PAF(3),VFR(3),o[0],0,0,0), C1,8); \
    GAPB(o[1]=__builtin_amdgcn_mfma_f32_32x32x16_bf16(PAF(3),VFR(7),o[1],0,0,0), C1,12); \
    }while(0)
  int t=1;
  for(;t+5<NT;t+=2){
    STEP(pB0,pB1,pA0,pA1,t,true,true,true);     WAIT_BAR(2); RESC(); ROT();
    STEP(pA0,pA1,pB0,pB1,t+1,true,true,true);   WAIT_BAR(2); RESC(); ROT();
  }
  #define ENDW(tt) do{ if((tt)+3<NT){WAIT_BAR(2);} else if((tt)+2<NT){WAIT_BAR(1);} else {WAIT_BAR(0);} }while(0)
  for(;t+1<NT;t+=2){
    STEP(pB0,pB1,pA0,pA1,t,(t+3<NT),(t+1<NT),(t+1<NT));       ENDW(t);   RESC(); ROT();
    STEP(pA0,pA1,pB0,pB1,t+1,(t+4<NT),(t+2<NT),(t+2<NT));     ENDW(t+1); RESC(); ROT();
  }
  STEP(pB0,pB1,pA0,pA1,NT-1,false,false,false); RESC();
  { float sacc=pB0[0]+pB0[1]; _Pragma("unroll") for(int r=2;r<16;++r)sacc+=pB0[r]; _Pragma("unroll") for(int r=0;r<16;++r)sacc+=pB1[r]; l_reg+=sacc;
    pw0=(u32x4){PKW(pB0,0),PKW(pB0,2),PKW(pB0,4),PKW(pB0,6)};pw1=(u32x4){PKW(pB0,8),PKW(pB0,10),PKW(pB0,12),PKW(pB0,14)};pw2=(u32x4){PKW(pB1,0),PKW(pB1,2),PKW(pB1,4),PKW(pB1,6)};pw3=(u32x4){PKW(pB1,8),PKW(pB1,10),PKW(pB1,12),PKW(pB1,14)};
    SBAR(); pv(o,vb0+sl_cur,PAF(0),PAF(1),PAF(2),PAF(3)); }
  #undef PKW
  #undef PAF
  #undef VFR
  #undef PIN
  #undef MX3
  #undef GAPA
  #undef GAPB
  #undef EX
  #undef VRD
  #undef KRD
  #undef STEP
  #undef ENDW
  {auto rr=__builtin_amdgcn_permlane32_swap(__float_as_uint(l_reg),__float_as_uint(l_reg),false,false);l_reg=__uint_as_float(rr[0])+__uint_as_float(rr[1]);}
  if(hi==0)wsf[32+r32]=l_reg;asm volatile("s_waitcnt lgkmcnt(0)":::"memory");
  float rli[16];
  #pragma unroll
  for(int r=0;r<16;++r)rli[r]=__builtin_amdgcn_rcpf(wsf[32+crow(r,hi)]);
  bf16*Ow=O+(orow0+wid*QBLK)*OP+ocol;
  { bf16*stg=(bf16*)(shm+LDS_OST)+wid*2048;
    #pragma unroll
    for(int r=0;r<16;++r){const int orow=crow(r,hi);
      #pragma unroll
      for(int d0=0;d0<2;++d0)stg[orow*64+d0*32+r32]=__float2bfloat16(o[d0][r]*rli[r]);}
    asm volatile("s_waitcnt lgkmcnt(0)":::"memory");
    #pragma unroll
    for(int i=0;i<4;++i){const int row=i*8+(lane>>3),ch=lane&7; const u32x4 v=*(const u32x4*)(stg+row*64+ch*8); ATTN_STORE16(Ow+(long)row*OP+ch*8,v);} }
  asm volatile("s_waitcnt lgkmcnt(0)\n\ts_barrier":::"memory");
  #undef DMA_K
  #undef DMA_V
  #undef CMASK
  #undef START
  #undef RESC
  #undef ROT
}
constexpr int ATTN_LDS_BYTES=LDS_BYTES;
#undef SBAR
#undef WAIT_BAR
}
constexpr int NB = 8, T = 4096, D = 1024, DEPTH = 4, LC = 256;
constexpr int ML = NB * T, MC = NB * LC, M = ML + MC;
constexpr int PROJ = 2048, SKV = T + LC;
constexpr int C_HY = 0, C_Q = 768, C_K = 1280, C_V = 1408, C_RGX = 1536, C_RGG = 1792;
constexpr int NEXP = 64, TOPK = 8, FF = 256;
constexpr int SH0 = M * TOPK + NEXP * 256;
constexpr int HIDROWS = SH0 + M;
constexpr float LN_EPS = 1e-6f, QK_EPS = 1e-6f;
constexpr float DN_ALPHA = 1.681792830507429f;
constexpr float ROUTED_SCALE = 2.5f;
constexpr int NWAVES = 8;
enum { I_X = 0, I_C, I_CTX, I_CCTX, I_WMOD, I_BMOD, I_LN1G, I_LN1B, I_LN2G, I_LN2B, I_WIN, I_WOUT, I_HYSW, I_HYSB, I_HYW1, I_HYB1, I_HYFREQ, I_HYW2, I_HYB2, I_HYW3, I_HYSKIP,
       I_QN, I_KN, I_RGCW, I_RGCB, I_RGLAM, I_RGWA, I_RGBA, I_RGWX, I_RGBX, I_WR, I_BR, I_WG, I_WU, I_WD, I_WSG, I_WSU, I_WSD, N_IN };

constexpr size_t MiB = 1u << 20;
constexpr size_t WS_CTL = 0, CTL_ZERO_BYTES = 1 * MiB;
constexpr size_t WS_MODV = 1 * MiB;
constexpr size_t WS_TW = 2 * MiB;
constexpr size_t WS_ROPE = 3 * MiB;
constexpr size_t WS_RTHI = 4 * MiB, WS_RTLO = 4 * MiB + 512 * 1024;
constexpr size_t WS_RGW = 5 * MiB;
constexpr size_t WS_IDX = 6 * MiB, WS_WT = 8 * MiB, WS_POS = 10 * MiB;
constexpr size_t WS_HIST = 12 * MiB;
constexpr size_t WS_TILES = 12 * MiB + 512 * 1024;
constexpr size_t WS_STOK = 13 * MiB;
constexpr size_t WS_SWT = 15 * MiB;
constexpr size_t WS_HC = 18 * MiB;
constexpr size_t WS_WIN = 26 * MiB;
constexpr size_t WS_WOUT = 42 * MiB;
constexpr size_t WS_WGU = 50 * MiB;
constexpr size_t WS_WDN = 115 * MiB;
constexpr size_t WS_ABUF = 148 * MiB;
constexpr size_t WS_FILT = 216 * MiB;
constexpr size_t WS_FILTC = WS_FILT + 16 * MiB;
constexpr size_t WS_BIG = 234 * MiB;
constexpr size_t WS_HID = WS_BIG;
constexpr size_t WS_Y2 = WS_BIG + 162 * MiB;
constexpr size_t WS_END_MOE = WS_Y2 + (size_t)SH0 * 2048;
constexpr size_t WS_P = WS_BIG;
constexpr size_t WS_QB = WS_BIG + 136 * MiB;
constexpr size_t WS_KB = WS_BIG + 170 * MiB;
constexpr size_t WS_VB = WS_BIG + 179 * MiB;
constexpr size_t WS_HT = WS_BIG + 188 * MiB;
constexpr size_t WS_HTC = WS_BIG + 284 * MiB;
constexpr size_t WS_SPEC = WS_BIG + 290 * MiB;
constexpr size_t WS_SPECC = WS_BIG + 322 * MiB;
constexpr size_t WS_RGA = WS_BIG + 324 * MiB;
constexpr size_t WS_RGB = WS_BIG + 392 * MiB;
constexpr size_t WS_MIX = WS_BIG + 460 * MiB;
constexpr size_t WS_END = WS_END_MOE;
static_assert(WS_MIX + (size_t)M * 2048 <= WS_END && WS_HID + (size_t)HIDROWS * 512 <= WS_Y2, "ws map");
constexpr int CW_BAR = 4096;
constexpr int RING_OFF = 0, RING_BYTES = 131072, SCRATCH_BYTES = 155648;
constexpr int LDSCTL_OFF = SCRATCH_BYTES, MISC_OFF = LDSCTL_OFF + 320;
constexpr int LTILES_OFF = LDSCTL_OFF + 1024;
constexpr int LDS_BYTES = 163840;
static_assert(LTILES_OFF + 1536 * 4 <= LDS_BYTES, "LDS map");

#define GAS __attribute__((address_space(1)))
#define LAS __attribute__((address_space(3)))
typedef unsigned short bf16;
typedef unsigned v4u __attribute__((ext_vector_type(4)));
typedef unsigned v2u __attribute__((ext_vector_type(2)));
typedef float f32x4 __attribute__((ext_vector_type(4)));
typedef float f32x2v __attribute__((ext_vector_type(2)));
typedef short bf16x8 __attribute__((ext_vector_type(8)));
typedef GAS unsigned gu32;
#define RLX_AGENT __ATOMIC_RELAXED, __HIP_MEMORY_SCOPE_AGENT
#define LDS_WAIT() asm volatile("s_waitcnt lgkmcnt(0)" ::: "memory")
#define VM_WAIT() asm volatile("s_waitcnt vmcnt(0)" ::: "memory")
__device__ __forceinline__ unsigned f2bf(float f) { unsigned u = __builtin_bit_cast(unsigned, f); return (u + 0x7fffu + ((u >> 16) & 1u)) >> 16; }
__device__ __forceinline__ unsigned pk2(float lo, float hi) { return f2bf(lo) | (f2bf(hi) << 16); }
__device__ __forceinline__ float bf2f(unsigned b) { return __builtin_bit_cast(float, b << 16); }
__device__ __forceinline__ float bflo(unsigned w) { return __builtin_bit_cast(float, w << 16); }
__device__ __forceinline__ float bfhi(unsigned w) { return __builtin_bit_cast(float, w & 0xffff0000u); }

#define XB_TMO      128
#define XB_XCNT(j)  (256  + 64 * (j))
#define XB_XSUB(j)  (1280 + 64 * (j))
#define XB_XGEN(j)  (2304 + 64 * (j))
#define XB_TOP      3328
#define XB_TOPGEN   3392
#define XCD_BAR_WORDS 3456
#define XB_SPIN_CAP (1u << 20)
__device__ __forceinline__ unsigned xb_ld(unsigned* p)              { return __hip_atomic_load(p, __ATOMIC_RELAXED, __HIP_MEMORY_SCOPE_AGENT); }
__device__ __forceinline__ unsigned xb_add(unsigned* p, unsigned v) { return __hip_atomic_fetch_add(p, v, __ATOMIC_RELAXED, __HIP_MEMORY_SCOPE_AGENT); }
__device__ __forceinline__ unsigned xb_xcc_id() { return (unsigned)__builtin_amdgcn_s_getreg((3 << 11) | 20) & 0xFu; }
#define XB_SPIN(cond, bar) do { unsigned _sp = 0; while (cond) { __builtin_amdgcn_s_sleep(1); \
    if ((++_sp & 255u) == 0u) { if (xb_ld(&(bar)[XB_TMO])) break; if (_sp > XB_SPIN_CAP) { atomicAdd(&(bar)[XB_TMO], 1u); break; } } } } while (0)
struct XcdBarrier { unsigned* bar; unsigned x; volatile LAS unsigned* st; };
__device__ __forceinline__ XcdBarrier xcd_barrier_post(unsigned* bar, volatile LAS unsigned* st) {
    XcdBarrier b; b.bar = bar; b.x = xb_xcc_id(); b.st = st;
    if (threadIdx.x == 0) (void)xb_add(&bar[XB_XCNT(b.x)], 1u);
    return b;
}
__device__ __forceinline__ void xcd_barrier_complete(unsigned* bar, unsigned x, unsigned& nloc, unsigned& nx) {
    const unsigned G = gridDim.x * gridDim.y * gridDim.z;
    unsigned sum, cnt, mine, sp = 0u;
    for (;;) {
        sum = 0u; cnt = 0u; mine = 0u;
#pragma unroll
        for (unsigned j = 0; j < 16; ++j) { const unsigned c = xb_ld(&bar[XB_XCNT(j)]); sum += c; cnt += (c > 0u) ? 1u : 0u; mine = (j == x) ? c : mine; }
        if (sum == G) break;
        __builtin_amdgcn_s_sleep(1);
        if ((++sp & 255u) == 0u) { if (xb_ld(&bar[XB_TMO])) break; if (sp > XB_SPIN_CAP) { atomicAdd(&bar[XB_TMO], 1u); break; } }
    }
    nloc = mine > 0u ? mine : 1u; nx = cnt > 0u ? cnt : 1u;
}
__device__ __forceinline__ void xcd_barrier(const XcdBarrier& b) {
    asm volatile("s_waitcnt vmcnt(0)" ::: "memory");
    __syncthreads();
    if (threadIdx.x == 0) {
        unsigned* bar = b.bar;
        __builtin_amdgcn_s_waitcnt(0);
        unsigned nloc = b.st[0], nx = b.st[1];
        if (nloc == 0u) { xcd_barrier_complete(bar, b.x, nloc, nx); b.st[0] = nloc; b.st[1] = nx; }
        const unsigned old = xb_add(&bar[XB_XSUB(b.x)], 1u);
        const unsigned gen = old / nloc;
        if (old + 1u == (gen + 1u) * nloc) {
            __builtin_amdgcn_fence(__ATOMIC_RELEASE, "agent");
            asm volatile("s_waitcnt vmcnt(0)" ::: "memory");
            const unsigned og = xb_add(&bar[XB_TOP], 1u);
            const unsigned tg = og / nx;
            if (og + 1u == (tg + 1u) * nx) xb_add(&bar[XB_TOPGEN], 1u);
            else XB_SPIN(xb_ld(&bar[XB_TOPGEN]) == tg, bar);
            __builtin_amdgcn_fence(__ATOMIC_ACQUIRE, "agent");
            xb_add(&bar[XB_XGEN(b.x)], 1u);
            asm volatile("s_waitcnt vmcnt(0)" ::: "memory");
        } else {
            XB_SPIN(xb_ld(&bar[XB_XGEN(b.x)]) == gen, bar);
            __builtin_amdgcn_fence(__ATOMIC_ACQUIRE, "agent");
            asm volatile("s_waitcnt vmcnt(0)" ::: "memory");
        }
    }
    __syncthreads();
}

struct Args { const float* in[N_IN]; float* out; unsigned char* ws; };
struct Frame {
    LAS unsigned char* lds; char* ldsg; volatile LAS unsigned* MISC; gu32* ctl; unsigned char* ws; float* out;
    int tid, lane, wave, vcu, G, z;
};
__device__ __forceinline__ Frame fresh(const Frame& F0) {
    Frame F = F0; int t = F0.tid; asm volatile("" : "+v"(t)); F.tid = t; F.lane = t & 63; F.wave = __builtin_amdgcn_readfirstlane(t >> 6);
    unsigned long long z = 0; asm volatile("" : "+s"(z)); F.ws = F0.ws + z; F.out = F0.out + z; F.z = (int)z; return F;
}
__device__ __forceinline__ float wave_sum(float v) {
#pragma unroll
    for (int o = 1; o < 64; o <<= 1) v += __shfl_xor(v, o);
    return v;
}
__device__ __forceinline__ float sigmoidf_(float x) { return 1.0f / (1.0f + __expf(-x)); }
__device__ __forceinline__ float siluf_(float x) { return x / (1.0f + __expf(-x)); }
__device__ __forceinline__ const float* modv(const Frame& F, int l, int r, int k) { return (const float*)(F.ws + WS_MODV) + ((size_t)(l * 9 + r) * 6 + k) * 1024; }
__device__ __forceinline__ int modrow_of(int R) { return R < ML ? (R >> 12) : 8; }
__device__ __forceinline__ void transpose_item(const float* W, int N, bf16* WT, int Kdst, int k0, int n0, int drow0, LAS float* scr, int lane) {
#pragma unroll 8
    for (int i = 0; i < 32; ++i) { const int kk = 2 * i + (lane >> 5); scr[kk * 33 + (lane & 31)] = W[(size_t)(k0 + kk) * N + n0 + (lane & 31)]; }
    LDS_WAIT(); asm volatile("" ::: "memory");
    const int c = lane & 7;
#pragma unroll
    for (int j = 0; j < 4; ++j) { const int n = (lane >> 3) + 8 * j; const LAS float* s = scr + (8 * c) * 33 + n;
        v4u o; o.x = pk2(s[0 * 33], s[1 * 33]); o.y = pk2(s[2 * 33], s[3 * 33]); o.z = pk2(s[4 * 33], s[5 * 33]); o.w = pk2(s[6 * 33], s[7 * 33]);
        *(GAS v4u*)(WT + (size_t)(drow0 + n) * Kdst + k0 + 8 * c) = o; }
    LDS_WAIT(); asm volatile("" ::: "memory");
}

__device__ __forceinline__ void phase_prologue_a(Frame& F0, const Args& A) {
    Frame F = fresh(F0);
    const int gw = F.vcu * NWAVES + F.wave, NGW = F.G * NWAVES;
    const int gt = F.vcu * 512 + F.tid, NGT = F.G * 512;
    {
        LAS float* sc = (LAS float*)(F.lds);
        LAS float* red = (LAS float*)(F.lds + 40960);
        for (int i = F.tid; i < 9 * 1024; i += 512) { const int r = i >> 10, k = i & 1023; const float v = r < 8 ? A.in[I_C + F.z][r * 1024 + k] : A.in[I_CCTX + F.z][k]; sc[i] = siluf_(v); }
        __syncthreads();
        const int col = F.tid & 31, ks = F.tid >> 5;
        for (int u = F.vcu; u < 4 * 192; u += F.G) {
            const int l = u / 192, j0 = (u % 192) * 32;
            const float* W = A.in[I_WMOD + F.z] + (size_t)l * 1024 * 6144 + j0 + col;
            float acc[9];
#pragma unroll
            for (int r = 0; r < 9; ++r) acc[r] = 0.f;
#pragma unroll 4
            for (int kk = 0; kk < 64; ++kk) { const int k = ks * 64 + kk; const float w = W[(size_t)k * 6144];
#pragma unroll
                for (int r = 0; r < 9; ++r) acc[r] += sc[r * 1024 + k] * w; }
#pragma unroll
            for (int r = 0; r < 9; ++r) red[(ks * 9 + r) * 32 + col] = acc[r];
            __syncthreads();
            if (F.tid < 288) { const int r = F.tid >> 5, c = F.tid & 31; float s = A.in[I_BMOD + F.z][l * 6144 + j0 + c];
#pragma unroll
                for (int q = 0; q < 16; ++q) s += red[(q * 9 + r) * 32 + c];
                ((float*)(F.ws + WS_MODV))[((size_t)(l * 9 + r)) * 6144 + j0 + c] = s; }
            __syncthreads();
        }
    }
    {
        LAS float* scr = (LAS float*)(F.lds + F.wave * 16384);
        constexpr int I_IN = (D / 64) * (PROJ / 32), I_OUT = (D / 64) * (D / 32);
        for (int it = gw; it < DEPTH * (I_IN + I_OUT); it += NGW) {
            const int l = it / (I_IN + I_OUT); int r = it % (I_IN + I_OUT);
            if (r < I_IN) { const int kb = r / (PROJ / 32), nb = r % (PROJ / 32);
                transpose_item(A.in[I_WIN + F.z] + (size_t)l * D * PROJ, PROJ, (bf16*)(F.ws + WS_WIN) + (size_t)l * PROJ * D, D, kb * 64, nb * 32, nb * 32, scr, F.lane); }
            else { r -= I_IN; const int kb = r / (D / 32), nb = r % (D / 32);
                transpose_item(A.in[I_WOUT + F.z] + (size_t)l * D * D, D, (bf16*)(F.ws + WS_WOUT) + (size_t)l * D * D, D, kb * 64, nb * 32, nb * 32, scr, F.lane); }
        }
    }
    for (int i = gt; i < DEPTH * NEXP * D; i += NGT) { const int l = i >> 16, e = (i >> 10) & 63, k = i & 1023;
        const float v = A.in[I_WR + F.z][((size_t)l * D + k) * NEXP + e]; const unsigned h = f2bf(v); const float lo = v - bf2f(h);
        ((bf16*)(F.ws + WS_RTHI))[i] = (bf16)h; ((bf16*)(F.ws + WS_RTLO))[i] = (bf16)f2bf(lo); }
    for (int i = gt; i < DEPTH * 2 * 2 * 4 * 64 * 64; i += NGT) { const int k = i & 63, n = (i >> 6) & 63, blk = (i >> 12) & 3, gate = (i >> 14) & 1, d = (i >> 15) & 1, l = i >> 16;
        const float* src = gate ? A.in[I_RGWX + F.z] : A.in[I_RGWA + F.z];
        ((bf16*)(F.ws + WS_RGW))[i] = (bf16)f2bf(src[((((size_t)l * 2 + d) * 4 + blk) * 64 + k) * 64 + n]); }
    for (int i = gt; i < 4096; i += NGT) { float s, c; sincospif(-(float)i * (1.0f / 4096.0f), &s, &c); ((f32x2v*)(F.ws + WS_TW))[i] = (f32x2v){c, s}; }
    for (int i = gt; i < T * 32; i += NGT) { const int t = i >> 5, p = i & 31; const float pos = (float)(p < 16 ? (t >> 6) : (t & 63));
        const float invf = powf(10000.0f, -(float)(p & 15) * (1.0f / 16.0f)); const float ang = pos * invf; float s, c; sincosf(ang, &s, &c); ((f32x2v*)(F.ws + WS_ROPE))[i] = (f32x2v){c, s}; }
}

__device__ __forceinline__ void modulate_row_bf16(const Frame& F, const float* hrow, const float* sh, const float* sc, bf16* orow) {
    const GAS f32x4* xr = (const GAS f32x4*)hrow + F.lane; const f32x4* shv = (const f32x4*)sh + F.lane; const f32x4* scv = (const f32x4*)sc + F.lane;
    GAS v2u* o8 = (GAS v2u*)orow + F.lane;
#pragma unroll
    for (int j = 0; j < 4; ++j) { const f32x4 v = xr[64 * j], a = shv[64 * j], b = scv[64 * j]; const f32x4 y = v * (b + 1.0f) + a; v2u o; o.x = pk2(y.x, y.y); o.y = pk2(y.z, y.w); o8[64 * j] = o; }
}
__device__ __forceinline__ void phase_prologue_b(Frame& F0, const Args& A) {
    Frame F = fresh(F0);
    const int gw = F.vcu * NWAVES + F.wave, NGW = F.G * NWAVES;
    for (int R = gw; R < M; R += NGW) { const int mr = modrow_of(R);
        const float* src = R < ML ? A.in[I_X + F.z] + (size_t)R * D : A.in[I_CTX + F.z] + (size_t)(R - ML) * D;
        modulate_row_bf16(F, src, modv(F, 0, mr, 0), modv(F, 0, mr, 1), (bf16*)(F.ws + WS_ABUF) + (size_t)R * D); }
}

__device__ __forceinline__ void phase_prep(Frame& F0, const Args& A, int l, bool do_moe, bool do_hy) {
    Frame F = fresh(F0);
    const int gw = F.vcu * NWAVES + F.wave, NGW = F.G * NWAVES;
    if (do_moe) {
        LAS float* scr = (LAS float*)(F.lds + F.wave * 16384);
        bf16* WGU = (bf16*)(F.ws + WS_WGU); bf16* WDN = (bf16*)(F.ws + WS_WDN);
        for (int it = gw; it < 65 * 384; it += NGW) {
            const int e = it / 384; int r = it % 384;
            const int which = r >> 7; r &= 127;
            if (which < 2) { const float* W = e < 64 ? (which == 0 ? A.in[I_WG + F.z] : A.in[I_WU + F.z]) + ((size_t)l * 64 + e) * (D * FF) : (which == 0 ? A.in[I_WSG + F.z] : A.in[I_WSU + F.z]) + (size_t)l * (D * FF);
                const int kb = r >> 3, nb = r & 7, n0 = nb * 32;
                transpose_item(W, FF, WGU + (size_t)e * 512 * D, D, kb * 64, n0, (n0 >> 7) * 256 + which * 128 + (n0 & 127), scr, F.lane); }
            else { const float* W = e < 64 ? A.in[I_WD + F.z] + ((size_t)l * 64 + e) * (FF * D) : A.in[I_WSD + F.z] + (size_t)l * (FF * D);
                const int kb = r >> 5, nb = r & 31;
                transpose_item(W, D, WDN + (size_t)e * D * FF, FF, kb * 64, nb * 32, nb * 32, scr, F.lane); }
        }
    }
    if (do_hy) {
        __syncthreads();
        LAS float* zb = (LAS float*)F.lds;
        LAS float* f1 = (LAS float*)(F.lds + 2048);
        LAS float* f2 = (LAS float*)(F.lds + 8192);
        const float* w1 = A.in[I_HYW1 + F.z] + (size_t)l * 17 * 64; const float* b1 = A.in[I_HYB1 + F.z] + l * 64; const float* fq = A.in[I_HYFREQ + F.z] + l * 64;
        const float* w2 = A.in[I_HYW2 + F.z] + (size_t)l * 64 * 64; const float* b2 = A.in[I_HYB2 + F.z] + l * 64; const float* w3 = A.in[I_HYW3 + F.z] + (size_t)l * 64 * 1024;
        const int nun = 256 + (l < DEPTH - 1 ? 16 : 0);
        for (int u = F.vcu; u < nun; u += F.G) {
            const bool lat = u < 256; const int L = lat ? T : LC; const int n0 = (lat ? u : u - 256) * 16;
            float* FT = (float*)(F.ws + (lat ? WS_FILT : WS_FILTC));
            if (F.tid < 16 * 17) { const int p = F.tid / 17, i = F.tid % 17; const int n = n0 + p; float z;
                if (i == 0) z = (float)n / (float)(L - 1);
                else { const int bi = (i - 1) & 7; const float band = 1e-4f + (float)bi * ((7.0f - 1e-4f) / 7.0f); const float w = 6.283185307179586f * (float)n / (float)L; const float a = band * w;
                    z = (i <= 8) ? cosf(a) : -sinf(a); }
                zb[p * 17 + i] = z; }
            __syncthreads();
            for (int o = F.tid; o < 16 * 64; o += 512) { const int p = o >> 6, j = o & 63; float s = b1[j];
#pragma unroll
                for (int i = 0; i < 17; ++i) s += zb[p * 17 + i] * w1[i * 64 + j];
                f1[o] = sinf(fq[j] * s); }
            __syncthreads();
            for (int o = F.tid; o < 16 * 64; o += 512) { const int p = o >> 6, j = o & 63; float s = b2[j];
#pragma unroll 8
                for (int i = 0; i < 64; ++i) s += f1[p * 64 + i] * w2[i * 64 + j];
                f2[o] = sinf(fq[j] * s); }
            __syncthreads();
#pragma unroll
            for (int cc = 0; cc < 2; ++cc) { const int col = F.tid + cc * 512; float acc[16];
#pragma unroll
                for (int p = 0; p < 16; ++p) acc[p] = 0.f;
                for (int k = 0; k < 64; ++k) { const float w = w3[k * 1024 + col];
#pragma unroll
                    for (int p = 0; p < 16; ++p) acc[p] += f2[p * 64 + k] * w; }
                const int c = col & 255; const float delta = 3.0701134573253945f + (float)c * ((15.350567286626973f - 3.0701134573253945f) / 255.0f);
#pragma unroll
                for (int p4 = 0; p4 < 4; ++p4) { f32x4 o;
#pragma unroll
                    for (int q = 0; q < 4; ++q) { const int n = n0 + p4 * 4 + q; const float tt = (float)n / (float)(L - 1); o[q] = acc[p4 * 4 + q] * __expf(-tt * delta); }
                    *(f32x4*)(FT + (size_t)col * L + n0 + p4 * 4) = o; } }
            __syncthreads();
        }
    }
}
struct TwHalf { const LAS f32x2v* T; __device__ __forceinline__ f32x2v operator[](int k) const { const f32x2v w = T[k & 2047]; return (k & 2048) ? (f32x2v){w.y, -w.x} : w; } };
#define PADI(e) ((e) + (((e) >> 5) << 1))
template <int R, class XT, class TWT>
__device__ __forceinline__ void dif_task(XT X, TWT tw, int s, int task) {
    const int lgM = 13 - s, lgq = lgM - R, q = 1 << lgq;
    const int j0 = task & (q - 1), blk = task >> lgq, base = (blk << lgM) + j0;
    f32x2v v[1 << R];
#pragma unroll
    for (int k = 0; k < (1 << R); ++k) v[k] = X[PADI(base + (k << lgq))];
#pragma unroll
    for (int r = 0; r < R; ++r) {
        constexpr int dummy = 0; (void)dummy;
        const int pb = R - 1 - r;
#pragma unroll
        for (int k = 0; k < (1 << R); ++k) if (!((k >> pb) & 1)) {
            const int klo = k & ((1 << pb) - 1);
            const f32x2v w = tw[(j0 + (klo << lgq)) << (s + r)];
            const f32x2v a = v[k], b = v[k + (1 << pb)], d = a - b;
            v[k] = a + b; v[k + (1 << pb)] = (f32x2v){d.x * w.x - d.y * w.y, d.x * w.y + d.y * w.x};
        }
    }
#pragma unroll
    for (int k = 0; k < (1 << R); ++k) X[PADI(base + (k << lgq))] = v[k];
}
template <int R, class XT, class TWT>
__device__ __forceinline__ void dit_task(XT X, TWT tw, int s, int task) {
    const int lgM = 13 - s, lgq = lgM - R, q = 1 << lgq;
    const int j0 = task & (q - 1), blk = task >> lgq, base = (blk << lgM) + j0;
    f32x2v v[1 << R];
#pragma unroll
    for (int k = 0; k < (1 << R); ++k) v[k] = X[PADI(base + (k << lgq))];
#pragma unroll
    for (int r = R - 1; r >= 0; --r) {
        const int pb = R - 1 - r;
#pragma unroll
        for (int k = 0; k < (1 << R); ++k) if (!((k >> pb) & 1)) {
            const int klo = k & ((1 << pb) - 1);
            const f32x2v w = tw[(j0 + (klo << lgq)) << (s + r)];
            const f32x2v a = v[k], qv = v[k + (1 << pb)]; const f32x2v b = (f32x2v){qv.x * w.x + qv.y * w.y, qv.y * w.x - qv.x * w.y};
            v[k] = a + b; v[k + (1 << pb)] = a - b;
        }
    }
#pragma unroll
    for (int k = 0; k < (1 << R); ++k) X[PADI(base + (k << lgq))] = v[k];
}

__device__ __forceinline__ void load_tw(Frame& F, LAS f32x2v* tw) { const f32x2v* g = (const f32x2v*)(F.ws + WS_TW); for (int i = F.tid; i < 2048; i += 512) tw[i] = g[i]; }
__device__ __forceinline__ void fft_fwd_upper(LAS f32x2v* X, TwHalf tw, int s0, int tid) {
    if (s0 == 0) { dif_task<4>(X, tw, 0, tid); __syncthreads(); }
    dif_task<4>(X, tw, 4, tid); __syncthreads();
    dif_task<4>(X, tw, 8, tid); __syncthreads();
}
__device__ __forceinline__ void fft_inv_upper(LAS f32x2v* X, TwHalf tw, int s0, int tid) {
    dit_task<4>(X, tw, 8, tid); __syncthreads();
    dit_task<4>(X, tw, 4, tid); __syncthreads();
    if (s0 == 0) { dit_task<4>(X, tw, 0, tid); __syncthreads(); }
}

__device__ __forceinline__ void phase_spectra(Frame& F0, int l) {
    Frame F = fresh(F0);
    LAS f32x2v* X = (LAS f32x2v*)F.lds; LAS f32x2v* twl = (LAS f32x2v*)(F.lds + 69632); const TwHalf tw{twl};
    __syncthreads(); load_tw(F, twl);
    const int nun = 512 + (l < DEPTH - 1 ? 32 : 0);
    for (int u = F.vcu; u < nun; u += F.G) {
        const bool lat = u < 512; const int L = lat ? T : LC, lgN = lat ? 13 : 9, N = 2 * L; const int col0 = lat ? u : (u - 512) * 16;
        const float* FT = (const float*)(F.ws + (lat ? WS_FILT : WS_FILTC));
        __syncthreads();
#pragma unroll 4
        for (int r = 0; r < 16; ++r) { const int e = F.tid + 512 * r, seg = e >> lgN, n = e & (N - 1); const int oc = col0 + seg;
            float v = 0.f;
            if (n < L) v = FT[(size_t)oc * L + n]; else if (n > L) v = FT[(size_t)(512 + oc) * L + (N - n)];
            X[PADI(e)] = (f32x2v){v, 0.f}; }
        __syncthreads();
        fft_fwd_upper(X, tw, 13 - lgN, F.tid);
        f32x2v* SP = (f32x2v*)(F.ws + (lat ? WS_SPEC : WS_SPECC)) + (size_t)col0 * N; const float sc = 1.0f / (float)N;
#pragma unroll 2
        for (int r = 0; r < 8; ++r) { const int e = 2 * (F.tid + 512 * r); const f32x2v a = X[PADI(e)], b = X[PADI(e + 1)];
            *(f32x4*)(SP + e) = (f32x4){(a.x + b.x) * sc, (a.y + b.y) * sc, (a.x - b.x) * sc, (a.y - b.y) * sc}; }
    }
    __syncthreads();
}

__device__ __forceinline__ void phase_hyconv(Frame& F0, const Args& A, int l) {
    Frame F = fresh(F0);
    LAS f32x2v* X = (LAS f32x2v*)F.lds; LAS f32x2v* twl = (LAS f32x2v*)(F.lds + 69632); const TwHalf tw{twl};
    LAS bf16* OUT = (LAS bf16*)(F.lds + 69632 + 16384);
    __syncthreads(); load_tw(F, twl);
    const int nun = 256 + (l < DEPTH - 1 ? 64 : 0);
    const float* skip = A.in[I_HYSKIP + F.z] + (size_t)l * 512;
    bf16* MIX = (bf16*)(F.ws + WS_MIX);
    for (int u = F.vcu; u < nun; u += F.G) {
        const bool lat = u < 256; const int L = lat ? T : LC, lgN = lat ? 13 : 9, N = 2 * L;
        const int bp = lat ? (u >> 6) : ((u - 256) >> 4), cbase = lat ? (u & 63) * 4 : ((u - 256) & 15) * 16;
        float* H0 = (float*)(F.ws + (lat ? WS_HT : WS_HTC)) + (size_t)(2 * bp) * 768 * L; float* H1 = H0 + (size_t)768 * L;
        const int rowb = lat ? (2 * bp) * T : ML + (2 * bp) * LC;
        const int nci = lat ? 4 : 1;
#pragma unroll 1
        for (int ci = 0; ci < nci; ++ci) {
            const int c0 = cbase + ci;
            const f32x2v* SPb = (const f32x2v*)(F.ws + (lat ? WS_SPEC : WS_SPECC)) + (size_t)c0 * N;
            __syncthreads();
#pragma unroll 2
            for (int r = 0; r < 16; ++r) { const int e = F.tid + 512 * r, seg = e >> lgN, n = e & (N - 1); f32x2v v = (f32x2v){0.f, 0.f};
                if (n < L) { const size_t o = (size_t)(512 + c0 + seg) * L + n; v = (f32x2v){H0[o], H1[o]}; }
                X[PADI(e)] = v; }
            __syncthreads();
#pragma unroll 1
            for (int ord = 0; ord < 2; ++ord) {
                fft_fwd_upper(X, tw, 13 - lgN, F.tid);
                const f32x2v* SP = SPb + (size_t)ord * 256 * N;
#pragma unroll 2
                for (int r = 0; r < 8; ++r) { const int e = 2 * (F.tid + 512 * r);
                    const f32x2v a = X[PADI(e)], b = X[PADI(e + 1)]; const f32x4 k = *(const f32x4*)(SP + e);
                    const f32x2v p = a + b, q = a - b; const f32x2v pk = (f32x2v){p.x * k.x - p.y * k.y, p.x * k.y + p.y * k.x}, qk = (f32x2v){q.x * k.z - q.y * k.w, q.x * k.w + q.y * k.z};
                    X[PADI(e)] = pk + qk; X[PADI(e + 1)] = pk - qk; }
                __syncthreads();
                fft_inv_upper(X, tw, 13 - lgN, F.tid);
#pragma unroll 2
                for (int r = 0; r < 16; ++r) { const int e = F.tid + 512 * r, seg = e >> lgN, n = e & (N - 1);
                    f32x2v z = (f32x2v){0.f, 0.f};
                    if (n < L) { const int c = c0 + seg; const size_t og = (size_t)(ord * 256 + c) * L + n, ov = (size_t)(512 + c) * L + n;
                        const f32x2v g = (f32x2v){H0[og], H1[og]}, zp = (f32x2v){H0[ov], H1[ov]}; const float sk = skip[ord * 256 + c];
                        z = g * (X[PADI(e)] + zp * sk);
                        if (ord == 0) { H0[ov] = z.x; H1[ov] = z.y; }
                        else if (lat) { OUT[n * 4 + ci] = (bf16)f2bf(z.x); OUT[(T + n) * 4 + ci] = (bf16)f2bf(z.y); }
                        else { const size_t row0 = (size_t)(rowb + n); MIX[row0 * 1024 + c] = (bf16)f2bf(z.x); MIX[(row0 + L) * 1024 + c] = (bf16)f2bf(z.y); } }
                    if (ord == 0) X[PADI(e)] = z; }
                __syncthreads();
            }
        }
        if (lat) {
#pragma unroll 4
            for (int r = 0; r < 16; ++r) { const int rr = F.tid + 512 * r; const v2u o = *(const LAS v2u*)(OUT + rr * 4); *(v2u*)(MIX + (size_t)(rowb + rr) * 1024 + cbase) = o; }
        }
    }
    __syncthreads();
}
__device__ __forceinline__ void phase_qkv_rows(Frame& F0, const Args& A, int l) {
    Frame F = fresh(F0);
    const int gw = F.vcu * NWAVES + F.wave, NGW = F.G * NWAVES, lane = F.lane;
    const bf16* P = (const bf16*)(F.ws + WS_P); bf16* QB = (bf16*)(F.ws + WS_QB); bf16* KB = (bf16*)(F.ws + WS_KB); bf16* VB = (bf16*)(F.ws + WS_VB);
    const float* qg = A.in[I_QN + F.z] + l * 64; const float* kg = A.in[I_KN + F.z] + l * 64; const f32x2v* rope = (const f32x2v*)(F.ws + WS_ROPE);
    const bool last = (l == DEPTH - 1);
    float qgl[8]; { const int d0 = (8 * lane) & 63;
#pragma unroll
        for (int j = 0; j < 8; ++j) qgl[j] = qg[d0 + j]; }
    const float kg0 = kg[(2 * lane) & 63], kg1 = kg[((2 * lane) & 63) + 1];
    for (int R = gw; R < M; R += NGW) {
        const bool lat = R < ML; const int b = lat ? (R >> 12) : ((R - ML) >> 8); const int t = lat ? (R & 4095) : ((R - ML) & 255);
        const bf16* pr = P + (size_t)R * PROJ;
        const long kvrow = (long)b * SKV + (lat ? t : T + t);
        { const unsigned kw = *(const unsigned*)(pr + C_K + 2 * lane), vw = *(const unsigned*)(pr + C_V + 2 * lane);
            float k0 = bflo(kw), k1 = bfhi(kw); float ss = k0 * k0 + k1 * k1;
#pragma unroll
            for (int o = 1; o < 32; o <<= 1) ss += __shfl_xor(ss, o);
            const float rs = 1.0f / sqrtf(ss * (1.0f / 64.0f) + QK_EPS); k0 = k0 * rs * kg0; k1 = k1 * rs * kg1;
            if (lat) { const f32x2v cs = rope[t * 32 + (lane & 31)]; const float r0 = k0 * cs.x - k1 * cs.y, r1 = k0 * cs.y + k1 * cs.x; k0 = r0; k1 = r1; }
            *(unsigned*)(KB + kvrow * 128 + 2 * lane) = pk2(k0, k1); *(unsigned*)(VB + kvrow * 128 + 2 * lane) = vw; }
        if (lat || !last) { const v4u qw = *(const v4u*)(pr + C_Q + 8 * lane); float q[8];
            q[0] = bflo(qw.x); q[1] = bfhi(qw.x); q[2] = bflo(qw.y); q[3] = bfhi(qw.y); q[4] = bflo(qw.z); q[5] = bfhi(qw.z); q[6] = bflo(qw.w); q[7] = bfhi(qw.w);
            float ss = 0.f;
#pragma unroll
            for (int j = 0; j < 8; ++j) ss += q[j] * q[j];
            ss += __shfl_xor(ss, 1); ss += __shfl_xor(ss, 2); ss += __shfl_xor(ss, 4);
            const float rs = 1.0f / sqrtf(ss * (1.0f / 64.0f) + QK_EPS);
#pragma unroll
            for (int j = 0; j < 8; ++j) q[j] = q[j] * rs * qgl[j];
            if (lat) { const int p0 = (4 * lane) & 31;
#pragma unroll
                for (int j = 0; j < 4; ++j) { const f32x2v cs = rope[t * 32 + p0 + j]; const float r0 = q[2 * j] * cs.x - q[2 * j + 1] * cs.y, r1 = q[2 * j] * cs.y + q[2 * j + 1] * cs.x; q[2 * j] = r0; q[2 * j + 1] = r1; } }
            constexpr float C2 = 0.125f * 1.4426950408889634f;
            v4u o; o.x = pk2(q[0] * C2, q[1] * C2); o.y = pk2(q[2] * C2, q[3] * C2); o.z = pk2(q[4] * C2, q[5] * C2); o.w = pk2(q[6] * C2, q[7] * C2);
            *(v4u*)(QB + (size_t)R * 512 + 8 * lane) = o; }
    }
}

__device__ __forceinline__ void phase_hy_short(Frame& F0, const Args& A, int l) {
    Frame F = fresh(F0);
    const int gw = F.vcu * NWAVES + F.wave, NGW = F.G * NWAVES, lane = F.lane;
    LAS float* scr = (LAS float*)(F.lds + F.wave * 16384);
    const bf16* P = (const bf16*)(F.ws + WS_P);
    const float* sw = A.in[I_HYSW + F.z] + (size_t)l * 3 * 768; const float* sb = A.in[I_HYSB + F.z] + (size_t)l * 768;
    const int nlat = NB * 64 * 24, nctx = (l < DEPTH - 1) ? NB * 4 * 24 : 0;
    __syncthreads();
    for (int it = gw; it < nlat + nctx; it += NGW) {
        const bool lat = it < nlat; const int r = lat ? it : it - nlat; const int cb = r % 24; const int tb = (r / 24) % (lat ? 64 : 4); const int b = r / (24 * (lat ? 64 : 4));
        const int L = lat ? T : LC, t0 = tb * 64, c0 = cb * 32; const size_t row0 = lat ? (size_t)b * T : (size_t)ML + (size_t)b * LC;
        for (int rr = lane >> 4; rr < 66; rr += 4) { const int t = t0 - 1 + rr; float v0 = 0.f, v1 = 0.f;
            if (t >= 0 && t < L) { const unsigned w = *(const unsigned*)(P + (row0 + t) * PROJ + C_HY + c0 + 2 * (lane & 15)); v0 = bflo(w); v1 = bfhi(w); }
            scr[rr * 33 + 2 * (lane & 15)] = v0; scr[rr * 33 + 2 * (lane & 15) + 1] = v1; }
        LDS_WAIT(); asm volatile("" ::: "memory");
        float* HT = (float*)(F.ws + (lat ? WS_HT : WS_HTC)) + ((size_t)b * 768 + c0) * L + t0 + lane;
#pragma unroll 4
        for (int c = 0; c < 32; ++c) { const int ch = c0 + c; const float w0 = sw[ch], w1 = sw[768 + ch], w2 = sw[1536 + ch], bb = sb[ch];
            HT[(size_t)c * L] = scr[lane * 33 + c] * w0 + scr[(lane + 1) * 33 + c] * w1 + scr[(lane + 2) * 33 + c] * w2 + bb; }
        LDS_WAIT(); asm volatile("" ::: "memory");
    }
}

template <int CTRL> __device__ __forceinline__ float dpp_f(float old, float src) { return __builtin_bit_cast(float, __builtin_amdgcn_update_dpp(__builtin_bit_cast(int, old), __builtin_bit_cast(int, src), CTRL, 0xF, 0xF, false)); }
template <bool REV, int S> __device__ __forceinline__ void rg_scan_step(float& Av, float& Bv) {
    const float Ap = dpp_f<(REV ? 0x100 : 0x110) + S>(1.0f, Av), Bp = dpp_f<(REV ? 0x100 : 0x110) + S>(0.0f, Bv);
    Bv = Av * Bp + Bv; Av = Ap * Av;
}
__device__ __forceinline__ int rg_chain_tile(int b, int dir, int p) { return p < 4 ? 512 + 4 * b + (dir ? 3 - p : p) : 64 * b + (dir ? 67 - p : p - 4); }
template <int PASS, bool REV>
__device__ __forceinline__ void rg_wave_body(const Frame& F, const LAS bf16* UB, const bf16* Wg, const float* lam, const float* ba, const float* bx, int blk, int R0, int u, int d,
                                             f32x2v* CAR, const LAS float* CIN, LAS float* HS, const bf16* P, bf16* MIX, bool emit) {
    const int lane = F.lane, fr = lane & 15, fq = lane >> 4;
    bf16x8 uf[4][2];
#pragma unroll
    for (int tg = 0; tg < 4; ++tg)
#pragma unroll
        for (int kk = 0; kk < 2; ++kk) uf[tg][kk] = *(const LAS bf16x8*)(UB + (tg * 16 + fr) * 264 + blk * 64 + kk * 32 + fq * 8);
#pragma unroll 1
    for (int ng = 0; ng < 4; ++ng) {
        f32x4 aa[4], ax[4];
#pragma unroll
        for (int tg = 0; tg < 4; ++tg) { aa[tg] = (f32x4){0.f, 0.f, 0.f, 0.f}; ax[tg] = (f32x4){0.f, 0.f, 0.f, 0.f}; }
#pragma unroll
        for (int kk = 0; kk < 2; ++kk) { const bf16x8 wa = *(const bf16x8*)(Wg + ((size_t)(0 * 4 + blk) * 64 + ng * 16 + fr) * 64 + kk * 32 + fq * 8);
            const bf16x8 wx = *(const bf16x8*)(Wg + ((size_t)(1 * 4 + blk) * 64 + ng * 16 + fr) * 64 + kk * 32 + fq * 8);
#pragma unroll
            for (int tg = 0; tg < 4; ++tg) { aa[tg] = __builtin_amdgcn_mfma_f32_16x16x32_bf16(wa, uf[tg][kk], aa[tg], 0, 0, 0); ax[tg] = __builtin_amdgcn_mfma_f32_16x16x32_bf16(wx, uf[tg][kk], ax[tg], 0, 0, 0); } }
        const int ch = blk * 64 + ng * 16 + fq * 4; const f32x4 lv = *(const f32x4*)(lam + ch), bav = *(const f32x4*)(ba + ch), bxv = *(const f32x4*)(bx + ch);
        f32x4 sp;
#pragma unroll
        for (int j = 0; j < 4; ++j) { const float x = -lv[j]; sp[j] = fmaxf(x, 0.f) + log1pf(__expf(-fabsf(x))); }
#pragma unroll
        for (int tg = 0; tg < 4; ++tg) { const v2u uw = *(const LAS v2u*)(UB + (tg * 16 + fr) * 264 + ch); const float uv[4] = {bflo(uw.x), bfhi(uw.x), bflo(uw.y), bfhi(uw.y)};
#pragma unroll
            for (int j = 0; j < 4; ++j) { const float r = sigmoidf_(aa[tg][j] + bav[j]), ig = sigmoidf_(ax[tg][j] + bxv[j]); const float la = -8.0f * r * sp[j];
                float Av = __expf(la), Bv = sqrtf(-expm1f(2.0f * la)) * (ig * uv[j]);
                rg_scan_step<REV, 1>(Av, Bv); rg_scan_step<REV, 2>(Av, Bv); rg_scan_step<REV, 4>(Av, Bv); rg_scan_step<REV, 8>(Av, Bv);
                aa[tg][j] = Av; ax[tg][j] = Bv; } }
        const int lastl = (lane & 48) | (REV ? 0 : 15);
        if (PASS == 1) {
            f32x4 At = (f32x4){1.f, 1.f, 1.f, 1.f}, Bt = (f32x4){0.f, 0.f, 0.f, 0.f};
#pragma unroll
            for (int t4 = 0; t4 < 4; ++t4) { const int tg = REV ? 3 - t4 : t4;
#pragma unroll
                for (int j = 0; j < 4; ++j) { const float ta = __shfl(aa[tg][j], lastl), tb = __shfl(ax[tg][j], lastl); Bt[j] = ta * Bt[j] + tb; At[j] = At[j] * ta; } }
            if (fr == 0) { f32x4* cp = (f32x4*)(CAR + ((size_t)u * 2 + d) * 256 + ch); cp[0] = (f32x4){At[0], Bt[0], At[1], Bt[1]}; cp[1] = (f32x4){At[2], Bt[2], At[3], Bt[3]}; }
        } else {
            f32x4 hin = *(const LAS f32x4*)(CIN + d * 256 + ch);
#pragma unroll
            for (int t4 = 0; t4 < 4; ++t4) { const int tg = REV ? 3 - t4 : t4;
#pragma unroll
                for (int j = 0; j < 4; ++j) { const float h = aa[tg][j] * hin[j] + ax[tg][j]; ax[tg][j] = h; hin[j] = __shfl(h, lastl); } }
            LAS float* hs = HS + (ng & 1) * 4096;
            if (!REV) {
#pragma unroll
                for (int tg = 0; tg < 4; ++tg) *(LAS f32x4*)(hs + (tg * 16 + fr) * 64 + blk * 16 + fq * 4) = ax[tg];
            }
            __syncthreads();
            if (REV && emit) {
#pragma unroll
                for (int tg = 0; tg < 4; ++tg) { const int tok = tg * 16 + fr; const f32x4 hf = *(const LAS f32x4*)(hs + tok * 64 + blk * 16 + fq * 4);
                    const v2u gw = *(const v2u*)(P + (size_t)(R0 + tok) * PROJ + C_RGG + ch); const float g[4] = {bflo(gw.x), bfhi(gw.x), bflo(gw.y), bfhi(gw.y)}; float y[4];
#pragma unroll
                    for (int j = 0; j < 4; ++j) { const float x = g[j]; const float tt = tanhf(0.7978845608028654f * (x + 0.044715f * x * x * x)); y[j] = (hf[j] + ax[tg][j]) * 0.5f * x * (1.0f + tt); }
                    v2u o; o.x = pk2(y[0], y[1]); o.y = pk2(y[2], y[3]); *(v2u*)(MIX + (size_t)(R0 + tok) * 1024 + 768 + ch) = o; }
            }
        }
    }
}
template <int PASS>
__device__ __forceinline__ void phase_rg(Frame& F0, const Args& A, int l) {
    Frame F = fresh(F0);
    LAS bf16* UB = (LAS bf16*)F.lds;
    LAS float* CIN = (LAS float*)(F.lds + 34816);
    LAS float* HS = (LAS float*)(F.lds + 36864);
    const bf16* P = (const bf16*)(F.ws + WS_P); bf16* MIX = (bf16*)(F.ws + WS_MIX);
    const float* cw = A.in[I_RGCW + F.z] + (size_t)l * 4 * 256; const float* cb = A.in[I_RGCB + F.z] + (size_t)l * 256;
    const int wave = F.wave, d = wave >> 2, blk = wave & 3;
    const bf16* Wg = (const bf16*)(F.ws + WS_RGW) + ((size_t)(l * 2 + d) * 2) * 4 * 4096;
    const float* lam = A.in[I_RGLAM + F.z] + (size_t)(l * 2 + d) * 256; const float* ba = A.in[I_RGBA + F.z] + (size_t)(l * 2 + d) * 256; const float* bx = A.in[I_RGBX + F.z] + (size_t)(l * 2 + d) * 256;
    f32x2v* CAR = (f32x2v*)(F.ws + WS_RGA);
    const bool last = (l == DEPTH - 1);
    const int ntile = (PASS == 2 && last) ? ML / 64 : M / 64;
    for (int u = F.vcu; u < ntile; u += F.G) {
        const int R0 = u * 64; const bool lat = R0 < ML; const int L = lat ? T : LC; const int t0 = lat ? (R0 & 4095) : ((R0 - ML) & 255);
        __syncthreads();
        { const int tok = F.tid >> 3, cg = (F.tid & 7) * 32; const int t = t0 + tok;
#pragma unroll
            for (int c8 = 0; c8 < 4; ++c8) { const int ch = cg + c8 * 8; float acc[8];
#pragma unroll
                for (int j = 0; j < 8; ++j) acc[j] = cb[ch + j];
#pragma unroll
                for (int tap = 0; tap < 4; ++tap) { const int tt = t - 1 + tap;
                    if (tt >= 0 && tt < L) { const v4u w = *(const v4u*)(P + (size_t)(R0 + tok - 1 + tap) * PROJ + C_RGX + ch); const float* cwp = cw + tap * 256 + ch;
                        acc[0] += bflo(w.x) * cwp[0]; acc[1] += bfhi(w.x) * cwp[1]; acc[2] += bflo(w.y) * cwp[2]; acc[3] += bfhi(w.y) * cwp[3];
                        acc[4] += bflo(w.z) * cwp[4]; acc[5] += bfhi(w.z) * cwp[5]; acc[6] += bflo(w.w) * cwp[6]; acc[7] += bfhi(w.w) * cwp[7]; } }
                v4u o; o.x = pk2(acc[0], acc[1]); o.y = pk2(acc[2], acc[3]); o.z = pk2(acc[4], acc[5]); o.w = pk2(acc[6], acc[7]);
                *(LAS v4u*)(UB + tok * 264 + ch) = o; } }
        if (PASS == 2) {
            const int dir = F.tid >> 8, ch = F.tid & 255; const int b = lat ? (u >> 6) : ((u - 512) >> 2); const int i = lat ? (u & 63) : ((u - 512) & 3);
            const int pos = lat ? (dir ? 4 + 63 - i : 4 + i) : (dir ? 3 - i : i);
            float h = 0.f;
            for (int p0 = 0; p0 < pos; p0 += 8) { f32x2v cv[8];
#pragma unroll
                for (int j = 0; j < 8; ++j) { const int p = p0 + j; cv[j] = (f32x2v){1.f, 0.f}; if (p < pos) cv[j] = CAR[((size_t)rg_chain_tile(b, dir, p) * 2 + dir) * 256 + ch]; }
#pragma unroll
                for (int j = 0; j < 8; ++j) h = cv[j].x * h + cv[j].y; }
            CIN[dir * 256 + ch] = h;
        }
        __syncthreads();
        const bool emit = true;
        if (d == 0) rg_wave_body<PASS, false>(F, UB, Wg, lam, ba, bx, blk, R0, u, 0, CAR, CIN, HS, P, MIX, emit);
        else        rg_wave_body<PASS, true >(F, UB, Wg, lam, ba, bx, blk, R0, u, 1, CAR, CIN, HS, P, MIX, emit);
    }
    __syncthreads();
}

__device__ __forceinline__ void phase_attention(Frame& F0, int l) {
    Frame F = fresh(F0);
    const attn_body::bf16* Q = (const attn_body::bf16*)(F.ws + WS_QB); const attn_body::bf16* K = (const attn_body::bf16*)(F.ws + WS_KB); const attn_body::bf16* V = (const attn_body::bf16*)(F.ws + WS_VB);
    attn_body::bf16* O = (attn_body::bf16*)(F.ws + WS_MIX);
    char* shm = F.ldsg;
    for (int v = F.vcu; v < 256; v += F.G) { const int pair = v >> 4, qb = v & 15, b = pair >> 1, kvh = pair & 1;
        for (int g = 0; g < 4; ++g) { const int h = kvh * 4 + g;
            attn_body::attn_unit<8>((long)b * T + qb * 256, h * 64, (long)b * SKV, kvh * 64, SKV / 64, (long)b * T + qb * 256, 256 + h * 64, Q, K, V, O, shm); } }
    if (l < DEPTH - 1) for (int v = F.vcu; v < 64; v += F.G) { const int b = v >> 3, h = v & 7;
        attn_body::attn_unit<8>((long)ML + b * LC, h * 64, (long)b * SKV + T, (h >> 2) * 64, LC / 64, (long)ML + b * LC, 256 + h * 64, Q, K, V, O, shm); }
}
__device__ __forceinline__ float* hrow_ptr(const Frame& F, int R) { return R < ML ? F.out + (size_t)R * D : (float*)(F.ws + WS_HC) + (size_t)(R - ML) * D; }

__device__ __forceinline__ void phase_ln1(Frame& F0, const Args& A, int l, bool v_from_h) {
    Frame F = fresh(F0);
    const bool last = (l == DEPTH - 1); const int ngroups = (last ? ML : M) / 16;
    LAS bf16* MH = (LAS bf16*)F.lds;
    LAS bf16* MLo = (LAS bf16*)(F.lds + 33024);
    LAS float* PL = (LAS float*)(F.lds + 66048);
    LAS float* LOG = (LAS float*)(F.lds + 66048 + 32768);
    LAS int* lhist = (LAS int*)(F.lds + 66048 + 32768 + 4096);
    const int lane = F.lane, wave = F.wave, fr = lane & 15, fq = lane >> 4;
    const float* lg = A.in[I_LN1G + F.z] + l * D; const float* lb = A.in[I_LN1B + F.z] + l * D; const float* brt = A.in[I_BR + F.z] + l * NEXP;
    const bf16* RH = (const bf16*)(F.ws + WS_RTHI) + (size_t)l * NEXP * D; const bf16* RL = (const bf16*)(F.ws + WS_RTLO) + (size_t)l * NEXP * D;
    int* IDX = (int*)(F.ws + WS_IDX); float* WT = (float*)(F.ws + WS_WT); bf16* ABUF = (bf16*)(F.ws + WS_ABUF);
    __syncthreads();
    if (F.tid < 64) lhist[F.tid] = 0;
    f32x4 gv[4], bv[4];
#pragma unroll
    for (int j = 0; j < 4; ++j) { gv[j] = *(const f32x4*)(lg + 4 * lane + 256 * j); bv[j] = *(const f32x4*)(lb + 4 * lane + 256 * j); }
    for (int g = F.vcu; g < ngroups; g += F.G) {
        __syncthreads();
#pragma unroll
        for (int rr = 0; rr < 2; ++rr) { const int tok = 2 * wave + rr, R = g * 16 + tok; const int mr = modrow_of(R);
            float* hp = hrow_ptr(F, R); const float* vp = hp; float vs = 1.0f;
            if (v_from_h) { vs = DN_ALPHA; if (l == 0) vp = R < ML ? A.in[I_X + F.z] + (size_t)R * D : A.in[I_CTX + F.z] + (size_t)(R - ML) * D; }
            f32x4 v[4]; float s = 0.f;
#pragma unroll
            for (int j = 0; j < 4; ++j) { v[j] = *(const f32x4*)(vp + 4 * lane + 256 * j) * vs; s += (v[j].x + v[j].y) + (v[j].z + v[j].w); }
            const float mean = wave_sum(s) * (1.f / D); float s2 = 0.f;
#pragma unroll
            for (int j = 0; j < 4; ++j) { v[j] = v[j] - mean; s2 += (v[j].x * v[j].x + v[j].y * v[j].y) + (v[j].z * v[j].z + v[j].w * v[j].w); }
            const float rstd = 1.f / sqrtf(wave_sum(s2) * (1.f / D) + LN_EPS);
            const float* sh2 = modv(F, l, mr, 3); const float* sc2 = modv(F, l, mr, 4);
#pragma unroll
            for (int j = 0; j < 4; ++j) { const f32x4 h = v[j] * rstd * gv[j] + bv[j]; *(f32x4*)(hp + 4 * lane + 256 * j) = h;
                const f32x4 m = h * (*(const f32x4*)(sc2 + 4 * lane + 256 * j) + 1.0f) + *(const f32x4*)(sh2 + 4 * lane + 256 * j);
                const unsigned h0 = f2bf(m.x), h1 = f2bf(m.y), h2 = f2bf(m.z), h3 = f2bf(m.w);
                v2u hi; hi.x = h0 | (h1 << 16); hi.y = h2 | (h3 << 16);
                v2u lo; lo.x = pk2(m.x - bf2f(h0), m.y - bf2f(h1)); lo.y = pk2(m.z - bf2f(h2), m.w - bf2f(h3));
                *(v2u*)(ABUF + (size_t)R * D + 4 * lane + 256 * j) = hi;
                *(LAS v2u*)(MH + tok * 1032 + 4 * lane + 256 * j) = hi; *(LAS v2u*)(MLo + tok * 1032 + 4 * lane + 256 * j) = lo; } }
        __syncthreads();
        f32x4 acc[4];
#pragma unroll
        for (int eg = 0; eg < 4; ++eg) acc[eg] = (f32x4){0.f, 0.f, 0.f, 0.f};
#pragma unroll
        for (int kk = 0; kk < 4; ++kk) { const int k0 = wave * 128 + kk * 32 + fq * 8;
            const bf16x8 ah = *(const LAS bf16x8*)(MH + fr * 1032 + k0), al = *(const LAS bf16x8*)(MLo + fr * 1032 + k0);
#pragma unroll
            for (int eg = 0; eg < 4; ++eg) { const bf16x8 wh = *(const bf16x8*)(RH + (size_t)(eg * 16 + fr) * D + k0), wl = *(const bf16x8*)(RL + (size_t)(eg * 16 + fr) * D + k0);
                acc[eg] = __builtin_amdgcn_mfma_f32_16x16x32_bf16(wh, ah, acc[eg], 0, 0, 0);
                acc[eg] = __builtin_amdgcn_mfma_f32_16x16x32_bf16(wl, ah, acc[eg], 0, 0, 0);
                acc[eg] = __builtin_amdgcn_mfma_f32_16x16x32_bf16(wh, al, acc[eg], 0, 0, 0); } }
#pragma unroll
        for (int eg = 0; eg < 4; ++eg) *(LAS f32x4*)(PL + (wave * 16 + fr) * 64 + eg * 16 + fq * 4) = acc[eg];
        __syncthreads();
        { const int o = F.tid * 2; float s0 = 0.f, s1 = 0.f;
#pragma unroll
            for (int w = 0; w < 8; ++w) { const f32x2v p = *(const LAS f32x2v*)(PL + w * 1024 + o); s0 += p.x; s1 += p.y; }
            *(LAS f32x2v*)(LOG + o) = (f32x2v){s0, s1}; }
        __syncthreads();
#pragma unroll
        for (int rr = 0; rr < 2; ++rr) { const int tok = 2 * wave + rr, R = g * 16 + tok;
            const float score = 1.0f / (1.0f + expf(-LOG[tok * 64 + lane])); float key = score + brt[lane];
            int my_e = 0; float my_s = 0.f, ssum = 0.f;
#pragma unroll
            for (int r = 0; r < 8; ++r) { float bk = key; int bi = lane;
#pragma unroll
                for (int o = 1; o < 64; o <<= 1) { const float ok = __shfl_xor(bk, o); const int oi = __shfl_xor(bi, o); if (ok > bk || (ok == bk && oi < bi)) { bk = ok; bi = oi; } }
                const float ws = __shfl(score, bi); ssum += ws; if (lane == r) { my_e = bi; my_s = ws; } if (lane == bi) key = -INFINITY; }
            if (lane < 8) { IDX[(size_t)R * 8 + lane] = my_e; WT[(size_t)R * 8 + lane] = my_s / ssum * ROUTED_SCALE; atomicAdd((int*)&lhist[my_e], 1); } }
    }
    __syncthreads();
    if (F.tid < 64) ((int*)(F.ws + WS_HIST))[F.vcu * 64 + F.tid] = lhist[F.tid];
}

__device__ __forceinline__ void phase_sort(Frame& F0, int l) {
    Frame F = fresh(F0);
    const bool last = (l == DEPTH - 1); const int ngroups = (last ? ML : M) / 16;
    LAS int* pa = (LAS int*)F.lds;
    LAS int* pb = pa + 512;
    LAS int* tot = pb + 512;
    LAS int* mybase = tot + 64;
    LAS int* segbase = mybase + 64;
    LAS int* tpre = segbase + 80;
    LAS int* lcnt = tpre + 80;
    const int* HIST = (const int*)(F.ws + WS_HIST);
    __syncthreads();
    { const int e = F.tid & 63, part = F.tid >> 6; int sa = 0, sb = 0;
        for (int w = part * 32; w < part * 32 + 32; ++w) if (w < F.G) { const int h = HIST[w * 64 + e]; sa += h; if (w < F.vcu) sb += h; }
        pa[part * 64 + e] = sa; pb[part * 64 + e] = sb; }
    __syncthreads();
    if (F.tid < 64) { int sa = 0, sb = 0;
#pragma unroll
        for (int p = 0; p < 8; ++p) { sa += pa[p * 64 + F.tid]; sb += pb[p * 64 + F.tid]; }
        tot[F.tid] = sa; mybase[F.tid] = sb; lcnt[F.tid] = 0; }
    __syncthreads();
    if (F.tid == 0) { int s = 0, tp = 0; for (int e = 0; e < 64; ++e) { segbase[e] = s; tpre[e] = tp; const int nt = (tot[e] + 255) >> 8; s += nt * 256; tp += nt; }
        segbase[64] = s; tpre[64] = tp; tpre[65] = tp + (last ? ML : M) / 256; }
    __syncthreads();
    const int* IDX = (const int*)(F.ws + WS_IDX); const float* WT = (const float*)(F.ws + WS_WT);
    int* POS = (int*)(F.ws + WS_POS); int* STOK = (int*)(F.ws + WS_STOK); float* SWT = (float*)(F.ws + WS_SWT);
    const int mygroups = (ngroups - F.vcu + F.G - 1) / F.G;
    for (int idx = F.tid; idx < mygroups * 128; idx += 512) { const int gi = idx >> 7, w = idx & 127; const int R = (F.vcu + F.G * gi) * 16 + (w >> 3), k = w & 7;
        const int e = IDX[(size_t)R * 8 + k]; const int rank = atomicAdd((int*)&lcnt[e], 1); const int pos = segbase[e] + mybase[e] + rank;
        POS[(size_t)R * 8 + k] = pos; STOK[pos] = R; SWT[pos] = WT[(size_t)R * 8 + k]; }
    for (int e = F.vcu; e < 64; e += F.G) { const int lo = segbase[e] + tot[e], hi = segbase[e + 1]; for (int p = lo + F.tid; p < hi; p += 512) { STOK[p] = 0; SWT[p] = 0.f; } }
    if (F.vcu == 0) { unsigned* TL = (unsigned*)(F.ws + WS_TILES); const int ntot = tpre[65];
        for (int i = F.tid; i < ntot; i += 512) { int e = 0; while (e < 64 && i >= tpre[e + 1]) ++e;
            TL[i] = ((unsigned)e << 16) | (unsigned)(e < 64 ? (segbase[e] >> 8) + (i - tpre[e]) : (SH0 >> 8) + (i - tpre[64])); }
        if (F.tid == 0) TL[1536] = (unsigned)ntot; }
    __syncthreads();
}

__device__ __forceinline__ int load_tiles(Frame& F0) {
    Frame F = fresh(F0);
    const unsigned* TL = (const unsigned*)(F.ws + WS_TILES); LAS unsigned* LT = (LAS unsigned*)(F.lds + LTILES_OFF);
    __syncthreads();
    const int ntot = (int)__hip_atomic_load(TL + 1536, RLX_AGENT);
    for (int i = F.tid; i < ntot && i < 1536; i += 512) LT[i] = TL[i];
    __syncthreads();
    return __builtin_amdgcn_readfirstlane(ntot);
}

__device__ __forceinline__ void phase_ln2(Frame& F0, const Args& A, int l, bool have_moe) {
    Frame F = fresh(F0);
    const bool last = (l == DEPTH - 1); const int nrows = last ? ML : M;
    const int gw = F.vcu * NWAVES + F.wave, NGW = F.G * NWAVES, lane = F.lane;
    const float* lg = A.in[I_LN2G + F.z] + l * D; const float* lb = A.in[I_LN2B + F.z] + l * D;
    const bf16* Y2 = (const bf16*)(F.ws + WS_Y2); bf16* ABUF = (bf16*)(F.ws + WS_ABUF); const int* POS = (const int*)(F.ws + WS_POS);
    f32x4 gv[4], bv[4];
#pragma unroll
    for (int j = 0; j < 4; ++j) { gv[j] = *(const f32x4*)(lg + 4 * lane + 256 * j); bv[j] = *(const f32x4*)(lb + 4 * lane + 256 * j); }
    for (int R = gw; R < nrows; R += NGW) { const int mr = modrow_of(R);
        float* hp = hrow_ptr(F, R); const float* g2 = modv(F, l, mr, 5);
        f32x4 f[4];
#pragma unroll
        for (int j = 0; j < 4; ++j) f[j] = (f32x4){0.f, 0.f, 0.f, 0.f};
        if (have_moe) {
            { const bf16* yr = ABUF + (size_t)R * D;
#pragma unroll
                for (int j = 0; j < 4; ++j) { const v2u w = *(const v2u*)(yr + 4 * lane + 256 * j); f[j] += (f32x4){bflo(w.x), bfhi(w.x), bflo(w.y), bfhi(w.y)}; } }
            int pk = 0; if (lane < 8) pk = POS[(size_t)R * 8 + lane];
#pragma unroll
            for (int k = 0; k < 8; ++k) { const int p = __shfl(pk, k); const bf16* yr = Y2 + (size_t)p * D;
#pragma unroll
                for (int j = 0; j < 4; ++j) { const v2u w = *(const v2u*)(yr + 4 * lane + 256 * j); f[j] += (f32x4){bflo(w.x), bfhi(w.x), bflo(w.y), bfhi(w.y)}; } }
        }
        f32x4 v[4]; float s = 0.f;
#pragma unroll
        for (int j = 0; j < 4; ++j) { v[j] = *(const f32x4*)(hp + 4 * lane + 256 * j) * DN_ALPHA + *(const f32x4*)(g2 + 4 * lane + 256 * j) * f[j]; s += (v[j].x + v[j].y) + (v[j].z + v[j].w); }
        const float mean = wave_sum(s) * (1.f / D); float s2 = 0.f;
#pragma unroll
        for (int j = 0; j < 4; ++j) { v[j] = v[j] - mean; s2 += (v[j].x * v[j].x + v[j].y * v[j].y) + (v[j].z * v[j].z + v[j].w * v[j].w); }
        const float rstd = 1.f / sqrtf(wave_sum(s2) * (1.f / D) + LN_EPS);
        const float* sh1 = last ? nullptr : modv(F, l + 1, mr, 0); const float* sc1 = last ? nullptr : modv(F, l + 1, mr, 1);
#pragma unroll
        for (int j = 0; j < 4; ++j) { const f32x4 h = v[j] * rstd * gv[j] + bv[j]; *(f32x4*)(hp + 4 * lane + 256 * j) = h;
            if (!last) { const f32x4 a = h * (*(const f32x4*)(sc1 + 4 * lane + 256 * j) + 1.0f) + *(const f32x4*)(sh1 + 4 * lane + 256 * j);
                v2u o; o.x = pk2(a.x, a.y); o.y = pk2(a.z, a.w); *(v2u*)(ABUF + (size_t)R * D + 4 * lane + 256 * j) = o; } }
    }
}
#ifndef MK_MIXER
#define MK_MIXER 7
#endif
#ifndef MK_MOE
#define MK_MOE 1
#endif
#ifndef MK_PHASES
#define MK_PHASES 0xFFFFFFFFu
#endif
#define PH(n) ((MK_PHASES >> (n)) & 1u)
#ifndef MK_REP
#define MK_REP 0u
#endif
#define REP(n) ((MK_REP >> (n)) & 1u)
__device__ __forceinline__ void zero_mix_cols(Frame& F, int c0, int ncols) {
    bf16* MIX = (bf16*)(F.ws + WS_MIX); const int per = ncols / 8; const size_t tot = (size_t)M * per;
    for (size_t i = (size_t)F.vcu * 512 + F.tid; i < tot; i += (size_t)F.G * 512) { const size_t R = i / per; const int c = (int)(i % per) * 8; *(v4u*)(MIX + R * 1024 + c0 + c) = (v4u){0u, 0u, 0u, 0u}; }
}
__global__ void __launch_bounds__(NWAVES * 64, 2) mk_fwd(Args args) {
    extern __shared__ __attribute__((aligned(16))) unsigned char lds[];
    Frame F;
    F.lds = (LAS unsigned char*)lds; F.ldsg = (char*)lds;
    F.MISC = (volatile LAS unsigned*)(F.lds + MISC_OFF);
    F.tid = threadIdx.x; F.lane = F.tid & 63; F.wave = __builtin_amdgcn_readfirstlane(F.tid >> 6);
    F.G = gridDim.x; { const int bx = blockIdx.x; F.vcu = (F.G % 8 == 0) ? (bx % 8) * (F.G / 8) + bx / 8 : bx; }
    F.ws = args.ws; F.out = args.out; F.ctl = (gu32*)(args.ws + WS_CTL); F.z = 0;
    for (int u = F.tid; u < (LDS_BYTES - LDSCTL_OFF) / 4; u += NWAVES * 64) ((LAS unsigned*)(F.lds + LDSCTL_OFF))[u] = 0u;
    __syncthreads();
    XcdBarrier bar = xcd_barrier_post((unsigned*)(F.ctl + CW_BAR), F.MISC + 8);
#define GRID_BAR() xcd_barrier(bar)
    const Args& A = args;
    if (PH(0)) phase_prologue_a(F, A);
    { float* SWT = (float*)(F.ws + WS_SWT); for (int i = F.vcu * 512 + F.tid; i < M; i += F.G * 512) SWT[SH0 + i] = 1.0f; }
    GRID_BAR();
    if (MK_MIXER && PH(1)) phase_prologue_b(F, A);
    for (int l = 0; l < DEPTH; ++l) {
        const bool last = (l == DEPTH - 1);
        if (l > 0 || MK_MIXER) GRID_BAR();
        if (MK_MIXER) {
            {
                pg8::Gemm g{(const pg8::bf16_t*)(F.ws + WS_ABUF), (const pg8::bf16_t*)(F.ws + WS_WIN) + (size_t)l * PROJ * D, M, PROJ, D, 0};
                pg8::StaticOrder S; S.init(M, PROJ, F.G, (int)blockIdx.x);
                pg8::EpiBf16 E{(pg8::bf16_t*)(F.ws + WS_P), PROJ, nullptr, 1 << 30, 0};
                if (PH(2)) { pg8::gemm_phase<pg8::EpiBf16, pg8::StaticOrder, true, false, 1024>(F.lds + RING_OFF, g, S, E); if (REP(2)) { pg8::gemm_phase<pg8::EpiBf16, pg8::StaticOrder, true, false, 1024>(F.lds + RING_OFF, g, S, E); } }
                if (PH(3)) { phase_prep(F, A, l, MK_MOE != 0, (MK_MIXER & 2) != 0); if (REP(3)) { phase_prep(F, A, l, MK_MOE != 0, (MK_MIXER & 2) != 0); } }
            }
            GRID_BAR();
            if ((MK_MIXER & 1) && PH(4)) { phase_qkv_rows(F, A, l); if (REP(4)) { phase_qkv_rows(F, A, l); } }
            if (MK_MIXER & 2) { if (PH(5)) { phase_hy_short(F, A, l); if (REP(5)) phase_hy_short(F, A, l); } if (PH(6)) { phase_spectra(F, l); if (REP(6)) phase_spectra(F, l); } }
            if ((MK_MIXER & 4) && PH(7)) { phase_rg<1>(F, A, l); if (REP(7)) { phase_rg<1>(F, A, l); } }
            GRID_BAR();
            if (MK_MIXER & 4) { if (PH(8)) phase_rg<2>(F, A, l); } else zero_mix_cols(F, 768, 256);
            if (MK_MIXER & 2) { if (PH(9)) phase_hyconv(F, A, l); } else zero_mix_cols(F, 0, 256);
            if (MK_MIXER & 1) { __syncthreads(); if (PH(10)) { phase_attention(F, l); if (REP(10)) phase_attention(F, l); } } else zero_mix_cols(F, 256, 512);
            GRID_BAR();
            {   pg8::Gemm g{(const pg8::bf16_t*)(F.ws + WS_MIX), (const pg8::bf16_t*)(F.ws + WS_WOUT) + (size_t)l * D * D, M, D, D, 0};
                pg8::StaticOrder S; S.init(M, D, F.G, (int)blockIdx.x);
                pg8::EpiResid E{l == 0 ? A.in[I_X] : F.out, l == 0 ? A.in[I_CTX] : (const float*)(F.ws + WS_HC), F.out, (float*)(F.ws + WS_HC), modv(F, l, 0, 2), 6144, ML / 256, DN_ALPHA};
                if (PH(11)) pg8::gemm_phase<pg8::EpiResid, pg8::StaticOrder, true, false, 1024>(F.lds + RING_OFF, g, S, E);
            }
            GRID_BAR();
        } else if (MK_MOE) {
            if (PH(3)) { phase_prep(F, A, l, true, false); if (REP(3)) { phase_prep(F, A, l, true, false); } }
        }
        if (PH(12)) phase_ln1(F, A, l, MK_MIXER == 0);
        GRID_BAR();
        if (MK_MOE) {
            if (PH(13)) { phase_sort(F, l); if (REP(13)) { phase_sort(F, l); } }
            GRID_BAR();
            {   const int ntiles = load_tiles(F);
                pg8::Gemm g{(const pg8::bf16_t*)(F.ws + WS_ABUF), (const pg8::bf16_t*)(F.ws + WS_WGU), M, 512, D, (size_t)512 * D * 2};
                pg8::MoeOrder S{(const LAS unsigned*)(F.lds + LTILES_OFF), ntiles, 2, F.G, F.vcu, (const int*)(F.ws + WS_STOK), SH0 / 256};
                pg8::EpiGU E{(pg8::bf16_t*)(F.ws + WS_HID), (const float*)(F.ws + WS_SWT)};
                if (PH(14)) { pg8::gemm_phase<pg8::EpiGU, pg8::MoeOrder, true, true, 1024>(F.lds + RING_OFF, g, S, E); if (REP(14)) { pg8::gemm_phase<pg8::EpiGU, pg8::MoeOrder, true, true, 1024>(F.lds + RING_OFF, g, S, E); } }
            }
            GRID_BAR();
            {   const int ntiles = load_tiles(F);
                pg8::Gemm g{(const pg8::bf16_t*)(F.ws + WS_HID), (const pg8::bf16_t*)(F.ws + WS_WDN), HIDROWS, D, FF, (size_t)D * FF * 2};
                pg8::MoeOrder S{(const LAS unsigned*)(F.lds + LTILES_OFF), ntiles, 4, F.G, F.vcu, (const int*)(F.ws + WS_STOK), SH0 / 256};
                pg8::EpiBf16 E{(pg8::bf16_t*)(F.ws + WS_Y2), D, (pg8::bf16_t*)(F.ws + WS_ABUF), SH0 / 256, SH0 / 256};
                if (PH(15)) { pg8::gemm_phase<pg8::EpiBf16, pg8::MoeOrder, true, false, 256>(F.lds + RING_OFF, g, S, E); if (REP(15)) { pg8::gemm_phase<pg8::EpiBf16, pg8::MoeOrder, true, false, 256>(F.lds + RING_OFF, g, S, E); } }
            }
            GRID_BAR();
        }
        if (PH(16)) phase_ln2(F, A, l, MK_MOE != 0);
    }
}

extern "C" void kernel_launch(void* const* d_in, const int* in_sizes, int n_in, void* d_out, int out_size, void* d_ws, size_t ws_size, hipStream_t stream) {
    static int grid = 0;
    if (grid == 0) {
        if (n_in != N_IN || in_sizes[0] != ML * D || out_size != ML * D || ws_size < WS_END) { fprintf(stderr, "kernel_launch: unexpected shapes (n_in %d in0 %d out %d ws %zu need %zu); nothing launched\n", n_in, n_in > 0 ? in_sizes[0] : -1, out_size, ws_size, (size_t)WS_END); grid = -1; return; }
        int dev = 0, cus = 0, per_cu = 0;
        if (hipGetDevice(&dev) != hipSuccess || hipDeviceGetAttribute(&cus, hipDeviceAttributeMultiprocessorCount, dev) != hipSuccess) { grid = -1; return; }
        if (hipFuncSetAttribute((const void*)mk_fwd, hipFuncAttributeMaxDynamicSharedMemorySize, LDS_BYTES) != hipSuccess) { fprintf(stderr, "kernel_launch: hipFuncSetAttribute failed\n"); grid = -1; return; }
        if (hipOccupancyMaxActiveBlocksPerMultiprocessor(&per_cu, (const void*)mk_fwd, NWAVES * 64, LDS_BYTES) != hipSuccess || per_cu < 1) { fprintf(stderr, "kernel_launch: occupancy query reports %d\n", per_cu); }
        (void)hipGetLastError();
        grid = cus;
    }
    if (grid < 0) return;
    if (hipMemsetAsync((char*)d_ws + WS_CTL, 0, CTL_ZERO_BYTES, stream) != hipSuccess) return;
    Args a{};
    for (int i = 0; i < N_IN; ++i) a.in[i] = (const float*)d_in[i];
    a.out = (float*)d_out; a.ws = (unsigned char*)d_ws;
    hipLaunchKernelGGL(mk_fwd, dim3(grid), dim3(NWAVES * 64), LDS_BYTES, stream, a);
}
```

```cpp
#include <hip/hip_runtime.h>
#include <hip/hip_bf16.h>
#include <cstdio>
#include <cstdint>
#include <cmath>
#ifndef MK_TMASK
#define MK_TMASK 0u
#endif
namespace pg8 {
#define PG8_LAS __attribute__((address_space(3)))
typedef unsigned short bf16_t;
typedef short bf16x8 __attribute__((ext_vector_type(8)));
typedef float f32x4 __attribute__((ext_vector_type(4)));
typedef unsigned u32x4 __attribute__((ext_vector_type(4)));
constexpr int BM = 256, BK = 64, HALF = 128, HTB = HALF * BK * 2  , STAGE_BYTES = 8 * HTB, NXCD = 8, WGM = 8;

__host__ __device__ __forceinline__ int lds_byte(int r, int c) { const int st = (r >> 4) * 2 + (c >> 5), rr = r & 15, cc = c & 31, ob = rr * 64 + cc * 2; return st * 1024 + (ob ^ (((ob >> 9) & 1) << 5)); }
__host__ __device__ __forceinline__ void stage_rc(int b, int& R, int& C) { const int st = b / 1024, sb = b % 1024, swz = sb ^ (((sb >> 9) & 1) << 5); R = (st >> 1) * 16 + swz / 64; C = (st & 1) * 32 + (swz % 64) / 2; }
__host__ __device__ __forceinline__ int perm32(int rho) { const int n = rho >> 4, i = rho & 15; return 8 * (i >> 2) + 4 * n + (i & 3); }

struct Unit { int pm, pn, e; };
struct Gemm { const bf16_t* A; const bf16_t* Bt; int M, N, K; size_t bstride; };

struct StaticOrder {
    int nM, nN, nwg, G, c;
    __host__ __device__ void init(int M, int N, int G_, int c_) { nM = M / BM; nN = N / BM; nwg = nM * nN; G = G_; c = c_; }
    __host__ __device__ bool next(int i, Unit& u) const {
        const long L = (long)i * G + c; if (L >= nwg) return false;
        int wgid = (int)L; { const int q = nwg / NXCD, r = nwg % NXCD, xcd = wgid % NXCD, off = wgid / NXCD; wgid = (xcd < r ? xcd * (q + 1) : r * (q + 1) + (xcd - r) * q) + off; }
        const int nig = WGM * nN, gid = wgid / nig, fm = gid * WGM, gsz = (nM - fm) < WGM ? (nM - fm) : WGM;
        u.pm = fm + ((wgid % nig) % gsz); u.pn = (wgid % nig) / gsz; u.e = 0; return true;
    }
    __device__ __forceinline__ void a_ready(const Unit&) const {}
    __device__ __forceinline__ void done(const Unit&) const {}
};

__device__ __forceinline__ unsigned cvt_pk_bf16(float lo, float hi) { unsigned r; asm volatile("v_cvt_pk_bf16_f32 %0, %1, %2" : "=v"(r) : "v"(lo), "v"(hi)); return r; }
typedef float f32x2 __attribute__((ext_vector_type(2)));
__device__ __forceinline__ unsigned pk4f8(float a, float b, float c, float d) { int w = 0; w = __builtin_amdgcn_cvt_pk_fp8_f32(a, b, w, false); w = __builtin_amdgcn_cvt_pk_fp8_f32(c, d, w, true); return (unsigned)w; }

struct EpiBf16 {
    static constexpr bool PERM = true;
    bf16_t* O; int ldc; bf16_t* O2; int pm_split; int pm_off2; bool nt;
    __device__ __forceinline__ void operator()(const f32x4 (&acc)[2][2][4][2], const Unit& u, int wr, int wc, int fr, int fq) const {
        bf16_t* base = O; int pm = u.pm; if (pm >= pm_split) { base = O2; pm -= pm_off2; }
        const int row0 = pm * BM + wr * 64 + fr; const int col0 = u.pn * BM + wc * 32 + 8 * fq;
#pragma unroll
        for (int ai = 0; ai < 2; ++ai)
#pragma unroll
            for (int m = 0; m < 4; ++m) { bf16_t* rowp = base + (size_t)(row0 + ai * HALF + m * 16) * ldc + col0;
#pragma unroll
                for (int bj = 0; bj < 2; ++bj) { const f32x4 v0 = acc[ai][bj][m][0], v1 = acc[ai][bj][m][1];
                    u32x4 w; w.x = cvt_pk_bf16(v0[0], v0[1]); w.y = cvt_pk_bf16(v0[2], v0[3]); w.z = cvt_pk_bf16(v1[0], v1[1]); w.w = cvt_pk_bf16(v1[2], v1[3]);
                    if (nt) __builtin_nontemporal_store(w, (u32x4*)(rowp + bj * HALF)); else *(u32x4*)(rowp + bj * HALF) = w; } }
    }
};
struct EpiF8 {
    static constexpr bool PERM = true;
    unsigned char* O; int ldc; unsigned char* O2; int ldc2; int pm_split; int pm_off2; float scale;
    __device__ __forceinline__ void operator()(const f32x4 (&acc)[2][2][4][2], const Unit& u, int wr, int wc, int fr, int fq) const {
        unsigned char* base = O; int pm = u.pm; int ld = ldc; if (pm >= pm_split) { base = O2; pm -= pm_off2; ld = ldc2; }
        const int row0 = pm * BM + wr * 64 + fr; const int col0 = u.pn * BM + wc * 32 + 8 * fq;
        typedef unsigned u32x2 __attribute__((ext_vector_type(2)));
#pragma unroll
        for (int ai = 0; ai < 2; ++ai)
#pragma unroll
            for (int m = 0; m < 4; ++m) { unsigned char* rowp = base + (size_t)(row0 + ai * HALF + m * 16) * ld + col0;
#pragma unroll
                for (int bj = 0; bj < 2; ++bj) { const f32x4 v0 = acc[ai][bj][m][0] * scale, v1 = acc[ai][bj][m][1] * scale;
                    u32x2 w; w.x = pk4f8(v0[0], v0[1], v0[2], v0[3]); w.y = pk4f8(v1[0], v1[1], v1[2], v1[3]);
                    *(u32x2*)(rowp + bj * HALF) = w; } }
    }
};
struct EpiResid {
    static constexpr bool PERM = true;
    const float* hs_lat; const float* hs_ctx; bf16_t* V; const float* gate; int gate_stride; int ml_tiles; float alpha;
    __device__ __forceinline__ void operator()(const f32x4 (&acc)[2][2][4][2], const Unit& u, int wr, int wc, int fr, int fq) const {
        const bool lat = u.pm < ml_tiles; const int pm = lat ? u.pm : u.pm - ml_tiles;
        const float* hs = lat ? hs_lat : hs_ctx;
        const int modrow = lat ? (u.pm >> 4) : 8;
        const int row0 = pm * BM + wr * 64 + fr, grow0 = u.pm * BM + wr * 64 + fr; const int col0 = u.pn * BM + wc * 32 + 8 * fq;
        f32x4 gv[2][2];
#pragma unroll
        for (int bj = 0; bj < 2; ++bj)
#pragma unroll
            for (int n = 0; n < 2; ++n) gv[bj][n] = *(const f32x4*)(gate + (size_t)modrow * gate_stride + col0 + bj * HALF + n * 4);
        f32x4 hv[2][2][2];
#pragma unroll
        for (int bj = 0; bj < 2; ++bj)
#pragma unroll
            for (int n = 0; n < 2; ++n) hv[0][bj][n] = *(const f32x4*)(hs + (size_t)row0 * 1024 + col0 + bj * HALF + n * 4);
#pragma unroll
        for (int st = 0; st < 8; ++st) { const int ai = st >> 2, m = st & 3;
            if (st < 7) { const int ai2 = (st + 1) >> 2, m2 = (st + 1) & 3; const size_t off2 = (size_t)(row0 + ai2 * HALF + m2 * 16) * 1024 + col0;
#pragma unroll
                for (int bj = 0; bj < 2; ++bj)
#pragma unroll
                    for (int n = 0; n < 2; ++n) hv[(st + 1) & 1][bj][n] = *(const f32x4*)(hs + off2 + bj * HALF + n * 4); }
            bf16_t* vrow = V + (size_t)(grow0 + ai * HALF + m * 16) * 1024 + col0;
#pragma unroll
            for (int bj = 0; bj < 2; ++bj) { const f32x4 v0 = hv[st & 1][bj][0] * alpha + gv[bj][0] * acc[ai][bj][m][0], v1 = hv[st & 1][bj][1] * alpha + gv[bj][1] * acc[ai][bj][m][1];
                u32x4 w; w.x = cvt_pk_bf16(v0[0], v0[1]); w.y = cvt_pk_bf16(v0[2], v0[3]); w.z = cvt_pk_bf16(v1[0], v1[1]); w.w = cvt_pk_bf16(v1[2], v1[3]);
                *(u32x4*)(vrow + bj * HALF) = w; } }
    }
};
struct EpiGU {
    static constexpr bool PERM = true;
    unsigned char* H; const float* swt;
    __device__ __forceinline__ void operator()(const f32x4 (&acc)[2][2][4][2], const Unit& u, int wr, int wc, int fr, int fq) const {
        const int row0 = u.pm * BM + wr * 64 + fr; const int col0 = u.pn * HALF + wc * 32 + 8 * fq;
        typedef unsigned u32x2 __attribute__((ext_vector_type(2)));
#pragma unroll
        for (int ai = 0; ai < 2; ++ai)
#pragma unroll
            for (int m = 0; m < 4; ++m) { const int row = row0 + ai * HALF + m * 16; const float w = swt[row];
                float h[8];
#pragma unroll
                for (int n = 0; n < 2; ++n)
#pragma unroll
                    for (int j = 0; j < 4; ++j) { const float g = acc[ai][0][m][n][j], up = acc[ai][1][m][n][j];
                        const float s = g * __builtin_amdgcn_rcpf(1.0f + __builtin_amdgcn_exp2f(-1.4426950408889634f * g)); h[n * 4 + j] = s * up * w; }
                u32x2 o; o.x = pk4f8(h[0], h[1], h[2], h[3]); o.y = pk4f8(h[4], h[5], h[6], h[7]);
                *(u32x2*)(H + (size_t)row * 256 + col0) = o; }
    }
};
struct MoeOrder {
    const PG8_LAS unsigned* tiles; int ntiles, nN, G, c; const int* stok; int sh_pm0; const PG8_LAS int* ltok;
    __device__ __forceinline__ bool next(int i, Unit& u) const {
        const int t = (i / nN) * G + c; if (t >= ntiles) return false;
        u.pn = i % nN; const unsigned pk = (unsigned)__builtin_amdgcn_readfirstlane((int)tiles[t]); u.e = (int)(pk >> 16); u.pm = (int)(pk & 0xffffu); return true;
    }
    __device__ __forceinline__ int arow_g(const Unit& u, int r) const { return u.e >= 64 ? (u.pm - sh_pm0) * BM + r : stok[u.pm * BM + r]; }
    __device__ __forceinline__ int arow(int ui, int r) const { return ltok[ui * BM + r]; }
    __device__ __forceinline__ void a_ready(const Unit&) const {}
    __device__ __forceinline__ void done(const Unit&) const {}
};

typedef int v8i_t __attribute__((ext_vector_type(8)));
typedef int v4i_t __attribute__((ext_vector_type(4)));
template <class Sched> __device__ __forceinline__ unsigned gather_off(const Sched& S, int ui, int h, int i, int t, int KB) { asm volatile("" : "+v"(t)); int R, C; stage_rc(t * 16 + i * 8192, R, C); return (unsigned)(S.arow(ui, h * HALF + R) * KB + C * 2); }
__device__ __forceinline__ const char* uptr(const char* p) { const unsigned long long v = (unsigned long long)p; const unsigned lo = (unsigned)__builtin_amdgcn_readfirstlane((int)(unsigned)v), hi = (unsigned)__builtin_amdgcn_readfirstlane((int)(unsigned)(v >> 32)); return (const char*)(((unsigned long long)hi << 32) | lo); }
__device__ __forceinline__ void pg8_tm(volatile PG8_LAS unsigned* m, int wid, int lane, int id) {
    if (MK_TMASK && wid == 0 && lane == 0) { const unsigned long long now = __builtin_amdgcn_s_memrealtime(); const unsigned long long tp = (unsigned long long)m[16] | ((unsigned long long)m[17] << 32); unsigned long long ta = (unsigned long long)m[18] | ((unsigned long long)m[19] << 32);
        if ((MK_TMASK >> m[20]) & 1u) ta += now - tp; m[16] = (unsigned)now; m[17] = (unsigned)(now >> 32); m[18] = (unsigned)ta; m[19] = (unsigned)(ta >> 32); m[20] = (unsigned)id; }
}
template <class Epi, class Sched, bool ALIGN_EPI, bool GATHER, int KC, bool F8 = false, bool TIMED = false>
__device__ __forceinline__ void gemm_phase(PG8_LAS unsigned char* lds, const Gemm g, const Sched& S, const Epi& E, int wave_, volatile PG8_LAS unsigned* tmisc = nullptr, int tseg_after = 0) {
    int lane_ = (int)__builtin_amdgcn_mbcnt_hi(~0u, __builtin_amdgcn_mbcnt_lo(~0u, 0u)); asm volatile("" : "+s"(wave_), "+v"(lane_));
    const int tid_ = wave_ * 64 + lane_;
    const int tid = tid_, wid = wave_, lane = tid & 63, wr = wid >> 2, wc = wid & 3, fr = lane & 15, fq = lane >> 4;
    constexpr int K = KC, KB = F8 ? KC : KC * 2, nt = KB / (BK * 2);
    unsigned voffB[2];
    unsigned oc[2][2];
    const size_t hstep = (size_t)HALF * KB;
#pragma unroll
    for (int i = 0; i < 2; ++i) { int R, C; stage_rc(tid * 16 + i * 8192, R, C); const int Rb = Epi::PERM ? ((R & ~31) + perm32(R & 31)) : R;
        voffB[i] = (unsigned)(Rb * KB + C * 2);
        oc[0][i] = (unsigned)(R * KB + C * 2); oc[1][i] = oc[0][i] + (unsigned)hstep; }
    const size_t kstep = (size_t)(BK * 2);
    const size_t tstep = 2 * hstep;
    const unsigned ldsw = (unsigned)wid * 1024u;
    const int aoff = lds_byte(wr * 64 + fr, fq * 8), boff = lds_byte(wc * 32 + fr, fq * 8);
    const int a8 = lds_byte(wr * 64 + fr, fq * 16), b8 = lds_byte(wc * 32 + fr, fq * 16);
#define PG8_SA(b, h) (((b) * 2 + (h)) * HTB)
#define PG8_SB(b, h) ((4 + (b) * 2 + (h)) * HTB)
#define PG8_STAGE(bufoff, gbase, voff) do { _Pragma("unroll") for (int _i = 0; _i < 2; ++_i) \
        __builtin_amdgcn_global_load_lds((const unsigned*)((const char*)(gbase) + (voff)[_i]), (PG8_LAS unsigned*)(lds + (bufoff) + ldsw + _i * 8192), 16, 0, 0); } while (0)
#define PG8_STAGE_A(bufoff, gbase, OA, h) do { _Pragma("unroll") for (int _i = 0; _i < 2; ++_i) \
        __builtin_amdgcn_global_load_lds((const unsigned*)((const char*)(gbase) + (OA)[h][_i]), (PG8_LAS unsigned*)(lds + (bufoff) + ldsw + _i * 8192), 16, 0, 0); } while (0)
#define PG8_LD16(off) (*(const PG8_LAS v4i_t*)(lds + (off)))
#define PG8_LDA(dst, b, h) do { _Pragma("unroll") for (int m = 0; m < 4; ++m) { if constexpr (F8) dst[m].w8 = __builtin_shufflevector(PG8_LD16(PG8_SA(b, h) + a8 + m * 2048), PG8_LD16(PG8_SA(b, h) + a8 + 16 + m * 2048), 0, 1, 2, 3, 4, 5, 6, 7); \
        else { _Pragma("unroll") for (int k = 0; k < 2; ++k) dst[m].p16[k] = *(const PG8_LAS bf16x8*)(lds + PG8_SA(b, h) + aoff + m * 2048 + k * 1024); } } } while (0)
#define PG8_LDB(dst, b, h) do { _Pragma("unroll") for (int n = 0; n < 2; ++n) { if constexpr (F8) dst[n].w8 = __builtin_shufflevector(PG8_LD16(PG8_SB(b, h) + b8 + n * 2048), PG8_LD16(PG8_SB(b, h) + b8 + 16 + n * 2048), 0, 1, 2, 3, 4, 5, 6, 7); \
        else { _Pragma("unroll") for (int k = 0; k < 2; ++k) dst[n].p16[k] = *(const PG8_LAS bf16x8*)(lds + PG8_SB(b, h) + boff + n * 2048 + k * 1024); } } } while (0)
#define PG8_MMA(ai, bj, At, Bt) do { __builtin_amdgcn_s_setprio(1); _Pragma("unroll") for (int m = 0; m < 4; ++m) _Pragma("unroll") for (int n = 0; n < 2; ++n) { \
        if constexpr (F8) asm volatile("v_mfma_scale_f32_16x16x128_f8f6f4 %0, %1, %2, %0, %3, %4 op_sel_hi:[0,0,0]" : "+v"(acc[ai][bj][m][n]) : "v"(Bt[n].w8), "v"(At[m].w8), "v"(0x7B7B7B7B), "v"(0x7F7F7F7F)); \
        else { _Pragma("unroll") for (int k = 0; k < 2; ++k) acc[ai][bj][m][n] = __builtin_amdgcn_mfma_f32_16x16x32_bf16(Bt[n].p16[k], At[m].p16[k], acc[ai][bj][m][n], 0, 0, 0); } } __builtin_amdgcn_s_setprio(0); } while (0)
#define PG8_WAIT_V(n) asm volatile("s_waitcnt vmcnt(" #n ")" ::: "memory")
#define PG8_WAIT_L(n) asm volatile("s_waitcnt lgkmcnt(" #n ")" ::: "memory")
#define PG8_BAR __builtin_amdgcn_s_barrier()
#define PG8_SCHED __builtin_amdgcn_sched_barrier(0)
    Unit cur, nxt; int ui = 0;
    if (!S.next(0, cur)) return;
    if constexpr (TIMED) pg8_tm(tmisc, wid, lane, 27);
    f32x4 acc[2][2][4][2];
#pragma unroll
    for (int a = 0; a < 2; ++a)
#pragma unroll
        for (int b = 0; b < 2; ++b)
#pragma unroll
            for (int m = 0; m < 4; ++m)
#pragma unroll
                for (int n = 0; n < 2; ++n) acc[a][b][m][n] = (f32x4){0.f, 0.f, 0.f, 0.f};
    union Frag { v8i_t w8; bf16x8 p16[2]; };
    Frag At[4], B0[2], B1[2];
    const char* cA; const char* cB = uptr((const char*)g.Bt + (size_t)cur.e * g.bstride + (size_t)cur.pn * tstep);
    if constexpr (GATHER) { cA = (const char*)g.A;
#pragma unroll
        for (int h = 0; h < 2; ++h)
#pragma unroll
            for (int i = 0; i < 2; ++i) oc[h][i] = gather_off(S, 0, h, i, tid, KB);
    } else cA = uptr((const char*)g.A + (size_t)cur.pm * tstep);
    S.a_ready(cur);
    PG8_STAGE(PG8_SB(0, 0), cB, voffB); PG8_STAGE(PG8_SB(0, 1), cB + hstep, voffB); PG8_STAGE_A(PG8_SA(0, 0), cA, oc, 0); PG8_STAGE_A(PG8_SA(0, 1), cA, oc, 1);
    if (wr == 1) PG8_BAR;
    PG8_WAIT_V(2); PG8_BAR;
    PG8_STAGE(PG8_SB(1, 0), cB + kstep, voffB); PG8_STAGE_A(PG8_SA(1, 0), cA + kstep, oc, 0); PG8_STAGE(PG8_SB(1, 1), cB + hstep + kstep, voffB);
    PG8_WAIT_V(6); PG8_BAR;
    for (;;) {
        const bool has_next = S.next(ui + 1, nxt);
        const char* nA = cA; const char* nB = has_next ? uptr((const char*)g.Bt + (size_t)nxt.e * g.bstride + (size_t)nxt.pn * tstep) : cB;
        if constexpr (GATHER) {
        } else { if (has_next) nA = uptr((const char*)g.A + (size_t)nxt.pm * tstep); }
#pragma unroll 1
        for (int t = 0; t < nt; t += 2) {
            const bool last = (t == nt - 2);
            const char* a1 = cA + (size_t)(t + 1) * kstep;
            const char* a2 = last ? nA : cA + (size_t)(t + 2) * kstep; const char* b2 = last ? nB : cB + (size_t)(t + 2) * kstep;
            const char* a3 = a2 + kstep; const char* b3 = b2 + kstep;
            unsigned o2[2][2];
#pragma unroll
            for (int h = 0; h < 2; ++h)
#pragma unroll
                for (int i = 0; i < 2; ++i) o2[h][i] = oc[h][i];
            if constexpr (GATHER) { if (last && has_next) {
#pragma unroll
                for (int h = 0; h < 2; ++h)
#pragma unroll
                    for (int i = 0; i < 2; ++i) o2[h][i] = gather_off(S, ui + 1, h, i, tid, KB); } }
            if (last && has_next) S.a_ready(nxt);
            PG8_LDB(B0, 0, 0); PG8_LDB(B1, 0, 1); PG8_SCHED; PG8_LDA(At, 0, 0); PG8_STAGE_A(PG8_SA(1, 1), a1, oc, 1);
            PG8_WAIT_V(8); PG8_WAIT_L(0); PG8_BAR; PG8_MMA(0, 0, At, B0); PG8_MMA(0, 1, At, B1); PG8_BAR; PG8_SCHED;
            PG8_LDA(At, 0, 1); PG8_STAGE(PG8_SB(0, 0), b2, voffB); PG8_STAGE(PG8_SB(0, 1), b2 + hstep, voffB); PG8_STAGE_A(PG8_SA(0, 0), a2, o2, 0);
            PG8_WAIT_V(8); PG8_WAIT_L(0); PG8_BAR; PG8_MMA(1, 0, At, B0); PG8_MMA(1, 1, At, B1); PG8_BAR; PG8_SCHED;
            PG8_LDB(B0, 1, 0); PG8_LDB(B1, 1, 1); PG8_SCHED; PG8_LDA(At, 1, 0); PG8_STAGE_A(PG8_SA(0, 1), a2, o2, 1);
            PG8_WAIT_V(8); PG8_WAIT_L(0); PG8_BAR; PG8_MMA(0, 0, At, B0); PG8_MMA(0, 1, At, B1); PG8_BAR; PG8_SCHED;
            PG8_LDA(At, 1, 1); PG8_STAGE(PG8_SB(1, 0), b3, voffB); PG8_STAGE(PG8_SB(1, 1), b3 + hstep, voffB); PG8_STAGE_A(PG8_SA(1, 0), a3, o2, 0);
            PG8_WAIT_V(8); PG8_WAIT_L(0); PG8_BAR; PG8_MMA(1, 0, At, B0); PG8_MMA(1, 1, At, B1); PG8_BAR; PG8_SCHED;
        }
        if constexpr (ALIGN_EPI) { if (wr == 0) PG8_BAR; }
        if constexpr (TIMED) pg8_tm(tmisc, wid, lane, 28);
        { int le_ = (int)__builtin_amdgcn_mbcnt_hi(~0u, __builtin_amdgcn_mbcnt_lo(~0u, 0u)); asm volatile("" : "+v"(le_));
          E(acc, cur, wr, wc, le_ & 15, le_ >> 4); } S.done(cur);
        if constexpr (TIMED) pg8_tm(tmisc, wid, lane, has_next ? 27 : tseg_after);
        if (!has_next) break;
#pragma unroll
        for (int a = 0; a < 2; ++a)
#pragma unroll
            for (int b = 0; b < 2; ++b)
#pragma unroll
                for (int m = 0; m < 4; ++m)
#pragma unroll
                    for (int n = 0; n < 2; ++n) acc[a][b][m][n] = (f32x4){0.f, 0.f, 0.f, 0.f};
        cur = nxt; cA = nA; cB = nB; ++ui;
        if constexpr (GATHER) {
#pragma unroll
            for (int h = 0; h < 2; ++h)
#pragma unroll
                for (int i = 0; i < 2; ++i) oc[h][i] = gather_off(S, ui, h, i, tid, KB); }
        if constexpr (ALIGN_EPI) { if (wr == 1) PG8_BAR; }
    }
    PG8_WAIT_V(0);
    if constexpr (!ALIGN_EPI) { if (wr == 0) PG8_BAR; }
    PG8_BAR;
#undef PG8_SA
#undef PG8_SB
#undef PG8_STAGE
#undef PG8_STAGE_A
#undef PG8_LDA
#undef PG8_LDB
#undef PG8_MMA
#undef PG8_WAIT_V
#undef PG8_WAIT_L
#undef PG8_BAR
#undef PG8_SCHED
}
}
namespace attn_body {
using bf16=__hip_bfloat16;
using bf16x8=__attribute__((ext_vector_type(8)))short;
using s16x4=__attribute__((ext_vector_type(4)))short;
using f32x16=__attribute__((ext_vector_type(16)))float;
using u32x4=__attribute__((ext_vector_type(4)))unsigned;
constexpr int D=64,QP=512,KP=128,OP=1024;
constexpr int NW=8,QBLK=32,QB=QBLK*NW,KVBLK=64;
constexpr int ATTN_UNIT_ROWS=QB;
__device__ __forceinline__ int crow(int r,int hi){return (r&3)+8*(r>>2)+4*hi;}
#define SBAR() __builtin_amdgcn_sched_barrier(0)
__device__ __forceinline__ void cmask(f32x16&p0,f32x16&p1,int jb,int qrel,int hi){
  const float NEG=-INFINITY; int kb=64*jb+4*hi;
  #pragma unroll
  for(int r=0;r<16;++r){int kv=kb+(r&3)+8*(r>>2); if(kv>qrel)p0[r]=NEG; if(kv+32>qrel)p1[r]=NEG;}
}

constexpr int NSLOT=3, SLOTB=8192;
constexpr int LDS_K=0, LDS_V=NSLOT*SLOTB, LDS_WS=2*NSLOT*SLOTB, LDS_OST=LDS_WS+NW*64*4, LDS_BYTES=LDS_OST+NW*4096;
constexpr float C2=0.125f*1.4426950408889634f;
__device__ __forceinline__ void glds16(const void*gsrc,unsigned lds_dst){unsigned keep;
  asm volatile("s_mov_b32 %0, m0\n\ts_mov_b32 m0, %2\n\ts_nop 0\n\tglobal_load_lds_dwordx4 %1, off\n\ts_mov_b32 m0, %0":"=&s"(keep):"v"(gsrc),"s"(lds_dst):"memory");}
__device__ __forceinline__ float max3f(float a,float b,float c){float r;asm("v_max3_f32 %0, %1, %2, %3":"=v"(r):"v"(a),"v"(b),"v"(c));return r;}
__device__ __forceinline__ float max2f(float a,float b){float r;asm("v_max_f32_e32 %0, %1, %2":"=v"(r):"v"(a),"v"(b));return r;}
__device__ __forceinline__ float fadd_s(float a,float b){float r;asm("v_add_f32_e32 %0, %1, %2":"=v"(r):"v"(a),"v"(b));return r;}
__device__ __forceinline__ float fsub_s(float a,float b){float r;asm("v_sub_f32_e32 %0, %1, %2":"=v"(r):"v"(a),"v"(b));return r;}
typedef float f32x2_t __attribute__((ext_vector_type(2))); typedef __bf16 bf16x2_t __attribute__((ext_vector_type(2)));
__device__ __forceinline__ unsigned cvtpk_s(float lo,float hi){f32x2_t v={lo,hi};bf16x2_t b=__builtin_convertvector(v,bf16x2_t);return __builtin_bit_cast(unsigned,b);}
#define WAIT_BAR(N) asm volatile("s_waitcnt vmcnt(" #N ") lgkmcnt(0)\n\ts_barrier":::"memory")

__device__ __forceinline__ void qkt(f32x16&p0,f32x16&p1,const char*Kslot,const bf16x8*qr,const f32x16&negm,int r32,int hi){
  const char*kb=Kslot+hi*1024+r32*16;
  #pragma unroll
  for(int d0=0;d0<4;++d0){
    const bf16x8 b0=*reinterpret_cast<const bf16x8*>(kb+d0*2048);
    const bf16x8 b1=*reinterpret_cast<const bf16x8*>(kb+d0*2048+512);
    if(d0==0){p0=__builtin_amdgcn_mfma_f32_32x32x16_bf16(b0,qr[0],negm,0,0,0);p1=__builtin_amdgcn_mfma_f32_32x32x16_bf16(b1,qr[0],negm,0,0,0);}
    else{p0=__builtin_amdgcn_mfma_f32_32x32x16_bf16(b0,qr[d0],p0,0,0,0);p1=__builtin_amdgcn_mfma_f32_32x32x16_bf16(b1,qr[d0],p1,0,0,0);}}
}
typedef __attribute__((address_space(3))) const char* lds_cptr;
typedef short v4i16_t __attribute__((ext_vector_type(4)));
__device__ __forceinline__ void kload8(bf16x8*kf,lds_cptr kp){
  kf[0]=*(const __attribute__((address_space(3))) bf16x8*)(kp);      kf[1]=*(const __attribute__((address_space(3))) bf16x8*)(kp+512);
  kf[2]=*(const __attribute__((address_space(3))) bf16x8*)(kp+2048); kf[3]=*(const __attribute__((address_space(3))) bf16x8*)(kp+2560);
  kf[4]=*(const __attribute__((address_space(3))) bf16x8*)(kp+4096); kf[5]=*(const __attribute__((address_space(3))) bf16x8*)(kp+4608);
  kf[6]=*(const __attribute__((address_space(3))) bf16x8*)(kp+6144); kf[7]=*(const __attribute__((address_space(3))) bf16x8*)(kp+6656);
}
__device__ __forceinline__ void kload2(bf16x8*kf,lds_cptr kp,int j){ kf[2*j]=*(const __attribute__((address_space(3))) bf16x8*)(kp+j*2048); kf[2*j+1]=*(const __attribute__((address_space(3))) bf16x8*)(kp+j*2048+512); }
__device__ __forceinline__ s16x4 vtr(lds_cptr p){ return __builtin_bit_cast(s16x4,__builtin_amdgcn_ds_read_tr16_b64_v4i16((__attribute__((address_space(3))) v4i16_t*)p)); }
__device__ __forceinline__ float rowmax(const f32x16&p0,const f32x16&p1){
  float a=max3f(p0[0],p0[1],p1[0]),b=max3f(p0[2],p0[3],p1[1]);a=max3f(a,p1[2],p1[3]);
  #pragma unroll
  for(int r=4;r<16;r+=4){a=max3f(a,p0[r],p0[r+1]);b=max3f(b,p0[r+2],p0[r+3]);a=max3f(a,p1[r],p1[r+1]);b=max3f(b,p1[r+2],p1[r+3]);}
  const float m=max2f(a,b);
  auto rr=__builtin_amdgcn_permlane32_swap(__float_as_uint(m),__float_as_uint(m),false,false);
  return max2f(__uint_as_float(rr[0]),__uint_as_float(rr[1]));
}
__device__ __forceinline__ void pv(f32x16*o,int vb,bf16x8 pa0,bf16x8 pa1,bf16x8 pa2,bf16x8 pa3){
  #pragma unroll
  for(int d0=0;d0<2;++d0){s16x4 lo[4],hi[4];
    #pragma unroll
    for(int ks=0;ks<4;++ks){
      asm volatile("ds_read_b64_tr_b16 %0,%1 offset:%c2":"=&v"(lo[ks]):"v"(vb),"i"(d0*4096+ks*1024):"memory");
      asm volatile("ds_read_b64_tr_b16 %0,%1 offset:%c2":"=&v"(hi[ks]):"v"(vb),"i"(d0*4096+ks*1024+512):"memory");}
    asm volatile("s_waitcnt lgkmcnt(0)":::"memory");SBAR();
    #define PK(k) (bf16x8){lo[k][0],lo[k][1],lo[k][2],lo[k][3],hi[k][0],hi[k][1],hi[k][2],hi[k][3]}
    o[d0]=__builtin_amdgcn_mfma_f32_32x32x16_bf16(pa0,PK(0),o[d0],0,0,0);
    o[d0]=__builtin_amdgcn_mfma_f32_32x32x16_bf16(pa1,PK(1),o[d0],0,0,0);
    o[d0]=__builtin_amdgcn_mfma_f32_32x32x16_bf16(pa2,PK(2),o[d0],0,0,0);
    o[d0]=__builtin_amdgcn_mfma_f32_32x32x16_bf16(pa3,PK(3),o[d0],0,0,0);
    #undef PK
  }
}

#ifndef ATTN_STORE16
#define ATTN_STORE16(p,v) (*(u32x4*)(p)=(v))
#endif
template<int THRL> __device__ __forceinline__ void attn_unit(long qrow0,int qcol,long kvrow0,int kvcol,int NT,long orow0,int ocol,const bf16*Q,const bf16* K,const bf16* V,bf16*O,char*shm,int wave_){
  int lane_=(int)__builtin_amdgcn_mbcnt_hi(~0u,__builtin_amdgcn_mbcnt_lo(~0u,0u)); asm volatile("":"+s"(wave_),"+v"(lane_)); const int wid=wave_; const int lane=lane_,tid=wid*64+lane,r32=lane&31,hi=lane>>5;
  const bf16*Qw=Q+(qrow0+wid*QBLK)*QP+qcol;
  const bf16*Kh=K+kvrow0*KP+kvcol,*Vh=V+kvrow0*KP+kvcol;
  const unsigned lds0=(unsigned)(uintptr_t)shm;
  float*wsf=(float*)(shm+LDS_WS)+wid*64;
  const bf16*ksrc=Kh+(long)lane*KP+wid*8;
  const bf16*vsrc=Vh+(long)(16*(wid&3)+(lane>>2))*KP+(wid>>2)*32+(lane&3)*8;
  const unsigned kdst=lds0+LDS_K+wid*1024, vdst=lds0+LDS_V+wid*1024;
  #define DMA_K(t,slot) glds16(ksrc+(long)(t)*KVBLK*KP,(unsigned)__builtin_amdgcn_readfirstlane(kdst+(slot)))
  #define DMA_V(t,slot) glds16(vsrc+(long)(t)*KVBLK*KP,(unsigned)__builtin_amdgcn_readfirstlane(vdst+(slot)))
  const int vb0=(int)(lds0+LDS_V)+((lane>>4)&1)*32+(lane&3)*8+(4*hi+((lane&15)>>2))*64;
  const char*Kbase=shm+LDS_K; bf16x8 kf[8];
  const lds_cptr shm3=(lds_cptr)shm; const lds_cptr kp0=shm3+LDS_K+hi*1024+r32*16; const lds_cptr vp0=shm3+LDS_V+((lane>>4)&1)*32+(lane&3)*8+(4*hi+((lane&15)>>2))*64;
  DMA_K(0,0);DMA_V(0,0);DMA_K(1,SLOTB);
  bf16x8 qr[4];
  #pragma unroll
  for(int d0=0;d0<4;++d0)qr[d0]=*reinterpret_cast<const bf16x8*>(&Qw[(long)r32*QP+d0*16+hi*8]);
  float mhat=0.f,l_reg=0.f;f32x16 o[2];{float z_=0.f;asm volatile("":"+v"(z_));
    _Pragma("unroll") for(int r=0;r<16;++r){o[0][r]=z_;o[1][r]=z_;}}f32x16 negm=o[0];asm volatile("":"+v"(negm));
  #define CMASK(P0,P1,t) do{}while(0)
  bool resc=false;
  #define START(P0,P1) do{ const float rm=rowmax(P0,P1); resc=false; \
    { const float dl=rm; mhat=fadd_s(mhat,dl); \
      _Pragma("unroll") for(int r=0;r<16;++r){P0[r]=fsub_s(P0[r],dl);P1[r]=fsub_s(P1[r],dl);} \
      _Pragma("unroll") for(int r=0;r<16;++r)negm[r]=-mhat; asm volatile("":"+v"(negm)); } \
    _Pragma("unroll") for(int r=0;r<16;++r)P0[r]=__builtin_amdgcn_exp2f(P0[r]); }while(0)
  #define RESC() do{ if(resc){ asm volatile("s_waitcnt lgkmcnt(0)":::"memory"); \
      _Pragma("unroll") for(int d_=0;d_<2;++d_) _Pragma("unroll") for(int r=0;r<16;++r)o[d_][r]*=wsf[crow(r,hi)]; } }while(0)
  f32x16 pA0,pA1,pB0,pB1;
  int sl_prev=0,sl_cur=0,sl_next=SLOTB;
  #define ROT() do{sl_prev=sl_cur;sl_cur=sl_next;sl_next=(sl_next==(NSLOT-1)*SLOTB)?0:sl_next+SLOTB;}while(0)
  DMA_K(2,2*SLOTB);
  WAIT_BAR(3);
  qkt(pA0,pA1,Kbase,qr,negm,r32,hi);asm volatile("s_nop 15\n\ts_nop 7":"+v"(pA0),"+v"(pA1));CMASK(pA0,pA1,0);
  START(pA0,pA1);
  _Pragma("unroll") for(int r=0;r<16;++r)pA1[r]=__builtin_amdgcn_exp2f(pA1[r]);
  WAIT_BAR(0);
  DMA_K(3,0);DMA_V(1,SLOTB);
  ROT();
  kload8(kf,kp0+sl_cur);
  WAIT_BAR(2);
  s16x4 vlo[8],vhi[8]; u32x4 pw0,pw1,pw2,pw3;
  #define PKW(P,B) cvtpk_s(P[B],P[B+1])
  #define PAF(k) __builtin_bit_cast(bf16x8,pw##k)
  #define VFR(i) (bf16x8){vlo[i][0],vlo[i][1],vlo[i][2],vlo[i][3],vhi[i][0],vhi[i][1],vhi[i][2],vhi[i][3]}
  #define PIN(x) asm volatile("":"+v"(x))
  #define MX3(a,b,c) __builtin_fmaxf(__builtin_fmaxf((a),(b)),(c))
  #define GAPA(MF,A0,A1,A2,A3,W0,W1,PW) do{ MF; sacc+=A0; sacc+=A1; sacc+=A2; sacc+=A3; PIN(sacc); W0; W1; PIN(PW); SBAR(); }while(0)
  #define EX(v) __builtin_amdgcn_exp2f(v)
  #define GAPB(MF,X,B) do{ MF; X[B]=EX(X[B]); X[B+1]=EX(X[B+1]); X[B+2]=EX(X[B+2]); X[B+3]=EX(X[B+3]); PIN(X); SBAR(); }while(0)
  #define VRD(i) do{ vlo[i]=vtr(vp_+(((i)>>2)*4096+((i)&3)*1024)); vhi[i]=vtr(vp_+(((i)>>2)*4096+((i)&3)*1024+512)); }while(0)
  #define KRD(G,j) do{ if(G){ kload2(kf,kp0+sl_next,j); SBAR(); } }while(0)
  #define STEP(C0,C1,P0,P1,t,GK,GV,GL) do{ SBAR(); \
    const lds_cptr vp_=vp0+sl_prev; \
    VRD(0); SBAR(); float sacc=(P0[0]+P0[1]); \
    GAPA(C0=__builtin_amdgcn_mfma_f32_32x32x16_bf16(kf[0],qr[0],negm,0,0,0), P0[2],P0[3],P0[4],P0[5],     pw0[0]=PKW(P0,0), pw0[1]=PKW(P0,2), pw0); \
    VRD(4); SBAR(); GAPA(C1=__builtin_amdgcn_mfma_f32_32x32x16_bf16(kf[1],qr[0],negm,0,0,0), P0[6],P0[7],P0[8],P0[9],     pw0[2]=PKW(P0,4), pw0[3]=PKW(P0,6), pw0); \
    VRD(1); SBAR(); GAPA(C0=__builtin_amdgcn_mfma_f32_32x32x16_bf16(kf[2],qr[1],C0,0,0,0),   P0[10],P0[11],P0[12],P0[13], pw1[0]=PKW(P0,8), pw1[1]=PKW(P0,10), pw1); \
    VRD(5); SBAR(); GAPA(C1=__builtin_amdgcn_mfma_f32_32x32x16_bf16(kf[3],qr[1],C1,0,0,0),   P0[14],P0[15],P1[0],P1[1],   pw1[2]=PKW(P0,12),pw1[3]=PKW(P0,14), pw1); \
    VRD(2); SBAR(); GAPA(C0=__builtin_amdgcn_mfma_f32_32x32x16_bf16(kf[4],qr[2],C0,0,0,0),   P1[2],P1[3],P1[4],P1[5],     pw2[0]=PKW(P1,0), pw2[1]=PKW(P1,2), pw2); \
    VRD(6); SBAR(); GAPA(C1=__builtin_amdgcn_mfma_f32_32x32x16_bf16(kf[5],qr[2],C1,0,0,0),   P1[6],P1[7],P1[8],P1[9],     pw2[2]=PKW(P1,4), pw2[3]=PKW(P1,6), pw2); \
    VRD(3); SBAR(); GAPA(C0=__builtin_amdgcn_mfma_f32_32x32x16_bf16(kf[6],qr[3],C0,0,0,0),   P1[10],P1[11],P1[12],P1[13], pw3[0]=PKW(P1,8), pw3[1]=PKW(P1,10), pw3); \
    VRD(7); SBAR(); GAPA(C1=__builtin_amdgcn_mfma_f32_32x32x16_bf16(kf[7],qr[3],C1,0,0,0),   P1[14],P1[15],0.f,0.f,       pw3[2]=PKW(P1,12),pw3[3]=PKW(P1,14), pw3); \
    l_reg+=sacc; \
    if(GK){DMA_K((t)+3,sl_cur);} if(GV){DMA_V((t)+1,sl_next);} \
    CMASK(C0,C1,t); \
    { float a=MX3(C0[0],C0[1],C1[0]),b=MX3(C0[2],C0[3],C1[1]); a=MX3(a,C1[2],C1[3]); \
      _Pragma("unroll") for(int r=4;r<16;r+=4){a=MX3(a,C0[r],C0[r+1]);b=MX3(b,C0[r+2],C0[r+3]);a=MX3(a,C1[r],C1[r+1]);b=MX3(b,C1[r+2],C1[r+3]);} \
      float rm=__builtin_fmaxf(a,b); { auto rr=__builtin_amdgcn_permlane32_swap(__float_as_uint(rm),__float_as_uint(rm),false,false); rm=__builtin_fmaxf(__uint_as_float(rr[0]),__uint_as_float(rr[1])); } \
      resc=false; \
      if(__builtin_expect(__any(rm>(float)THRL),0)){ const float dl=__builtin_fmaxf(rm,0.f); mhat+=dl; \
        _Pragma("unroll") for(int r=0;r<16;++r){C0[r]-=dl;C1[r]-=dl;} \
        _Pragma("unroll") for(int r=0;r<16;++r)negm[r]=-mhat; asm volatile("":"+v"(negm)); \
        const float f=__builtin_amdgcn_exp2f(-dl); l_reg*=f; if(hi==0)wsf[r32]=f; resc=true; } } \
    SBAR(); \
    GAPB(o[0]=__builtin_amdgcn_mfma_f32_32x32x16_bf16(PAF(0),VFR(0),o[0],0,0,0), C0,0); \
    GAPB(o[1]=__builtin_amdgcn_mfma_f32_32x32x16_bf16(PAF(0),VFR(4),o[1],0,0,0), C0,4); \
    KRD(GL,0); GAPB(o[0]=__builtin_amdgcn_mfma_f32_32x32x16_bf16(PAF(1),VFR(1),o[0],0,0,0), C0,8); \
    KRD(GL,1); GAPB(o[1]=__builtin_amdgcn_mfma_f32_32x32x16_bf16(PAF(1),VFR(5),o[1],0,0,0), C0,12); \
    KRD(GL,2); GAPB(o[0]=__builtin_amdgcn_mfma_f32_32x32x16_bf16(PAF(2),VFR(2),o[0],0,0,0), C1,0); \
    KRD(GL,3); GAPB(o[1]=__builtin_amdgcn_mfma_f32_32x32x16_bf16(PAF(2),VFR(6),o[1],0,0,0), C1,4); \
    GAPB(o[0]=__builtin_amdgcn_mfma_f32_32x32x16_bf16(PAF(3),VFR(3),o[0],0,0,0), C1,8); \
    GAPB(o[1]=__builtin_amdgcn_mfma_f32_32x32x16_bf16(PAF(3),VFR(7),o[1],0,0,0), C1,12); \
    }while(0)
  int t=1;
  for(;t+5<NT;t+=2){
    STEP(pB0,pB1,pA0,pA1,t,true,true,true);     WAIT_BAR(2); RESC(); ROT();
    STEP(pA0,pA1,pB0,pB1,t+1,true,true,true);   WAIT_BAR(2); RESC(); ROT();
  }
  #define ENDW(tt) do{ if((tt)+3<NT){WAIT_BAR(2);} else if((tt)+2<NT){WAIT_BAR(1);} else {WAIT_BAR(0);} }while(0)
  for(;t+1<NT;t+=2){
    STEP(pB0,pB1,pA0,pA1,t,(t+3<NT),(t+1<NT),(t+1<NT));       ENDW(t);   RESC(); ROT();
    STEP(pA0,pA1,pB0,pB1,t+1,(t+4<NT),(t+2<NT),(t+2<NT));     ENDW(t+1); RESC(); ROT();
  }
  STEP(pB0,pB1,pA0,pA1,NT-1,false,false,false); RESC();
  { float sacc=pB0[0]+pB0[1]; _Pragma("unroll") for(int r=2;r<16;++r)sacc+=pB0[r]; _Pragma("unroll") for(int r=0;r<16;++r)sacc+=pB1[r]; l_reg+=sacc;
    pw0=(u32x4){PKW(pB0,0),PKW(pB0,2),PKW(pB0,4),PKW(pB0,6)};pw1=(u32x4){PKW(pB0,8),PKW(pB0,10),PKW(pB0,12),PKW(pB0,14)};pw2=(u32x4){PKW(pB1,0),PKW(pB1,2),PKW(pB1,4),PKW(pB1,6)};pw3=(u32x4){PKW(pB1,8),PKW(pB1,10),PKW(pB1,12),PKW(pB1,14)};
    SBAR(); pv(o,vb0+sl_cur,PAF(0),PAF(1),PAF(2),PAF(3)); }
  #undef PKW
  #undef PAF
  #undef VFR
  #undef PIN
  #undef MX3
  #undef GAPA
  #undef GAPB
  #undef EX
  #undef VRD
  #undef KRD
  #undef STEP
  #undef ENDW
  {auto rr=__builtin_amdgcn_permlane32_swap(__float_as_uint(l_reg),__float_as_uint(l_reg),false,false);l_reg=__uint_as_float(rr[0])+__uint_as_float(rr[1]);}
  if(hi==0)wsf[32+r32]=l_reg;asm volatile("s_waitcnt lgkmcnt(0)":::"memory");
  float rli[16];
  #pragma unroll
  for(int r=0;r<16;++r)rli[r]=__builtin_amdgcn_rcpf(wsf[32+crow(r,hi)]);
  bf16*Ow=O+(orow0+wid*QBLK)*OP+ocol;
  { bf16*stg=(bf16*)(shm+LDS_OST)+wid*2048;
    #pragma unroll
    for(int r=0;r<16;++r){const int orow=crow(r,hi);
      #pragma unroll
      for(int d0=0;d0<2;++d0)stg[orow*64+d0*32+r32]=__float2bfloat16(o[d0][r]*rli[r]);}
    asm volatile("s_waitcnt lgkmcnt(0)":::"memory");
    #pragma unroll
    for(int i=0;i<4;++i){const int row=i*8+(lane>>3),ch=lane&7; const u32x4 v=*(const u32x4*)(stg+row*64+ch*8); ATTN_STORE16(Ow+(long)row*OP+ch*8,v);} }
  asm volatile("s_waitcnt lgkmcnt(0)\n\ts_barrier":::"memory");
  #undef DMA_K
  #undef DMA_V
  #undef CMASK
  #undef START
  #undef RESC
  #undef ROT
}
constexpr int ATTN_LDS_BYTES=LDS_BYTES;
#undef SBAR
#undef WAIT_BAR
}
constexpr int NB = 8, T = 4096, D = 1024, DEPTH = 4, LC = 256;
constexpr int ML = NB * T, MC = NB * LC, M = ML + MC;
constexpr int PROJ = 2048, SKV = T + LC;
constexpr int C_HY = 0, C_Q = 768, C_K = 1280, C_V = 1408, C_RGX = 1536, C_RGG = 1792;
constexpr int NEXP = 64, TOPK = 8, FF = 256;
constexpr int SH0 = M * TOPK + NEXP * 256;
constexpr int HIDROWS = SH0 + M;
constexpr float LN_EPS = 1e-6f, QK_EPS = 1e-6f;
constexpr float DN_ALPHA = 1.681792830507429f;
constexpr float ROUTED_SCALE = 2.5f;
constexpr int NWAVES = 8;
enum { I_X = 0, I_C, I_CTX, I_CCTX, I_WMOD, I_BMOD, I_LN1G, I_LN1B, I_LN2G, I_LN2B, I_WIN, I_WOUT, I_HYSW, I_HYSB, I_HYW1, I_HYB1, I_HYFREQ, I_HYW2, I_HYB2, I_HYW3, I_HYSKIP,
       I_QN, I_KN, I_RGCW, I_RGCB, I_RGLAM, I_RGWA, I_RGBA, I_RGWX, I_RGBX, I_WR, I_BR, I_WG, I_WU, I_WD, I_WSG, I_WSU, I_WSD, N_IN };

constexpr size_t MiB = 1u << 20;
constexpr size_t WS_CTL = 0, CTL_ZERO_BYTES = 1 * MiB;
constexpr size_t WS_MODV = 1 * MiB;
constexpr size_t WS_TW = 2 * MiB;
constexpr size_t WS_ROPE = 3 * MiB;
constexpr size_t WS_RTHI = 4 * MiB, WS_RTLO = 4 * MiB + 512 * 1024;
constexpr size_t WS_RGW = 5 * MiB;
constexpr size_t WS_IDX = 6 * MiB, WS_WT = 8 * MiB, WS_POS = 10 * MiB;
constexpr size_t WS_HIST = 12 * MiB;
constexpr size_t WS_TILES = 12 * MiB + 512 * 1024;
constexpr size_t WS_STOK = 13 * MiB;
constexpr size_t WS_SWT = 15 * MiB;
constexpr size_t WS_HC = 18 * MiB;
constexpr size_t WS_WIN = 26 * MiB;
constexpr size_t WS_WOUT = 42 * MiB;
constexpr size_t WS_WGU = 50 * MiB;
constexpr size_t WS_WDN = 115 * MiB;
constexpr size_t WS_ABUF = 148 * MiB;
constexpr size_t WS_FILT = 216 * MiB;
constexpr size_t WS_FILTC = WS_FILT + 16 * MiB;
constexpr size_t WS_BIG = 234 * MiB;
constexpr size_t WS_HID = WS_BIG;
constexpr size_t WS_Y2 = WS_BIG + 162 * MiB;
constexpr size_t WS_END_MOE = WS_Y2 + (size_t)SH0 * 2048;
constexpr size_t WS_SHY = WS_BIG + 452 * MiB;
constexpr size_t WS_P = WS_BIG;
constexpr size_t WS_V = WS_BIG;
constexpr size_t WS_QB = WS_BIG + 136 * MiB;
constexpr size_t WS_KB = WS_BIG + 170 * MiB;
constexpr size_t WS_VB = WS_BIG + 179 * MiB;
constexpr size_t WS_HT = WS_BIG + 188 * MiB;
constexpr size_t WS_HTC = WS_BIG + 284 * MiB;
constexpr size_t WS_SPEC = WS_BIG + 290 * MiB;
constexpr size_t WS_SPECC = WS_BIG + 322 * MiB;
constexpr size_t WS_RGA = WS_BIG + 324 * MiB;
constexpr size_t WS_RGB = WS_BIG + 392 * MiB;
constexpr size_t WS_MIX = WS_BIG + 460 * MiB;
constexpr size_t WS_END = WS_END_MOE;
static_assert(WS_MIX + (size_t)M * 2048 <= WS_END && WS_HID + (size_t)HIDROWS * 512 <= WS_Y2, "ws map");
constexpr int CW_BAR = 4096;
constexpr int RING_OFF = 0, RING_BYTES = 131072, SCRATCH_BYTES = 155648;
constexpr int LDSCTL_OFF = SCRATCH_BYTES, MISC_OFF = LDSCTL_OFF + 320;
constexpr int LTILES_OFF = LDSCTL_OFF + 1024;
constexpr int LDS_BYTES = 163840;
static_assert(LTILES_OFF + 1536 * 4 <= LDS_BYTES, "LDS map");

#define GAS __attribute__((address_space(1)))
#define LAS __attribute__((address_space(3)))
typedef unsigned short bf16;
typedef unsigned v4u __attribute__((ext_vector_type(4)));
typedef unsigned v2u __attribute__((ext_vector_type(2)));
typedef float f32x4 __attribute__((ext_vector_type(4)));
typedef float f32x2v __attribute__((ext_vector_type(2)));
typedef short bf16x8 __attribute__((ext_vector_type(8)));
typedef GAS unsigned gu32;
#define RLX_AGENT __ATOMIC_RELAXED, __HIP_MEMORY_SCOPE_AGENT
#define LDS_WAIT() asm volatile("s_waitcnt lgkmcnt(0)" ::: "memory")
#define VM_WAIT() asm volatile("s_waitcnt vmcnt(0)" ::: "memory")
__device__ __forceinline__ unsigned f2bf(float f) { unsigned u = __builtin_bit_cast(unsigned, f); return (u + 0x7fffu + ((u >> 16) & 1u)) >> 16; }
__device__ __forceinline__ unsigned pk2(float lo, float hi) { return f2bf(lo) | (f2bf(hi) << 16); }
__device__ __forceinline__ float bf2f(unsigned b) { return __builtin_bit_cast(float, b << 16); }
__device__ __forceinline__ float bflo(unsigned w) { return __builtin_bit_cast(float, w << 16); }
__device__ __forceinline__ float bfhi(unsigned w) { return __builtin_bit_cast(float, w & 0xffff0000u); }

#define XB_TMO      128
#define XB_XCNT(j)  (256  + 64 * (j))
#define XB_XSUB(j)  (1280 + 64 * (j))
#define XB_XGEN(j)  (2304 + 64 * (j))
#define XB_TOP      3328
#define XB_TOPGEN   3392
#define XCD_BAR_WORDS 3456
#define XB_SPIN_CAP (1u << 20)
__device__ __forceinline__ unsigned xb_ld(unsigned* p)              { return __hip_atomic_load(p, __ATOMIC_RELAXED, __HIP_MEMORY_SCOPE_AGENT); }
__device__ __forceinline__ unsigned xb_add(unsigned* p, unsigned v) { return __hip_atomic_fetch_add(p, v, __ATOMIC_RELAXED, __HIP_MEMORY_SCOPE_AGENT); }
__device__ __forceinline__ unsigned xb_xcc_id() { return (unsigned)__builtin_amdgcn_s_getreg((3 << 11) | 20) & 0xFu; }
#define XB_SPIN(cond, bar) do { unsigned _sp = 0; while (cond) { __builtin_amdgcn_s_sleep(1); \
    if ((++_sp & 255u) == 0u) { if (xb_ld(&(bar)[XB_TMO])) break; if (_sp > XB_SPIN_CAP) { atomicAdd(&(bar)[XB_TMO], 1u); break; } } } } while (0)
struct XcdBarrier { unsigned* bar; unsigned x; volatile LAS unsigned* st; };
__device__ __forceinline__ XcdBarrier xcd_barrier_post(unsigned* bar, volatile LAS unsigned* st) {
    XcdBarrier b; b.bar = bar; b.x = xb_xcc_id(); b.st = st;
    if (threadIdx.x == 0) (void)xb_add(&bar[XB_XCNT(b.x)], 1u);
    return b;
}
__device__ __forceinline__ void xcd_barrier_complete(unsigned* bar, unsigned x, unsigned& nloc, unsigned& nx) {
    const unsigned G = gridDim.x * gridDim.y * gridDim.z;
    unsigned sum, cnt, mine, sp = 0u;
    for (;;) {
        sum = 0u; cnt = 0u; mine = 0u;
#pragma unroll
        for (unsigned j = 0; j < 16; ++j) { const unsigned c = xb_ld(&bar[XB_XCNT(j)]); sum += c; cnt += (c > 0u) ? 1u : 0u; mine = (j == x) ? c : mine; }
        if (sum == G) break;
        __builtin_amdgcn_s_sleep(1);
        if ((++sp & 255u) == 0u) { if (xb_ld(&bar[XB_TMO])) break; if (sp > XB_SPIN_CAP) { atomicAdd(&bar[XB_TMO], 1u); break; } }
    }
    nloc = mine > 0u ? mine : 1u; nx = cnt > 0u ? cnt : 1u;
}
__device__ __forceinline__ int lane_id() { return (int)__builtin_amdgcn_mbcnt_hi(~0u, __builtin_amdgcn_mbcnt_lo(~0u, 0u)); }
__device__ __forceinline__ void xcd_barrier(const XcdBarrier& b, bool leader) {
    asm volatile("s_waitcnt vmcnt(0)" ::: "memory");
    __syncthreads();
    if (leader) {
        unsigned long long z_ = 0; asm volatile("" : "+s"(z_));
        unsigned* bar = b.bar + z_;
        __builtin_amdgcn_s_waitcnt(0);
        unsigned nloc = b.st[0], nx = b.st[1];
        if (nloc == 0u) { xcd_barrier_complete(bar, b.x, nloc, nx); b.st[0] = nloc; b.st[1] = nx; }
        const unsigned old = xb_add(&bar[XB_XSUB(b.x)], 1u);
        const unsigned gen = old / nloc;
        if (old + 1u == (gen + 1u) * nloc) {
            __builtin_amdgcn_fence(__ATOMIC_RELEASE, "agent");
            asm volatile("s_waitcnt vmcnt(0)" ::: "memory");
            const unsigned og = xb_add(&bar[XB_TOP], 1u);
            const unsigned tg = og / nx;
            if (og + 1u == (tg + 1u) * nx) xb_add(&bar[XB_TOPGEN], 1u);
            else XB_SPIN(xb_ld(&bar[XB_TOPGEN]) == tg, bar);
            __builtin_amdgcn_fence(__ATOMIC_ACQUIRE, "agent");
            xb_add(&bar[XB_XGEN(b.x)], 1u);
            asm volatile("s_waitcnt vmcnt(0)" ::: "memory");
        } else {
            XB_SPIN(xb_ld(&bar[XB_XGEN(b.x)]) == gen, bar);
            __builtin_amdgcn_fence(__ATOMIC_ACQUIRE, "agent");
            asm volatile("s_waitcnt vmcnt(0)" ::: "memory");
        }
    }
    __syncthreads();
}

__device__ __forceinline__ void lds_barrier() { asm volatile("s_waitcnt lgkmcnt(0)" ::: "memory"); __builtin_amdgcn_s_barrier(); asm volatile("" ::: "memory"); }
struct Args { const float* in[N_IN]; float* out; unsigned char* ws; };
struct Frame {
    LAS unsigned char* lds; char* ldsg; volatile LAS unsigned* MISC; gu32* ctl; unsigned char* ws; float* out;
    int tid, lane, wave, vcu, G, z;
};
__device__ __forceinline__ Frame fresh(const Frame& F0) {
    Frame F = F0; int w = F0.wave, ln = lane_id(); asm volatile("" : "+s"(w), "+v"(ln)); F.wave = w; F.lane = ln; F.tid = w * 64 + ln;
    unsigned long long z = 0; asm volatile("" : "+s"(z)); F.ws = F0.ws + z; F.out = F0.out + z; F.z = (int)z; return F;
}
__device__ __forceinline__ void tm_set(const Frame& F, unsigned long long tp, unsigned long long ta, int seg) { F.MISC[16] = (unsigned)tp; F.MISC[17] = (unsigned)(tp >> 32); F.MISC[18] = (unsigned)ta; F.MISC[19] = (unsigned)(ta >> 32); F.MISC[20] = (unsigned)seg; }
__device__ __forceinline__ unsigned long long tm_acc(const Frame& F) { return (unsigned long long)F.MISC[18] | ((unsigned long long)F.MISC[19] << 32); }
__device__ __forceinline__ void tm_seg(const Frame& F, int id) {
    if (MK_TMASK && F.wave == 0 && lane_id() == 0) { const unsigned long long now = __builtin_amdgcn_s_memrealtime(); const unsigned long long tp = (unsigned long long)F.MISC[16] | ((unsigned long long)F.MISC[17] << 32); unsigned long long ta = tm_acc(F);
        if ((MK_TMASK >> F.MISC[20]) & 1u) ta += now - tp; tm_set(F, now, ta, id); }
}
template <int CTRL, int RMASK> __device__ __forceinline__ float dpp0(float x) { return __builtin_bit_cast(float, __builtin_amdgcn_update_dpp(0, __builtin_bit_cast(int, x), CTRL, RMASK, 0xF, false)); }
__device__ __forceinline__ float wave_sum(float v) {
    v += dpp0<0x111, 0xF>(v); v += dpp0<0x112, 0xF>(v); v += dpp0<0x114, 0xF>(v); v += dpp0<0x118, 0xF>(v);
    v += dpp0<0x142, 0xA>(v); v += dpp0<0x143, 0xC>(v);
    return __builtin_bit_cast(float, __builtin_amdgcn_readlane(__builtin_bit_cast(int, v), 63));
}
template <int CTRL> __device__ __forceinline__ float dppx(float x) { return __builtin_bit_cast(float, __builtin_amdgcn_update_dpp(__builtin_bit_cast(int, x), __builtin_bit_cast(int, x), CTRL, 0xF, 0xF, false)); }
__device__ __forceinline__ float sum8(float v) {
    v += dppx<0xB1>(v);
    v += dppx<0x4E>(v);
    v += dppx<0x141>(v);
    return v;
}
__device__ __forceinline__ float sum32(float v) {
    v = sum8(v); v += dppx<0x140>(v);
    auto rr = __builtin_amdgcn_permlane16_swap(__float_as_uint(v), __float_as_uint(v), false, false);
    return __uint_as_float(rr[0]) + __uint_as_float(rr[1]);
}
__device__ __forceinline__ float sigmoidf_(float x) { return 1.0f / (1.0f + __expf(-x)); }
__device__ __forceinline__ float siluf_(float x) { return x / (1.0f + __expf(-x)); }
__device__ __forceinline__ const float* modv(const Frame& F, int l, int r, int k) { return (const float*)(F.ws + WS_MODV) + ((size_t)(l * 9 + r) * 6 + k) * 1024; }
__device__ __forceinline__ int modrow_of(int R) { return R < ML ? (R >> 12) : 8; }
constexpr int TSCR = 16896;
__device__ __forceinline__ void transpose_item(const float* W, int N, bf16* WT, int Kdst, int k0, int n0, int drow0, LAS float* scr, int lane) {
    const int rg = lane >> 4, c4 = (lane & 15) * 4;
    f32x4 v[16];
#pragma unroll
    for (int i = 0; i < 16; ++i) v[i] = __builtin_nontemporal_load((const f32x4*)(W + (size_t)(k0 + 4 * i + rg) * N + n0 + c4));
#pragma unroll
    for (int i = 0; i < 16; ++i) { LAS float* d = scr + (4 * i + rg) * 65 + c4; d[0] = v[i].x; d[1] = v[i].y; d[2] = v[i].z; d[3] = v[i].w; }
    LDS_WAIT(); asm volatile("" ::: "memory");
    const int kc = (lane & 7) * 8;
#pragma unroll
    for (int j = 0; j < 8; ++j) { const int n = (lane >> 3) + 8 * j; const LAS float* s = scr + kc * 65 + n;
        v4u o; o.x = pk2(s[0 * 65], s[1 * 65]); o.y = pk2(s[2 * 65], s[3 * 65]); o.z = pk2(s[4 * 65], s[5 * 65]); o.w = pk2(s[6 * 65], s[7 * 65]);
        __builtin_nontemporal_store(o, (GAS v4u*)(WT + (size_t)(drow0 + n) * Kdst + k0 + kc)); }
    LDS_WAIT(); asm volatile("" ::: "memory");
}

__device__ __forceinline__ unsigned pk4_fp8(float a, float b, float c, float d) { int w = 0; w = __builtin_amdgcn_cvt_pk_fp8_f32(a, b, w, false); w = __builtin_amdgcn_cvt_pk_fp8_f32(c, d, w, true); return (unsigned)w; }
__device__ __forceinline__ void transpose_item8(const float* W, int N, unsigned char* WT, int Kdst, int k0, int n0, int drow0, LAS float* scr, int lane, float scale) {
    const int rg = lane >> 4, c4 = (lane & 15) * 4;
    f32x4 v[16];
#pragma unroll
    for (int i = 0; i < 16; ++i) v[i] = __builtin_nontemporal_load((const f32x4*)(W + (size_t)(k0 + 4 * i + rg) * N + n0 + c4));
#pragma unroll
    for (int i = 0; i < 16; ++i) { LAS float* d = scr + (4 * i + rg) * 65 + c4; d[0] = v[i].x * scale; d[1] = v[i].y * scale; d[2] = v[i].z * scale; d[3] = v[i].w * scale; }
    LDS_WAIT(); asm volatile("" ::: "memory");
    const int kc = (lane & 7) * 8;
#pragma unroll
    for (int j = 0; j < 8; ++j) { const int n = (lane >> 3) + 8 * j; const LAS float* s = scr + kc * 65 + n;
        v2u o; o.x = pk4_fp8(s[0 * 65], s[1 * 65], s[2 * 65], s[3 * 65]); o.y = pk4_fp8(s[4 * 65], s[5 * 65], s[6 * 65], s[7 * 65]);
        __builtin_nontemporal_store(o, (GAS v2u*)(WT + (size_t)(drow0 + n) * Kdst + k0 + kc)); }
    LDS_WAIT(); asm volatile("" ::: "memory");
}

__device__ __forceinline__ void phase_prologue_a(Frame& F0, const Args& A) {
    Frame F = fresh(F0);
    const int gw = F.vcu * NWAVES + F.wave, NGW = F.G * NWAVES;
    const int gt = F.vcu * 512 + F.tid, NGT = F.G * 512;
    {
        LAS float* sc = (LAS float*)(F.lds);
        LAS float* red = (LAS float*)(F.lds + 40960);
        for (int i = F.tid; i < 9 * 1024; i += 512) { const int r = i >> 10, k = i & 1023; const float v = r < 8 ? A.in[I_C + F.z][r * 1024 + k] : A.in[I_CCTX + F.z][k]; sc[i] = siluf_(v); }
        lds_barrier();
        const int col4 = (F.tid & 7) * 4, ks = F.tid >> 3;
        for (int u = F.vcu; u < 4 * 192; u += F.G) {
            const int l = u / 192, j0 = (u % 192) * 32;
            const float* W = A.in[I_WMOD + F.z] + (size_t)l * 1024 * 6144 + j0 + col4;
            f32x4 acc[9];
#pragma unroll
            for (int r = 0; r < 9; ++r) acc[r] = (f32x4){0.f, 0.f, 0.f, 0.f};
            f32x4 wv[16];
#pragma unroll
            for (int kk = 0; kk < 16; ++kk) wv[kk] = __builtin_nontemporal_load((const f32x4*)(W + (size_t)(ks * 16 + kk) * 6144));
#pragma unroll
            for (int kk = 0; kk < 16; ++kk) { const int k = ks * 16 + kk;
#pragma unroll
                for (int r = 0; r < 9; ++r) acc[r] += wv[kk] * sc[r * 1024 + k]; }
#pragma unroll
            for (int r = 0; r < 9; ++r) *(LAS f32x4*)(red + (ks * 9 + r) * 32 + col4) = acc[r];
            lds_barrier();
            if (F.tid < 288) { const int r = F.tid >> 5, c = F.tid & 31; float s = A.in[I_BMOD + F.z][l * 6144 + j0 + c];
#pragma unroll 8
                for (int q = 0; q < 64; ++q) s += red[(q * 9 + r) * 32 + c];
                ((float*)(F.ws + WS_MODV))[((size_t)(l * 9 + r)) * 6144 + j0 + c] = s; }
            lds_barrier();
        }
    }
    {
        LAS float* scr = (LAS float*)(F.lds + F.wave * TSCR);
        constexpr int I_IN = (D / 64) * (PROJ / 64), I_OUT = (D / 64) * (D / 64);
        for (int it = gw; it < DEPTH * (I_IN + I_OUT); it += NGW) {
            const int l = it / (I_IN + I_OUT); int r = it % (I_IN + I_OUT);
            if (r < I_IN) { const int kb = r / (PROJ / 64), nb = r % (PROJ / 64);
                transpose_item(A.in[I_WIN + F.z] + (size_t)l * D * PROJ, PROJ, (bf16*)(F.ws + WS_WIN) + (size_t)l * PROJ * D, D, kb * 64, nb * 64, nb * 64, scr, F.lane); }
            else { r -= I_IN; const int kb = r / (D / 64), nb = r % (D / 64);
                transpose_item(A.in[I_WOUT + F.z] + (size_t)l * D * D, D, (bf16*)(F.ws + WS_WOUT) + (size_t)l * D * D, D, kb * 64, nb * 64, nb * 64, scr, F.lane); }
        }
    }
    for (int i = gt; i < DEPTH * NEXP * D; i += NGT) { const int l = i >> 16, e = (i >> 10) & 63, k = i & 1023;
        const float v = A.in[I_WR + F.z][((size_t)l * D + k) * NEXP + e]; const unsigned h = f2bf(v); const float lo = v - bf2f(h);
        ((bf16*)(F.ws + WS_RTHI))[i] = (bf16)h; ((bf16*)(F.ws + WS_RTLO))[i] = (bf16)f2bf(lo); }
    for (int i = gt; i < DEPTH * 2 * 2 * 4 * 64 * 64; i += NGT) { const int k = i & 63, n = (i >> 6) & 63, blk = (i >> 12) & 3, gate = (i >> 14) & 1, d = (i >> 15) & 1, l = i >> 16;
        const float* src = gate ? A.in[I_RGWX + F.z] : A.in[I_RGWA + F.z];
        ((bf16*)(F.ws + WS_RGW))[i] = (bf16)f2bf(src[((((size_t)l * 2 + d) * 4 + blk) * 64 + k) * 64 + n]); }
    for (int i = gt; i < 4096; i += NGT) { float s, c; sincospif(-(float)i * (1.0f / 4096.0f), &s, &c); ((f32x2v*)(F.ws + WS_TW))[i] = (f32x2v){c, s}; }
    for (int i = gt; i < T * 32; i += NGT) { const int t = i >> 5, p = i & 31; const float pos = (float)(p < 16 ? (t >> 6) : (t & 63));
        const float invf = __builtin_amdgcn_exp2f(-(float)(p & 15) * (13.287712379549449f / 16.0f));     const float ang = pos * invf; float s, c; sincosf(ang, &s, &c); ((f32x2v*)(F.ws + WS_ROPE))[i] = (f32x2v){c, s}; }
}

__device__ __forceinline__ void modulate_row_bf16(const Frame& F, const float* hrow, const float* sh, const float* sc, bf16* orow) {
    const GAS f32x4* xr = (const GAS f32x4*)hrow + F.lane; const f32x4* shv = (const f32x4*)sh + F.lane; const f32x4* scv = (const f32x4*)sc + F.lane;
    GAS v2u* o8 = (GAS v2u*)orow + F.lane;
#pragma unroll
    for (int j = 0; j < 4; ++j) { const f32x4 v = xr[64 * j], a = shv[64 * j], b = scv[64 * j]; const f32x4 y = v * (b + 1.0f) + a; v2u o; o.x = pk2(y.x, y.y); o.y = pk2(y.z, y.w); o8[64 * j] = o; }
}
__device__ __forceinline__ void phase_prologue_b(Frame& F0, const Args& A) {
    Frame F = fresh(F0);
    const int gw = F.vcu * NWAVES + F.wave, NGW = F.G * NWAVES;
    for (int R = gw; R < M; R += NGW) { const int mr = modrow_of(R);
        const float* src = R < ML ? A.in[I_X + F.z] + (size_t)R * D : A.in[I_CTX + F.z] + (size_t)(R - ML) * D;
        modulate_row_bf16(F, src, modv(F, 0, mr, 0), modv(F, 0, mr, 1), (bf16*)(F.ws + WS_ABUF) + (size_t)R * D); }
}

__device__ __forceinline__ void phase_prep(Frame& F0, const Args& A, int l, bool do_moe, bool do_hy) {
    Frame F = fresh(F0);
    const int gw = F.vcu * NWAVES + F.wave, NGW = F.G * NWAVES;
    if (do_moe) {
        LAS float* scr = (LAS float*)(F.lds + F.wave * TSCR);
        bf16* WGU = (bf16*)(F.ws + WS_WGU); bf16* WDN = (bf16*)(F.ws + WS_WDN);
        constexpr int NIT = 65 * 192; int it0, it1;
        if (F.G == 256) { const int b = (int)blockIdx.x; if (b < 64) { it0 = 37 * b; it1 = it0 + 37; } else { it0 = 2368 + (int)(((long)(b - 64) * (NIT - 2368)) / 192); it1 = 2368 + (int)(((long)(b - 63) * (NIT - 2368)) / 192); } }
        else { it0 = (int)(((long)F.vcu * NIT) / F.G); it1 = (int)(((long)(F.vcu + 1) * NIT) / F.G); }
        for (int it = it0 + F.wave; it < it1; it += NWAVES) {
            const int e = it / 192; int r = it % 192;
            const int which = r >> 6; r &= 63;
            if (which < 2) { const float* W = e < 64 ? (which == 0 ? A.in[I_WG + F.z] : A.in[I_WU + F.z]) + ((size_t)l * 64 + e) * (D * FF) : (which == 0 ? A.in[I_WSG + F.z] : A.in[I_WSU + F.z]) + (size_t)l * (D * FF);
                const int kb = r >> 2, nb = r & 3, n0 = nb * 64;
                transpose_item8(W, FF, (unsigned char*)WGU + (size_t)e * 512 * D, D, kb * 64, n0, (n0 >> 7) * 256 + which * 128 + (n0 & 127), scr, F.lane, 16.0f); }
            else { const float* W = e < 64 ? A.in[I_WD + F.z] + ((size_t)l * 64 + e) * (FF * D) : A.in[I_WSD + F.z] + (size_t)l * (FF * D);
                const int kb = r >> 4, nb = r & 15;
                transpose_item8(W, D, (unsigned char*)WDN + (size_t)e * D * FF, FF, kb * 64, nb * 64, nb * 64, scr, F.lane, 16.0f); }
        }
    }
    if (do_hy) {
        lds_barrier();
        LAS float* zb = (LAS float*)F.lds;
        LAS float* f1 = (LAS float*)(F.lds + 2048);
        LAS float* f2 = (LAS float*)(F.lds + 8192);
        const float* w1 = A.in[I_HYW1 + F.z] + (size_t)l * 17 * 64; const float* b1 = A.in[I_HYB1 + F.z] + l * 64; const float* fq = A.in[I_HYFREQ + F.z] + l * 64;
        const float* w2 = A.in[I_HYW2 + F.z] + (size_t)l * 64 * 64; const float* b2 = A.in[I_HYB2 + F.z] + l * 64; const float* w3 = A.in[I_HYW3 + F.z] + (size_t)l * 64 * 1024;
        const int nun = 256 + (l < DEPTH - 1 ? 16 : 0);
        for (int u = F.vcu; u < nun; u += F.G) {
            const bool lat = u < 256; const int L = lat ? T : LC; const int n0 = (lat ? u : u - 256) * 16;
            float* FT = (float*)(F.ws + (lat ? WS_FILT : WS_FILTC));
            if (F.tid < 16 * 17) { const int p = F.tid / 17, i = F.tid % 17; const int n = n0 + p; float z;
                if (i == 0) z = (float)n / (float)(L - 1);
                else { const int bi = (i - 1) & 7; const float band = 1e-4f + (float)bi * ((7.0f - 1e-4f) / 7.0f); const float w = 6.283185307179586f * (float)n / (float)L; const float a = band * w;
                    z = (i <= 8) ? cosf(a) : -sinf(a); }
                zb[p * 17 + i] = z; }
            lds_barrier();
            for (int o = F.tid; o < 16 * 64; o += 512) { const int p = o >> 6, j = o & 63; float s = b1[j];
#pragma unroll
                for (int i = 0; i < 17; ++i) s += zb[p * 17 + i] * w1[i * 64 + j];
                f1[o] = sinf(fq[j] * s); }
            lds_barrier();
            for (int o = F.tid; o < 16 * 64; o += 512) { const int p = o >> 6, j = o & 63; float s = b2[j];
#pragma unroll 8
                for (int i = 0; i < 64; ++i) s += f1[p * 64 + i] * w2[i * 64 + j];
                f2[o] = sinf(fq[j] * s); }
            lds_barrier();
#pragma unroll
            for (int cc = 0; cc < 2; ++cc) { const int col = F.tid + cc * 512; float acc[16];
#pragma unroll
                for (int p = 0; p < 16; ++p) acc[p] = 0.f;
                for (int k = 0; k < 64; ++k) { const float w = w3[k * 1024 + col];
#pragma unroll
                    for (int p = 0; p < 16; ++p) acc[p] += f2[p * 64 + k] * w; }
                const int c = col & 255; const float delta = 3.0701134573253945f + (float)c * ((15.350567286626973f - 3.0701134573253945f) / 255.0f);
#pragma unroll
                for (int p4 = 0; p4 < 4; ++p4) { f32x4 o;
#pragma unroll
                    for (int q = 0; q < 4; ++q) { const int n = n0 + p4 * 4 + q; const float tt = (float)n / (float)(L - 1); o[q] = acc[p4 * 4 + q] * __expf(-tt * delta); }
                    *(f32x4*)(FT + (size_t)col * L + n0 + p4 * 4) = o; } }
            lds_barrier();
        }
    }
}
struct TwHalf { const LAS f32x2v* T; __device__ __forceinline__ f32x2v operator[](int k) const { const f32x2v w = T[k & 2047]; return (k & 2048) ? (f32x2v){w.y, -w.x} : w; } };
#define PADI(e) ((e) + (((e) >> 5) << 1))
template <int R, class XT, class TWT>
__device__ __forceinline__ void dif_task(XT X, TWT tw, int s, int task) {
    const int lgM = 13 - s, lgq = lgM - R, q = 1 << lgq;
    const int j0 = task & (q - 1), blk = task >> lgq, base = (blk << lgM) + j0;
    const int pb = PADI(base), qp = (q >= 32) ? q + (q >> 4) : q;
    f32x2v v[1 << R];
#pragma unroll
    for (int k = 0; k < (1 << R); ++k) v[k] = X[pb + k * qp];
#pragma unroll
    for (int r = 0; r < R; ++r) {
        const int pb = R - 1 - r;
#pragma unroll
        for (int k = 0; k < (1 << R); ++k) if (!((k >> pb) & 1)) {
            const int klo = k & ((1 << pb) - 1);
            const f32x2v w = tw[(j0 + (klo << lgq)) << (s + r)];
            const f32x2v a = v[k], b = v[k + (1 << pb)], d = a - b;
            v[k] = a + b; v[k + (1 << pb)] = (f32x2v){d.x * w.x - d.y * w.y, d.x * w.y + d.y * w.x};
        }
    }
#pragma unroll
    for (int k = 0; k < (1 << R); ++k) X[pb + k * qp] = v[k];
}
template <int R, class XT, class TWT>
__device__ __forceinline__ void dit_task(XT X, TWT tw, int s, int task) {
    const int lgM = 13 - s, lgq = lgM - R, q = 1 << lgq;
    const int j0 = task & (q - 1), blk = task >> lgq, base = (blk << lgM) + j0;
    const int pb = PADI(base), qp = (q >= 32) ? q + (q >> 4) : q;
    f32x2v v[1 << R];
#pragma unroll
    for (int k = 0; k < (1 << R); ++k) v[k] = X[pb + k * qp];
#pragma unroll
    for (int r = R - 1; r >= 0; --r) {
        const int pb = R - 1 - r;
#pragma unroll
        for (int k = 0; k < (1 << R); ++k) if (!((k >> pb) & 1)) {
            const int klo = k & ((1 << pb) - 1);
            const f32x2v w = tw[(j0 + (klo << lgq)) << (s + r)];
            const f32x2v a = v[k], qv = v[k + (1 << pb)]; const f32x2v b = (f32x2v){qv.x * w.x + qv.y * w.y, qv.y * w.x - qv.x * w.y};
            v[k] = a + b; v[k + (1 << pb)] = a - b;
        }
    }
#pragma unroll
    for (int k = 0; k < (1 << R); ++k) X[pb + k * qp] = v[k];
}

__device__ __forceinline__ void load_tw(Frame& F, LAS f32x2v* tw) { const f32x2v* g = (const f32x2v*)(F.ws + WS_TW); for (int i = F.tid; i < 2048; i += 512) tw[i] = g[i]; }
__device__ __forceinline__ void fft_fwd_upper(LAS f32x2v* X, TwHalf tw, int s0, int tid) {
    if (s0 == 0) { dif_task<4>(X, tw, 0, tid); lds_barrier(); }
    dif_task<4>(X, tw, 4, tid); lds_barrier();
    dif_task<4>(X, tw, 8, tid); lds_barrier();
}
__device__ __forceinline__ void fft_inv_upper(LAS f32x2v* X, TwHalf tw, int s0, int tid) {
    dit_task<4>(X, tw, 8, tid); lds_barrier();
    dit_task<4>(X, tw, 4, tid); lds_barrier();
    if (s0 == 0) { dit_task<4>(X, tw, 0, tid); lds_barrier(); }
}

__device__ __forceinline__ void phase_spectra(Frame& F0, int l) {
    Frame F = fresh(F0);
    LAS f32x2v* X = (LAS f32x2v*)F.lds; LAS f32x2v* twl = (LAS f32x2v*)(F.lds + 69632); const TwHalf tw{twl};
    lds_barrier(); load_tw(F, twl);
    const int nun = 512 + (l < DEPTH - 1 ? 32 : 0);
    for (int u = F.vcu; u < nun; u += F.G) {
        const bool lat = u < 512; const int L = lat ? T : LC, lgN = lat ? 13 : 9, N = 2 * L; const int col0 = lat ? u : (u - 512) * 16;
        const float* FT = (const float*)(F.ws + (lat ? WS_FILT : WS_FILTC));
        lds_barrier();
        { float vv[16];
#pragma unroll
            for (int r = 0; r < 16; ++r) { const int e = F.tid + 512 * r, seg = e >> lgN, n = e & (N - 1); const int oc = col0 + seg;
                float v = 0.f;
                if (n < L) v = FT[(size_t)oc * L + n]; else if (n > L) v = FT[(size_t)(512 + oc) * L + (N - n)];
                vv[r] = v; }
#pragma unroll
            for (int r = 0; r < 16; ++r) X[PADI(F.tid + 512 * r)] = (f32x2v){vv[r], 0.f}; }
        lds_barrier();
        fft_fwd_upper(X, tw, 13 - lgN, F.tid);
        f32x2v* SP = (f32x2v*)(F.ws + (lat ? WS_SPEC : WS_SPECC)) + (size_t)col0 * N; const float sc = 1.0f / (float)N;
#pragma unroll 2
        for (int r = 0; r < 8; ++r) { const int e = 2 * (F.tid + 512 * r); const f32x2v a = X[PADI(e)], b = X[PADI(e + 1)];
            *(f32x4*)(SP + e) = (f32x4){(a.x + b.x) * sc, (a.y + b.y) * sc, (a.x - b.x) * sc, (a.y - b.y) * sc}; }
    }
    lds_barrier();
}

template <bool LAT>
__device__ __forceinline__ void hyconv_unit(const Frame& F, LAS f32x2v* X, const TwHalf tw, LAS bf16* OUT, const float* skip, bf16* MIX, int u) {
    constexpr int L = LAT ? T : LC, lgN = LAT ? 13 : 9, N = 2 * L, NV = LAT ? 8 : 16;
    const int bp = LAT ? (u >> 6) : ((u - 256) >> 4), cbase = LAT ? (u & 63) * 4 : ((u - 256) & 15) * 16;
    bf16* H0 = (bf16*)(F.ws + (LAT ? WS_HT : WS_HTC)) + (size_t)(2 * bp) * 768 * L; bf16* H1 = H0 + (size_t)768 * L;
    const int rowb = LAT ? (2 * bp) * T : ML + (2 * bp) * LC;
    const bool act = LAT || F.tid < LC;
    const int n = LAT ? 0 : F.tid;
    constexpr int nci = LAT ? 4 : 1;
#pragma unroll 1
    for (int ci = 0; ci < nci; ++ci) {
        const int c0 = cbase + ci;
        const f32x2v* SPb = (const f32x2v*)(F.ws + (LAT ? WS_SPEC : WS_SPECC)) + (size_t)c0 * N;
        lds_barrier();
        if constexpr (LAT) { f32x2v v[8];
#pragma unroll
            for (int r = 0; r < 8; ++r) { const bf16* p0 = H0 + (size_t)(512 + c0) * L; const bf16* p1 = H1 + (size_t)(512 + c0) * L; const int i = F.tid + 512 * r; v[r] = (f32x2v){bf2f(p0[i]), bf2f(p1[i])}; }
#pragma unroll
            for (int r = 0; r < 16; ++r) { const int e = F.tid + 512 * r; X[PADI(e)] = (r < 8) ? v[r] : (f32x2v){0.f, 0.f}; }
        } else {
            f32x2v v[16];
            { const bf16* p0 = H0 + (size_t)(512 + c0) * L + n; const bf16* p1 = H1 + (size_t)(512 + c0) * L + n;
#pragma unroll
              for (int r = 0; r < 16; ++r) { v[r] = (f32x2v){0.f, 0.f}; if (act) v[r] = (f32x2v){bf2f(p0[r * L]), bf2f(p1[r * L])}; } }
#pragma unroll
            for (int r = 0; r < 16; ++r) X[PADI(F.tid + 512 * r)] = v[r];
        }
        lds_barrier();
#pragma unroll 1
        for (int ord = 0; ord < 2; ++ord) {
            const f32x2v* SP = SPb + (size_t)ord * 256 * N;
            f32x4 kq[8];
#pragma unroll
            for (int r = 0; r < 8; ++r) kq[r] = *(const f32x4*)(SP + 2 * (F.tid + 512 * r));
            fft_fwd_upper(X, tw, 13 - lgN, F.tid);
#pragma unroll
            for (int r = 0; r < 8; ++r) { const int e = 2 * (F.tid + 512 * r);
                const f32x2v a = X[PADI(e)], b = X[PADI(e + 1)]; const f32x4 k = kq[r];
                const f32x2v p = a + b, q = a - b; const f32x2v pk = (f32x2v){p.x * k.x - p.y * k.y, p.x * k.y + p.y * k.x}, qk = (f32x2v){q.x * k.z - q.y * k.w, q.x * k.w + q.y * k.z};
                X[PADI(e)] = pk + qk; X[PADI(e + 1)] = pk - qk; }
            lds_barrier();
            if constexpr (LAT) {
                f32x2v g[8], zp[8]; const float sk = skip[ord * 256 + c0];
                const bf16* g0 = H0 + (size_t)(ord * 256 + c0) * L; const bf16* g1 = H1 + (size_t)(ord * 256 + c0) * L; bf16* v0 = H0 + (size_t)(512 + c0) * L; bf16* v1 = H1 + (size_t)(512 + c0) * L;
                fft_inv_upper(X, tw, 13 - lgN, F.tid);
#pragma unroll
                for (int r = 0; r < 8; ++r) { const int i = F.tid + 512 * r; g[r] = (f32x2v){bf2f(g0[i]), bf2f(g1[i])}; zp[r] = (f32x2v){bf2f(v0[i]), bf2f(v1[i])}; }
#pragma unroll
                for (int r = 0; r < 16; ++r) { const int e = F.tid + 512 * r; f32x2v z = (f32x2v){0.f, 0.f};
                    if (r < 8) { z = g[r] * (X[PADI(e)] + zp[r] * sk);
                        if (ord == 0) { v0[e] = (bf16)f2bf(z.x); v1[e] = (bf16)f2bf(z.y); }
                        else { OUT[e * 4 + ci] = (bf16)f2bf(z.x); OUT[(T + e) * 4 + ci] = (bf16)f2bf(z.y); } }
                    if (ord == 0) X[PADI(e)] = z; }
            } else {
                fft_inv_upper(X, tw, 13 - lgN, F.tid);
                f32x2v g[16], zp[16];
                { const bf16* g0 = H0 + (size_t)(ord * 256 + c0) * L + n; const bf16* g1 = H1 + (size_t)(ord * 256 + c0) * L + n; const bf16* v0 = H0 + (size_t)(512 + c0) * L + n; const bf16* v1 = H1 + (size_t)(512 + c0) * L + n;
#pragma unroll
                  for (int r = 0; r < 16; ++r) { g[r] = (f32x2v){0.f, 0.f}; zp[r] = g[r]; if (act) { g[r] = (f32x2v){bf2f(g0[r * L]), bf2f(g1[r * L])}; zp[r] = (f32x2v){bf2f(v0[r * L]), bf2f(v1[r * L])}; } } }
                f32x2v z[16];
#pragma unroll
                for (int r = 0; r < 16; ++r) { z[r] = g[r] * (X[PADI(F.tid + 512 * r)] + zp[r] * skip[ord * 256 + c0 + r]); }
                if (ord == 0) { bf16* v0 = H0 + (size_t)(512 + c0) * L + n; bf16* v1 = H1 + (size_t)(512 + c0) * L + n;
#pragma unroll
                    for (int r = 0; r < 16; ++r) { if (act) { v0[r * L] = (bf16)f2bf(z[r].x); v1[r * L] = (bf16)f2bf(z[r].y); } X[PADI(F.tid + 512 * r)] = z[r]; } }
                else if (act) {
                    v4u oa, ob, oc, od;
                    oa.x = pk2(z[0].x, z[1].x); oa.y = pk2(z[2].x, z[3].x); oa.z = pk2(z[4].x, z[5].x); oa.w = pk2(z[6].x, z[7].x); ob.x = pk2(z[8].x, z[9].x); ob.y = pk2(z[10].x, z[11].x); ob.z = pk2(z[12].x, z[13].x); ob.w = pk2(z[14].x, z[15].x);
                    oc.x = pk2(z[0].y, z[1].y); oc.y = pk2(z[2].y, z[3].y); oc.z = pk2(z[4].y, z[5].y); oc.w = pk2(z[6].y, z[7].y); od.x = pk2(z[8].y, z[9].y); od.y = pk2(z[10].y, z[11].y); od.z = pk2(z[12].y, z[13].y); od.w = pk2(z[14].y, z[15].y);
                    bf16* m0 = MIX + (size_t)(rowb + n) * 1024 + c0; bf16* m1 = m0 + (size_t)L * 1024;
                    *(v4u*)m0 = oa; *(v4u*)(m0 + 8) = ob; *(v4u*)m1 = oc; *(v4u*)(m1 + 8) = od; }
            }
            lds_barrier();
        }
    }
    if (LAT) {
#pragma unroll 4
        for (int r = 0; r < 16; ++r) { const int rr = F.tid + 512 * r; const v2u o = *(const LAS v2u*)(OUT + rr * 4); *(v2u*)(MIX + (size_t)(rowb + rr) * 1024 + cbase) = o; }
    }
}
__device__ __forceinline__ void phase_hyconv(Frame& F0, const Args& A, int l) {
    Frame F = fresh(F0);
    LAS f32x2v* X = (LAS f32x2v*)F.lds; LAS f32x2v* twl = (LAS f32x2v*)(F.lds + 69632); const TwHalf tw{twl};
    LAS bf16* OUT = (LAS bf16*)(F.lds + 69632 + 16384);
    lds_barrier(); load_tw(F, twl);
    const float* skip = A.in[I_HYSKIP + F.z] + (size_t)l * 512;
    bf16* MIX = (bf16*)(F.ws + WS_MIX);
    for (int u = F.vcu; u < 256; u += F.G) hyconv_unit<true>(F, X, tw, OUT, skip, MIX, u);
    if (l < DEPTH - 1) { const int v = F.vcu - 64; if (v >= 0 && v < 64) hyconv_unit<false>(F, X, tw, OUT, skip, MIX, 256 + v); else if (F.G < 128) for (int u = 256 + F.vcu; u < 320; u += F.G) hyconv_unit<false>(F, X, tw, OUT, skip, MIX, u); }
    lds_barrier();
}
__device__ __forceinline__ void phase_qkv_rows(Frame& F0, const Args& A, int l) {
    Frame F = fresh(F0);
    const int gw = F.vcu * NWAVES + F.wave, NGW = F.G * NWAVES, lane = F.lane;
    const bf16* P = (const bf16*)(F.ws + WS_P); bf16* QB = (bf16*)(F.ws + WS_QB); bf16* KB = (bf16*)(F.ws + WS_KB); bf16* VB = (bf16*)(F.ws + WS_VB);
    const float* qg = A.in[I_QN + F.z] + l * 64; const float* kg = A.in[I_KN + F.z] + l * 64; const f32x2v* rope = (const f32x2v*)(F.ws + WS_ROPE);
    const bool last = (l == DEPTH - 1);
    float qgl[8]; { const int d0 = (8 * lane) & 63;
#pragma unroll
        for (int j = 0; j < 8; ++j) qgl[j] = qg[d0 + j]; }
    const float kg0 = kg[(2 * lane) & 63], kg1 = kg[((2 * lane) & 63) + 1];
    const int p0 = (4 * lane) & 31;
    for (int Rb = gw; Rb < M; Rb += 2 * NGW) {
        unsigned kw[2], vw[2]; v4u qw[2]; f32x2v kcs[2], qcs[2][4]; bool lat[2], doq[2], ok[2]; int tt[2]; long kvrow[2];
#pragma unroll
        for (int q = 0; q < 2; ++q) { const int R = Rb + q * NGW; ok[q] = R < M; const int Rc = ok[q] ? R : Rb;
            lat[q] = Rc < ML; const int b = lat[q] ? (Rc >> 12) : ((Rc - ML) >> 8); tt[q] = lat[q] ? (Rc & 4095) : ((Rc - ML) & 255);
            kvrow[q] = (long)b * SKV + (lat[q] ? tt[q] : T + tt[q]); doq[q] = lat[q] || !last;
            const bf16* pr = P + (size_t)Rc * PROJ;
            kw[q] = *(const unsigned*)(pr + C_K + 2 * lane); vw[q] = *(const unsigned*)(pr + C_V + 2 * lane); qw[q] = *(const v4u*)(pr + C_Q + 8 * lane);
            const int tr = lat[q] ? tt[q] : 0; kcs[q] = rope[tr * 32 + (lane & 31)];
#pragma unroll
            for (int j = 0; j < 4; ++j) qcs[q][j] = rope[tr * 32 + p0 + j]; }
#pragma unroll
        for (int q = 0; q < 2; ++q) { if (!ok[q]) continue; const int R = Rb + q * NGW;
            { float k0 = bflo(kw[q]), k1 = bfhi(kw[q]); float ss = k0 * k0 + k1 * k1;
                ss = sum32(ss);
                const float rs = 1.0f / sqrtf(ss * (1.0f / 64.0f) + QK_EPS); k0 = k0 * rs * kg0; k1 = k1 * rs * kg1;
                if (lat[q]) { const f32x2v cs = kcs[q]; const float r0 = k0 * cs.x - k1 * cs.y, r1 = k0 * cs.y + k1 * cs.x; k0 = r0; k1 = r1; }
                *(unsigned*)(KB + kvrow[q] * 128 + 2 * lane) = pk2(k0, k1); *(unsigned*)(VB + kvrow[q] * 128 + 2 * lane) = vw[q]; }
            if (doq[q]) { float qv[8];
                qv[0] = bflo(qw[q].x); qv[1] = bfhi(qw[q].x); qv[2] = bflo(qw[q].y); qv[3] = bfhi(qw[q].y); qv[4] = bflo(qw[q].z); qv[5] = bfhi(qw[q].z); qv[6] = bflo(qw[q].w); qv[7] = bfhi(qw[q].w);
                float ss = 0.f;
#pragma unroll
                for (int j = 0; j < 8; ++j) ss += qv[j] * qv[j];
                ss = sum8(ss);
                const float rs = 1.0f / sqrtf(ss * (1.0f / 64.0f) + QK_EPS);
#pragma unroll
                for (int j = 0; j < 8; ++j) qv[j] = qv[j] * rs * qgl[j];
                if (lat[q]) {
#pragma unroll
                    for (int j = 0; j < 4; ++j) { const f32x2v cs = qcs[q][j]; const float r0 = qv[2 * j] * cs.x - qv[2 * j + 1] * cs.y, r1 = qv[2 * j] * cs.y + qv[2 * j + 1] * cs.x; qv[2 * j] = r0; qv[2 * j + 1] = r1; } }
                constexpr float C2 = 0.125f * 1.4426950408889634f;
                v4u o; o.x = pk2(qv[0] * C2, qv[1] * C2); o.y = pk2(qv[2] * C2, qv[3] * C2); o.z = pk2(qv[4] * C2, qv[5] * C2); o.w = pk2(qv[6] * C2, qv[7] * C2);
                *(v4u*)(QB + (size_t)R * 512 + 8 * lane) = o; }
        }
    }
}

__device__ __forceinline__ void phase_hy_short(Frame& F0, const Args& A, int l) {
    Frame F = fresh(F0);
    const int gw = F.vcu * NWAVES + F.wave, NGW = F.G * NWAVES, lane = F.lane;
    LAS float* scr = (LAS float*)(F.lds + F.wave * 16384);
    const bf16* P = (const bf16*)(F.ws + WS_P);
    const float* sw = A.in[I_HYSW + F.z] + (size_t)l * 3 * 768; const float* sb = A.in[I_HYSB + F.z] + (size_t)l * 768;
    const int nlat = NB * 64 * 24, nctx = (l < DEPTH - 1) ? NB * 4 * 24 : 0;
    lds_barrier();
    for (int it = gw; it < nlat + nctx; it += NGW) {
        const bool lat = it < nlat; const int r = lat ? it : it - nlat; const int cb = r % 24; const int tb = (r / 24) % (lat ? 64 : 4); const int b = r / (24 * (lat ? 64 : 4));
        const int L = lat ? T : LC, t0 = tb * 64, c0 = cb * 32; const size_t row0 = lat ? (size_t)b * T : (size_t)ML + (size_t)b * LC;
        { v4u w[5]; const int cq = (lane & 3) * 8;
#pragma unroll
            for (int i = 0; i < 5; ++i) { const int rr = (lane >> 2) + 16 * i; const int t = t0 - 1 + rr; w[i] = (v4u){0u, 0u, 0u, 0u};
                if (rr < 66 && t >= 0 && t < L) w[i] = *(const v4u*)(P + (row0 + t) * PROJ + C_HY + c0 + cq); }
#pragma unroll
            for (int i = 0; i < 5; ++i) { const int rr = (lane >> 2) + 16 * i; if (rr < 66) { LAS float* d = scr + rr * 33 + cq;
                d[0] = bflo(w[i].x); d[1] = bfhi(w[i].x); d[2] = bflo(w[i].y); d[3] = bfhi(w[i].y); d[4] = bflo(w[i].z); d[5] = bfhi(w[i].z); d[6] = bflo(w[i].w); d[7] = bfhi(w[i].w); } } }
        LDS_WAIT(); asm volatile("" ::: "memory");
        bf16* HT = (bf16*)(F.ws + (lat ? WS_HT : WS_HTC)) + ((size_t)b * 768 + c0) * L + t0 + lane;
        float outv[32];
#pragma unroll
        for (int c = 0; c < 32; ++c) { const int ch = c0 + c; const float w0 = sw[ch], w1 = sw[768 + ch], w2 = sw[1536 + ch], bb = sb[ch];
            outv[c] = scr[lane * 33 + c] * w0 + scr[(lane + 1) * 33 + c] * w1 + scr[(lane + 2) * 33 + c] * w2 + bb; }
#pragma unroll
        for (int c = 0; c < 32; ++c) HT[(size_t)c * L] = (bf16)f2bf(outv[c]);
        LDS_WAIT(); asm volatile("" ::: "memory");
    }
}

__device__ __forceinline__ float fsigmoid(float x) { return __builtin_amdgcn_rcpf(1.0f + __expf(-x)); }
__device__ __forceinline__ float bperm_f(int idx4, float x) { return __builtin_bit_cast(float, __builtin_amdgcn_ds_bpermute(idx4, __builtin_bit_cast(int, x))); }
template <int CTRL> __device__ __forceinline__ float dpp_f(float old, float src) { return __builtin_bit_cast(float, __builtin_amdgcn_update_dpp(__builtin_bit_cast(int, old), __builtin_bit_cast(int, src), CTRL, 0xF, 0xF, false)); }
template <bool REV, int S> __device__ __forceinline__ void rg_scan_step(float& Av, float& Bv) {
    const float Ap = dpp_f<(REV ? 0x100 : 0x110) + S>(1.0f, Av), Bp = dpp_f<(REV ? 0x100 : 0x110) + S>(0.0f, Bv);
    Bv = Av * Bp + Bv; Av = Ap * Av;
}
__device__ __forceinline__ int rg_chain_tile(int b, int dir, int p) { return p < 4 ? 512 + 4 * b + (dir ? 3 - p : p) : 64 * b + (dir ? 67 - p : p - 4); }
template <int PASS, bool REV>
__device__ __forceinline__ void rg_wave_body(const Frame& F, const LAS bf16* UB, const bf16* Wg, const LAS float* cst  , int blk, int R0, int u, int d,
                                             f32x2v* CAR, const LAS float* CIN, LAS float* HS, const bf16* P, bf16* MIX, bool emit, int ng_lo, int ng_hi) {
    const int lane = F.lane, fr = lane & 15, fq = lane >> 4;
    bf16x8 wcur[2][2];
#pragma unroll
    for (int gt = 0; gt < 2; ++gt)
#pragma unroll
        for (int kk = 0; kk < 2; ++kk) wcur[gt][kk] = *(const bf16x8*)(Wg + ((size_t)(gt * 4 + blk) * 64 + ng_lo * 16 + fr) * 64 + kk * 32 + fq * 8);
#pragma unroll 1
    for (int ng = ng_lo; ng < ng_hi; ++ng) {
        f32x4 aa[4], ax[4];
        v2u gwv[4];
#pragma unroll
        for (int tg = 0; tg < 4; ++tg) { aa[tg] = (f32x4){0.f, 0.f, 0.f, 0.f}; ax[tg] = (f32x4){0.f, 0.f, 0.f, 0.f}; }
#pragma unroll
        for (int kk = 0; kk < 2; ++kk) { const bf16x8 wa = wcur[0][kk], wx = wcur[1][kk]; bf16x8 uf[4][2];
#pragma unroll
            for (int tg = 0; tg < 4; ++tg) uf[tg][kk] = *(const LAS bf16x8*)(UB + (tg * 16 + fr) * 264 + blk * 64 + kk * 32 + fq * 8);
#pragma unroll
            for (int tg = 0; tg < 4; ++tg) { aa[tg] = __builtin_amdgcn_mfma_f32_16x16x32_bf16(wa, uf[tg][kk], aa[tg], 0, 0, 0); ax[tg] = __builtin_amdgcn_mfma_f32_16x16x32_bf16(wx, uf[tg][kk], ax[tg], 0, 0, 0); } }
        { const int ng1 = (ng + 1 < ng_hi) ? ng + 1 : ng_lo;
#pragma unroll
            for (int gt = 0; gt < 2; ++gt)
#pragma unroll
                for (int kk = 0; kk < 2; ++kk) wcur[gt][kk] = *(const bf16x8*)(Wg + ((size_t)(gt * 4 + blk) * 64 + ng1 * 16 + fr) * 64 + kk * 32 + fq * 8); }
        if (PASS == 2 && REV && emit) {
#pragma unroll
            for (int tg = 0; tg < 4; ++tg) gwv[tg] = *(const v2u*)(P + (size_t)(R0 + tg * 16 + fr) * PROJ + C_RGG + blk * 64 + ng * 16 + fq * 4); }
        const int ch = blk * 64 + ng * 16 + fq * 4; const f32x4 sp = *(const LAS f32x4*)(cst + ch), bav = *(const LAS f32x4*)(cst + 256 + ch), bxv = *(const LAS f32x4*)(cst + 512 + ch);
#pragma unroll
        for (int tg = 0; tg < 4; ++tg) { const v2u uw = *(const LAS v2u*)(UB + (tg * 16 + fr) * 264 + ch); const float uv[4] = {bflo(uw.x), bfhi(uw.x), bflo(uw.y), bfhi(uw.y)};
#pragma unroll
            for (int j = 0; j < 4; ++j) { const float r = fsigmoid(aa[tg][j] + bav[j]), ig = fsigmoid(ax[tg][j] + bxv[j]); const float la = -8.0f * r * sp[j];
                float Av = __expf(la); const float om = __builtin_fmaf(-Av, Av, 1.0f);
                float Bv = __builtin_amdgcn_sqrtf(om) * (ig * uv[j]);
                rg_scan_step<REV, 1>(Av, Bv); rg_scan_step<REV, 2>(Av, Bv); rg_scan_step<REV, 4>(Av, Bv); rg_scan_step<REV, 8>(Av, Bv);
                aa[tg][j] = Av; ax[tg][j] = Bv; } }
        const int lastl4 = ((lane & 48) | (REV ? 0 : 15)) << 2;
        if (PASS == 1) {
            f32x4 At = (f32x4){1.f, 1.f, 1.f, 1.f}, Bt = (f32x4){0.f, 0.f, 0.f, 0.f};
#pragma unroll
            for (int t4 = 0; t4 < 4; ++t4) { const int tg = REV ? 3 - t4 : t4;
#pragma unroll
                for (int j = 0; j < 4; ++j) { const float ta = bperm_f(lastl4, aa[tg][j]), tb = bperm_f(lastl4, ax[tg][j]); Bt[j] = ta * Bt[j] + tb; At[j] = At[j] * ta; } }
            if (fr == 0) { f32x4* cp = (f32x4*)(CAR + ((size_t)u * 2 + d) * 256 + ch); cp[0] = (f32x4){At[0], Bt[0], At[1], Bt[1]}; cp[1] = (f32x4){At[2], Bt[2], At[3], Bt[3]}; }
        } else {
            f32x4 hin = *(const LAS f32x4*)(CIN + d * 256 + ch);
#pragma unroll
            for (int t4 = 0; t4 < 4; ++t4) { const int tg = REV ? 3 - t4 : t4;
#pragma unroll
                for (int j = 0; j < 4; ++j) { const float h = aa[tg][j] * hin[j] + ax[tg][j]; ax[tg][j] = h; hin[j] = bperm_f(lastl4, h); } }
            LAS float* hs = HS + (ng & 1) * 4096;
            if (!REV) {
#pragma unroll
                for (int tg = 0; tg < 4; ++tg) *(LAS f32x4*)(hs + (tg * 16 + fr) * 64 + blk * 16 + fq * 4) = ax[tg];
            }
            lds_barrier();
            if (REV && emit) {
#pragma unroll
                for (int tg = 0; tg < 4; ++tg) { const int tok = tg * 16 + fr; const f32x4 hf = *(const LAS f32x4*)(hs + tok * 64 + blk * 16 + fq * 4);
                    const v2u gw = gwv[tg]; const float g[4] = {bflo(gw.x), bfhi(gw.x), bflo(gw.y), bfhi(gw.y)}; float y[4];
#pragma unroll
                    for (int j = 0; j < 4; ++j) { const float x = g[j]; const float u2 = 1.5957691216057308f * (x + 0.044715f * x * x * x); y[j] = (hf[j] + ax[tg][j]) * x * fsigmoid(u2); }
                    v2u o; o.x = pk2(y[0], y[1]); o.y = pk2(y[2], y[3]); *(v2u*)(MIX + (size_t)(R0 + tok) * 1024 + 768 + ch) = o; }
            }
        }
    }
}
template <int PASS>
__device__ __forceinline__ void phase_rg(Frame& F0, const Args& A, int l) {
    Frame F = fresh(F0);
    LAS bf16* UB = (LAS bf16*)F.lds;
    LAS float* CIN = (LAS float*)(F.lds + 34816);
    LAS float* HS = (LAS float*)(F.lds + 36864);
    const bf16* P = (const bf16*)(F.ws + WS_P); bf16* MIX = (bf16*)(F.ws + WS_MIX);
    const float* cw = A.in[I_RGCW + F.z] + (size_t)l * 4 * 256; const float* cb = A.in[I_RGCB + F.z] + (size_t)l * 256;
    const int wave = F.wave, d = wave >> 2, blk = wave & 3;
    const bf16* Wg = (const bf16*)(F.ws + WS_RGW) + ((size_t)(l * 2 + d) * 2) * 4 * 4096;
    LAS float* CST = (LAS float*)(F.lds + 69632);
    lds_barrier();
    for (int i = F.tid; i < 2 * 3 * 256; i += 512) { const int dd = i / 768, k = (i / 256) % 3, c = i & 255; const size_t o = (size_t)(l * 2 + dd) * 256 + c; float v;
        if (k == 0) { const float x = -A.in[I_RGLAM + F.z][o]; const float ex = __expf(-fabsf(x)); const float l1p = ex < 0.03125f ? ex * (1.0f + ex * (-0.5f + ex * (0.33333334f + ex * -0.25f))) : __logf(1.0f + ex); v = fmaxf(x, 0.f) + l1p;     } else v = (k == 1 ? A.in[I_RGBA + F.z] : A.in[I_RGBX + F.z])[o];
        CST[i] = v; }
    LAS float* CW = CST + 1536;
    for (int i = F.tid; i < 1280; i += 512) CW[i] = i < 1024 ? cw[i] : cb[i - 1024];
    f32x2v* CAR = (f32x2v*)(F.ws + WS_RGA);
    const bool last = (l == DEPTH - 1);
    const int ntile = (PASS == 2 && last) ? ML / 64 : M / 64;
    const int nit = (F.G == 256) ? 3 : (ntile + F.G - 1) / F.G;
    for (int it = 0; it < nit; ++it) {
        int u = F.vcu + it * F.G, ng_lo = 0, ng_hi = 4;
        if (F.G == 256 && it == 2) { if (F.vcu >= 128) { const int pc = F.vcu - 128; u = 512 + (pc >> 2); ng_lo = pc & 3; ng_hi = ng_lo + 1; } else u = ntile; }
        if (u >= ntile) continue;
        const int R0 = u * 64; const bool lat = R0 < ML; const int L = lat ? T : LC; const int t0 = lat ? (R0 & 4095) : ((R0 - ML) & 255);
        lds_barrier(); tm_seg(F, 24);
        { const int tok = F.tid >> 3, cg = (F.tid & 7) * 32; const int t = t0 + tok;
#pragma unroll
            for (int c8 = 0; c8 < 4; ++c8) { const int ch = cg + c8 * 8; float acc[8];
#pragma unroll
                for (int j = 0; j < 8; ++j) acc[j] = CW[1024 + ch + j];
#pragma unroll
                for (int tap = 0; tap < 4; ++tap) { const int tt = t - 1 + tap;
                    if (tt >= 0 && tt < L) { const v4u w = *(const v4u*)(P + (size_t)(R0 + tok - 1 + tap) * PROJ + C_RGX + ch); const LAS float* cwp = CW + tap * 256 + ch;
                        acc[0] += bflo(w.x) * cwp[0]; acc[1] += bfhi(w.x) * cwp[1]; acc[2] += bflo(w.y) * cwp[2]; acc[3] += bfhi(w.y) * cwp[3];
                        acc[4] += bflo(w.z) * cwp[4]; acc[5] += bfhi(w.z) * cwp[5]; acc[6] += bflo(w.w) * cwp[6]; acc[7] += bfhi(w.w) * cwp[7]; } }
                v4u o; o.x = pk2(acc[0], acc[1]); o.y = pk2(acc[2], acc[3]); o.z = pk2(acc[4], acc[5]); o.w = pk2(acc[6], acc[7]);
                *(LAS v4u*)(UB + tok * 264 + ch) = o; } }
        tm_seg(F, 25);
        if (PASS == 2) {
            const int dir = F.tid >> 8, ch = F.tid & 255; const int b = lat ? (u >> 6) : ((u - 512) >> 2); const int i = lat ? (u & 63) : ((u - 512) & 3);
            const int pos = lat ? (dir ? 4 + 63 - i : 4 + i) : (dir ? 3 - i : i);
            float h = 0.f;
            for (int p0 = 0; p0 < pos; p0 += 17) { f32x2v cv[17];
#pragma unroll
                for (int j = 0; j < 17; ++j) { const int p = p0 + j; cv[j] = (f32x2v){1.f, 0.f}; if (p < pos) cv[j] = CAR[((size_t)rg_chain_tile(b, dir, p) * 2 + dir) * 256 + ch]; }
#pragma unroll
                for (int j = 0; j < 17; ++j) h = cv[j].x * h + cv[j].y; }
            CIN[dir * 256 + ch] = h;
        }
        lds_barrier(); tm_seg(F, 26);
        const bool emit = true;
        if (d == 0) rg_wave_body<PASS, false>(F, UB, Wg, CST, blk, R0, u, 0, CAR, CIN, HS, P, MIX, emit, ng_lo, ng_hi);
        else        rg_wave_body<PASS, true >(F, UB, Wg, CST + 768, blk, R0, u, 1, CAR, CIN, HS, P, MIX, emit, ng_lo, ng_hi);
    }
    lds_barrier(); tm_seg(F, PASS == 1 ? 15 : 11);
}

__device__ __forceinline__ void phase_attention(Frame& F0, int l) {
    Frame F = fresh(F0);
    const attn_body::bf16* Q = (const attn_body::bf16*)(F.ws + WS_QB); const attn_body::bf16* K = (const attn_body::bf16*)(F.ws + WS_KB); const attn_body::bf16* V = (const attn_body::bf16*)(F.ws + WS_VB);
    attn_body::bf16* O = (attn_body::bf16*)(F.ws + WS_MIX);
    char* shm = F.ldsg;
    for (int v = F.vcu; v < 256; v += F.G) { const int pair = v >> 4, qb = v & 15, b = pair >> 1, kvh = pair & 1;
        for (int g = 0; g < 4; ++g) { const int h = kvh * 4 + g;
            attn_body::attn_unit<8>((long)b * T + qb * 256, h * 64, (long)b * SKV, kvh * 64, SKV / 64, (long)b * T + qb * 256, 256 + h * 64, Q, K, V, O, shm, F.wave); } }
    if (l < DEPTH - 1) for (int v = F.vcu; v < 64; v += F.G) { const int b = v >> 3, h = v & 7;
        attn_body::attn_unit<8>((long)ML + b * LC, h * 64, (long)b * SKV + T, (h >> 2) * 64, LC / 64, (long)ML + b * LC, 256 + h * 64, Q, K, V, O, shm, F.wave); }
}
__device__ __forceinline__ float* hrow_ptr(const Frame& F, int R) { return R < ML ? F.out + (size_t)R * D : (float*)(F.ws + WS_HC) + (size_t)(R - ML) * D; }

__device__ __forceinline__ unsigned wave_max_u32(unsigned x) {
#define WMX_STEP(ctrl, rmask) { const unsigned y_ = (unsigned)__builtin_amdgcn_update_dpp((int)x, (int)x, ctrl, rmask, 0xF, false); x = x > y_ ? x : y_; }
    WMX_STEP(0x111, 0xF) WMX_STEP(0x112, 0xF) WMX_STEP(0x114, 0xF) WMX_STEP(0x118, 0xF) WMX_STEP(0x142, 0xA) WMX_STEP(0x143, 0xC)
#undef WMX_STEP
    return (unsigned)__builtin_amdgcn_readlane((int)x, 63);
}
__device__ __forceinline__ void phase_ln1(Frame& F0, const Args& A, int l, bool v_from_h) {
    Frame F = fresh(F0);
    const bool last = (l == DEPTH - 1); const int ngroups = (last ? ML : M) / 16;
    LAS bf16* MH = (LAS bf16*)F.lds;
    LAS bf16* MLo = (LAS bf16*)(F.lds + 33024);
    LAS float* PL = (LAS float*)(F.lds + 66048);
    LAS float* LOG = (LAS float*)(F.lds + 66048 + 32768);
    LAS int* lhist = (LAS int*)(F.lds + 66048 + 32768 + 4096);
    const int lane = F.lane, wave = F.wave, fr = lane & 15, fq = lane >> 4;
    const float* lg = A.in[I_LN1G + F.z] + l * D; const float* lb = A.in[I_LN1B + F.z] + l * D; const float* brt = A.in[I_BR + F.z] + l * NEXP;
    const bf16* RH = (const bf16*)(F.ws + WS_RTHI) + (size_t)l * NEXP * D; const bf16* RL = (const bf16*)(F.ws + WS_RTLO) + (size_t)l * NEXP * D;
    int* IDX = (int*)(F.ws + WS_IDX); float* WT = (float*)(F.ws + WS_WT); bf16* ABUF = (bf16*)(F.ws + WS_ABUF);
    lds_barrier();
    if (F.tid < 64) lhist[F.tid] = 0;
#define LN1_VSRC(R_) ((v_from_h && l == 0) ? ((R_) < ML ? A.in[I_X + F.z] + (size_t)(R_) * D : A.in[I_CTX + F.z] + (size_t)((R_) - ML) * D) : (const float*)hrow_ptr(F, (R_)))
    f32x4 nv[2][4]; v2u nvb[2][4];
    const bf16* VB16 = (const bf16*)(F.ws + WS_V);
#define LN1_PREFETCH(g_) do { _Pragma("unroll") for (int rr = 0; rr < 2; ++rr) { const int R_ = (g_) * 16 + 2 * wave + rr; \
        if (v_from_h) { const float* vp_ = LN1_VSRC(R_); _Pragma("unroll") for (int j = 0; j < 4; ++j) nv[rr][j] = *(const f32x4*)(vp_ + 4 * lane + 256 * j); } \
        else { _Pragma("unroll") for (int j = 0; j < 4; ++j) nvb[rr][j] = __builtin_nontemporal_load((const v2u*)(VB16 + (size_t)R_ * D + 4 * lane + 256 * j)); } } } while (0)
#define LN1_ROWPART(g_, gn_) do { \
        f32x4 cv[2][4]; _Pragma("unroll") for (int rr = 0; rr < 2; ++rr) _Pragma("unroll") for (int j = 0; j < 4; ++j) cv[rr][j] = v_from_h ? nv[rr][j] : (f32x4){bflo(nvb[rr][j].x), bfhi(nvb[rr][j].x), bflo(nvb[rr][j].y), bfhi(nvb[rr][j].y)}; \
        const int mr = modrow_of((g_) * 16); f32x4 sc2v[4], sh2v[4], gv[4], bv[4]; \
        { const float* sh2 = modv(F, l, mr, 3); const float* sc2 = modv(F, l, mr, 4); \
          _Pragma("unroll") for (int j = 0; j < 4; ++j) { sc2v[j] = *(const f32x4*)(sc2 + 4 * lane + 256 * j); sh2v[j] = *(const f32x4*)(sh2 + 4 * lane + 256 * j); gv[j] = *(const f32x4*)(lg + 4 * lane + 256 * j); bv[j] = *(const f32x4*)(lb + 4 * lane + 256 * j); } } \
        if ((gn_) < ngroups) LN1_PREFETCH(gn_); \
        const float vs = v_from_h ? DN_ALPHA : 1.0f; \
        _Pragma("unroll") for (int rr = 0; rr < 2; ++rr) { const int tok = 2 * wave + rr, R = (g_) * 16 + tok; float* hp = hrow_ptr(F, R); f32x4 v[4]; float s = 0.f; \
            _Pragma("unroll") for (int j = 0; j < 4; ++j) { v[j] = cv[rr][j] * vs; s += (v[j].x + v[j].y) + (v[j].z + v[j].w); } \
            const float mean = wave_sum(s) * (1.f / D); float s2 = 0.f; \
            _Pragma("unroll") for (int j = 0; j < 4; ++j) { v[j] = v[j] - mean; s2 += (v[j].x * v[j].x + v[j].y * v[j].y) + (v[j].z * v[j].z + v[j].w * v[j].w); } \
            const float rstd = 1.f / sqrtf(wave_sum(s2) * (1.f / D) + LN_EPS); \
            _Pragma("unroll") for (int j = 0; j < 4; ++j) { const f32x4 h = v[j] * rstd * gv[j] + bv[j]; __builtin_nontemporal_store(h, (f32x4*)(hp + 4 * lane + 256 * j)); \
                const f32x4 m = h * (sc2v[j] + 1.0f) + sh2v[j]; \
                const unsigned h0 = f2bf(m.x), h1 = f2bf(m.y), h2 = f2bf(m.z), h3 = f2bf(m.w); \
                v2u hi; hi.x = h0 | (h1 << 16); hi.y = h2 | (h3 << 16); \
                v2u lo; lo.x = pk2(m.x - bf2f(h0), m.y - bf2f(h1)); lo.y = pk2(m.z - bf2f(h2), m.w - bf2f(h3)); \
                *(unsigned*)((unsigned char*)ABUF + (size_t)R * D + 4 * lane + 256 * j) = pk4_fp8(m.x, m.y, m.z, m.w); \
                *(LAS v2u*)(MH + tok * 1032 + 4 * lane + 256 * j) = hi; *(LAS v2u*)(MLo + tok * 1032 + 4 * lane + 256 * j) = lo; } } } while (0)
    if (F.vcu < ngroups) { LN1_PREFETCH(F.vcu); LN1_ROWPART(F.vcu, F.vcu + F.G); }
    bf16x8 wh[4][4], wl[4][4];
#define LN1_WLOAD(KA, KB2) do { _Pragma("unroll") for (int kk = (KA); kk < (KB2); ++kk) { const int k0_ = wave * 128 + kk * 32 + fq * 8; _Pragma("unroll") for (int eg = 0; eg < 4; ++eg) { wh[kk][eg] = *(const bf16x8*)(RH + (size_t)(eg * 16 + fr) * D + k0_); wl[kk][eg] = *(const bf16x8*)(RL + (size_t)(eg * 16 + fr) * D + k0_); } } } while (0)
    LN1_WLOAD(0, 2);
    lds_barrier();
    for (int g = F.vcu; g < ngroups; g += F.G) {
        tm_seg(F, 21);
        {   LN1_WLOAD(2, 4);
            f32x4 acc[4];
#pragma unroll
            for (int eg = 0; eg < 4; ++eg) acc[eg] = (f32x4){0.f, 0.f, 0.f, 0.f};
#pragma unroll
            for (int kk = 0; kk < 4; ++kk) { const int k0 = wave * 128 + kk * 32 + fq * 8;
                const bf16x8 ah = *(const LAS bf16x8*)(MH + fr * 1032 + k0), al = *(const LAS bf16x8*)(MLo + fr * 1032 + k0);
#pragma unroll
                for (int eg = 0; eg < 4; ++eg) {
                    acc[eg] = __builtin_amdgcn_mfma_f32_16x16x32_bf16(wh[kk][eg], ah, acc[eg], 0, 0, 0);
                    acc[eg] = __builtin_amdgcn_mfma_f32_16x16x32_bf16(wl[kk][eg], ah, acc[eg], 0, 0, 0);
                    acc[eg] = __builtin_amdgcn_mfma_f32_16x16x32_bf16(wh[kk][eg], al, acc[eg], 0, 0, 0); } }
#pragma unroll
            for (int eg = 0; eg < 4; ++eg) *(LAS f32x4*)(PL + (wave * 16 + fr) * 64 + eg * 16 + fq * 4) = acc[eg]; }
        lds_barrier(); tm_seg(F, 20);
        if (g + F.G < ngroups) LN1_ROWPART(g + F.G, g + 2 * F.G);
        tm_seg(F, 22);
        { const int o = F.tid * 2; float s0 = 0.f, s1 = 0.f;
#pragma unroll
            for (int w = 0; w < 8; ++w) { const f32x2v p = *(const LAS f32x2v*)(PL + w * 1024 + o); s0 += p.x; s1 += p.y; }
            *(LAS f32x2v*)(LOG + o) = (f32x2v){s0, s1}; }
        lds_barrier(); tm_seg(F, 23);
        LN1_WLOAD(0, 2); asm volatile("" ::: "memory");
        {
            float score[2]; unsigned key[2]; int my_e[2] = {0, 0}; float my_s[2] = {0.f, 0.f}, ssum[2] = {0.f, 0.f};
#pragma unroll
            for (int rr = 0; rr < 2; ++rr) { score[rr] = __builtin_amdgcn_rcpf(1.0f + __expf(-LOG[(2 * wave + rr) * 64 + lane]));
                key[rr] = (__float_as_uint(score[rr] + brt[lane] + 2.0f) & ~63u) | (unsigned)(63 - lane); }
#pragma unroll
            for (int r = 0; r < 8; ++r) {
#pragma unroll
                for (int rr = 0; rr < 2; ++rr) { const unsigned mx = wave_max_u32(key[rr]); const int bi = 63 - (int)(mx & 63u);
                    const float ws = __builtin_bit_cast(float, __builtin_amdgcn_readlane(__builtin_bit_cast(int, score[rr]), bi)); ssum[rr] += ws; if (lane == r) { my_e[rr] = bi; my_s[rr] = ws; } if (lane == bi) key[rr] = 0u; } }
#pragma unroll
            for (int rr = 0; rr < 2; ++rr) { const int R = g * 16 + 2 * wave + rr;
                if (lane < 8) { IDX[(size_t)R * 8 + lane] = my_e[rr]; WT[(size_t)R * 8 + lane] = my_s[rr] / ssum[rr] * ROUTED_SCALE; atomicAdd((int*)&lhist[my_e[rr]], 1); } }
        }
    }
#undef LN1_ROWPART
#undef LN1_WLOAD
#undef LN1_PREFETCH
    lds_barrier(); tm_seg(F, 6  );
    if (F.tid < 64) ((int*)(F.ws + WS_HIST))[F.vcu * 64 + F.tid] = lhist[F.tid];
}

__device__ __forceinline__ void phase_sort(Frame& F0, int l) {
    Frame F = fresh(F0);
    const bool last = (l == DEPTH - 1); const int ngroups = (last ? ML : M) / 16;
    LAS int* pa = (LAS int*)F.lds;
    LAS int* pb = pa + 512;
    LAS int* tot = pb + 512;
    LAS int* mybase = tot + 64;
    LAS int* segbase = mybase + 64;
    LAS int* tpre = segbase + 80;
    LAS int* lcnt = tpre + 80;
    const int* HIST = (const int*)(F.ws + WS_HIST);
    lds_barrier();
    { const int e = F.tid & 63, part = F.tid >> 6; int sa = 0, sb = 0;
        for (int w = part * 32; w < part * 32 + 32; ++w) if (w < F.G) { const int h = HIST[w * 64 + e]; sa += h; if (w < F.vcu) sb += h; }
        pa[part * 64 + e] = sa; pb[part * 64 + e] = sb; }
    lds_barrier();
    if (F.tid < 64) { int sa = 0, sb = 0;
#pragma unroll
        for (int p = 0; p < 8; ++p) { sa += pa[p * 64 + F.tid]; sb += pb[p * 64 + F.tid]; }
        tot[F.tid] = sa; mybase[F.tid] = sb; lcnt[F.tid] = 0; }
    lds_barrier();
    if (F.tid == 0) { int s = 0, tp = 0; for (int e = 0; e < 64; ++e) { segbase[e] = s; tpre[e] = tp; const int nt = (tot[e] + 255) >> 8; s += nt * 256; tp += nt; }
        segbase[64] = s; tpre[64] = tp; tpre[65] = tp + (last ? ML : M) / 256; }
    lds_barrier();
    const int* IDX = (const int*)(F.ws + WS_IDX); const float* WT = (const float*)(F.ws + WS_WT);
    int* POS = (int*)(F.ws + WS_POS); int* STOK = (int*)(F.ws + WS_STOK); float* SWT = (float*)(F.ws + WS_SWT);
    const int mygroups = (ngroups - F.vcu + F.G - 1) / F.G;
    for (int idx = F.tid; idx < mygroups * 128; idx += 512) { const int gi = idx >> 7, w = idx & 127; const int R = (F.vcu + F.G * gi) * 16 + (w >> 3), k = w & 7;
        const int e = IDX[(size_t)R * 8 + k]; const int rank = atomicAdd((int*)&lcnt[e], 1); const int pos = segbase[e] + mybase[e] + rank;
        POS[(size_t)R * 8 + k] = pos; STOK[pos] = R; SWT[pos] = WT[(size_t)R * 8 + k]; }
    for (int e = F.vcu; e < 64; e += F.G) { const int lo = segbase[e] + tot[e], hi = segbase[e + 1]; for (int p = lo + F.tid; p < hi; p += 512) { STOK[p] = 0; SWT[p] = 0.f; } }
    if (F.vcu == 0) { unsigned* TL = (unsigned*)(F.ws + WS_TILES); const int ntot = tpre[65];
        for (int i = F.tid; i < ntot; i += 512) { int e = 0; while (e < 64 && i >= tpre[e + 1]) ++e;
            TL[i] = ((unsigned)e << 16) | (unsigned)(e < 64 ? (segbase[e] >> 8) + (i - tpre[e]) : (SH0 >> 8) + (i - tpre[64])); }
        if (F.tid == 0) TL[1536] = (unsigned)ntot; }
    lds_barrier();
}

__device__ __forceinline__ int load_tiles(Frame& F0) {
    Frame F = fresh(F0);
    const unsigned* TL = (const unsigned*)(F.ws + WS_TILES); LAS unsigned* LT = (LAS unsigned*)(F.lds + LTILES_OFF);
    lds_barrier();
    const int ntot = (int)__hip_atomic_load(TL + 1536, RLX_AGENT);
    for (int i = F.tid; i < ntot && i < 1536; i += 512) LT[i] = TL[i];
    lds_barrier();
    return __builtin_amdgcn_readfirstlane(ntot);
}

__device__ __forceinline__ void add_f8x16(f32x4 (&f)[4], const v4u w) {
    typedef float f2 __attribute__((ext_vector_type(2)));
    const unsigned ww[4] = {w.x, w.y, w.z, w.w};
#pragma unroll
    for (int i = 0; i < 4; ++i) { const f2 lo = __builtin_amdgcn_cvt_pk_f32_fp8((int)ww[i], false), hi = __builtin_amdgcn_cvt_pk_f32_fp8((int)ww[i], true); f[i] += (f32x4){lo.x, lo.y, hi.x, hi.y}; }
}
__device__ __forceinline__ void phase_ln2(Frame& F0, const Args& A, int l, bool have_moe) {
    Frame F = fresh(F0);
    const bool last = (l == DEPTH - 1); const int nrows = last ? ML : M;
    const int gw = F.vcu * NWAVES + F.wave, NGW = F.G * NWAVES, lane = F.lane;
    const float* lg = A.in[I_LN2G + F.z] + l * D; const float* lb = A.in[I_LN2B + F.z] + l * D;
    const unsigned char* Y2 = (const unsigned char*)(F.ws + WS_Y2); const unsigned char* SHY = (const unsigned char*)(F.ws + WS_SHY); unsigned char* AB8 = (unsigned char*)(F.ws + WS_ABUF); bf16* ABUF = (bf16*)(F.ws + WS_ABUF); const int* POS = (const int*)(F.ws + WS_POS);
    const unsigned c0 = 16u * (unsigned)lane;
    LAS float* MV = (LAS float*)F.lds; LAS float* LG = MV + 27 * 1024; LAS float* LB = LG + 1024;
    lds_barrier();
    for (int i = F.tid; i < 27 * 256; i += 512) { const int r = i / 768, k = (i / 256) % 3, c = (i & 255) * 4;
        const f32x4 v = (k == 0) ? *(const f32x4*)(modv(F, l, r, 5) + c) : (last ? (f32x4){0.f, 0.f, 0.f, 0.f} : *(const f32x4*)(modv(F, l + 1, r, k == 1 ? 1 : 0) + c));
        *(LAS f32x4*)(MV + (r * 3 + k) * 1024 + c) = v; }
    for (int i = F.tid; i < 256; i += 512) { *(LAS f32x4*)(LG + i * 4) = *(const f32x4*)(lg + i * 4); *(LAS f32x4*)(LB + i * 4) = *(const f32x4*)(lb + i * 4); }
    lds_barrier();
    int pkn[2] = {0, 0};
    if (have_moe && lane < 8) { const int R = 2 * gw; if (R < nrows) { pkn[0] = POS[R * 8 + lane]; pkn[1] = POS[(R + 1) * 8 + lane]; } }
    for (int R = 2 * gw; R < nrows; R += 2 * NGW) {
        int pk[2] = {pkn[0], pkn[1]};
        if (have_moe && lane < 8) { const int Rn = R + 2 * NGW; if (Rn < nrows) { pkn[0] = POS[Rn * 8 + lane]; pkn[1] = POS[(Rn + 1) * 8 + lane]; } }
        v4u w[2][9]; f32x4 hv[2][4];
#pragma unroll
        for (int q = 0; q < 2; ++q) { const float* hp = hrow_ptr(F, R + q);
#pragma unroll
            for (int j = 0; j < 4; ++j) hv[q][j] = *(const f32x4*)(hp + c0 + 4 * j);
            if (have_moe) { w[q][8] = __builtin_nontemporal_load((const v4u*)(SHY + (size_t)(R + q) * D + c0));
#pragma unroll
                for (int k = 0; k < 8; ++k) { const int p = __builtin_amdgcn_readlane(pk[q], k); w[q][k] = __builtin_nontemporal_load((const v4u*)(Y2 + (size_t)p * D + c0)); } } }
#pragma unroll
        for (int q = 0; q < 2; ++q) { const int Rq = R + q; const int mr = modrow_of(Rq); float* hp = hrow_ptr(F, Rq); const LAS float* mv = MV + mr * 3 * 1024;
            f32x4 f[4];
#pragma unroll
            for (int j = 0; j < 4; ++j) f[j] = (f32x4){0.f, 0.f, 0.f, 0.f};
            if (have_moe) {
#pragma unroll
                for (int k = 0; k < 9; ++k) add_f8x16(f, w[q][k]); }
            f32x4 v[4]; float s = 0.f;
#pragma unroll
            for (int j = 0; j < 4; ++j) { const unsigned col = c0 + 4 * j; v[j] = hv[q][j] * DN_ALPHA + *(const LAS f32x4*)(mv + col) * (f[j] * (1.0f / 16.0f)); s += (v[j].x + v[j].y) + (v[j].z + v[j].w); }
            const float mean = wave_sum(s) * (1.f / D); float s2 = 0.f;
#pragma unroll
            for (int j = 0; j < 4; ++j) { v[j] = v[j] - mean; s2 += (v[j].x * v[j].x + v[j].y * v[j].y) + (v[j].z * v[j].z + v[j].w * v[j].w); }
            const float rstd = 1.f / sqrtf(wave_sum(s2) * (1.f / D) + LN_EPS);
            f32x4 a[4];
#pragma unroll
            for (int j = 0; j < 4; ++j) { const unsigned col = c0 + 4 * j; const f32x4 h = v[j] * rstd * *(const LAS f32x4*)(LG + col) + *(const LAS f32x4*)(LB + col); __builtin_nontemporal_store(h, (f32x4*)(hp + col));
                if (!last) a[j] = h * (*(const LAS f32x4*)(mv + 1024 + col) + 1.0f) + *(const LAS f32x4*)(mv + 2048 + col); }
            if (!last) {
#pragma unroll
                for (int hh = 0; hh < 2; ++hh) { v4u o; o.x = pk2(a[2 * hh].x, a[2 * hh].y); o.y = pk2(a[2 * hh].z, a[2 * hh].w); o.z = pk2(a[2 * hh + 1].x, a[2 * hh + 1].y); o.w = pk2(a[2 * hh + 1].z, a[2 * hh + 1].w);
                    *(v4u*)(ABUF + (size_t)Rq * D + c0 + 8 * hh) = o; } }
        }
    }
}
#ifndef MK_MIXER
#define MK_MIXER 7
#endif
#ifndef MK_MOE
#define MK_MOE 1
#endif
#ifndef MK_PHASES
#define MK_PHASES 0xFFFFFFFFu
#endif
#define PH(n) ((MK_PHASES >> (n)) & 1u)
#ifndef MK_TMULT
#define MK_TMULT 1
#endif
enum { SG_PRO = 0, SG_PROB = 1, SG_INPROJ = 2, SG_POST1 = 3, SG_POST2 = 4, SG_OUTPROJ = 5, SG_LN1 = 6, SG_SORT = 7, SG_GU = 8, SG_DOWN = 9, SG_LN2 = 10 };
#ifndef MK_REP
#define MK_REP 0u
#endif
#define REP(n) ((MK_REP >> (n)) & 1u)
__device__ __forceinline__ void zero_mix_cols(Frame& F, int c0, int ncols) {
    bf16* MIX = (bf16*)(F.ws + WS_MIX); const int per = ncols / 8; const size_t tot = (size_t)M * per;
    for (size_t i = (size_t)F.vcu * 512 + F.tid; i < tot; i += (size_t)F.G * 512) { const size_t R = i / per; const int c = (int)(i % per) * 8; *(v4u*)(MIX + R * 1024 + c0 + c) = (v4u){0u, 0u, 0u, 0u}; }
}
__global__ void __launch_bounds__(NWAVES * 64, 2) mk_fwd(Args args) {
    extern __shared__ __attribute__((aligned(16))) unsigned char lds[];
    Frame F;
    F.lds = (LAS unsigned char*)lds; F.ldsg = (char*)lds;
    F.MISC = (volatile LAS unsigned*)(F.lds + MISC_OFF);
    F.tid = threadIdx.x; F.lane = F.tid & 63; F.wave = __builtin_amdgcn_readfirstlane(F.tid >> 6);
    F.G = gridDim.x; { const int bx = blockIdx.x; F.vcu = (F.G % 8 == 0) ? (bx % 8) * (F.G / 8) + bx / 8 : bx; }
    F.ws = args.ws; F.out = args.out; F.ctl = (gu32*)(args.ws + WS_CTL); F.z = 0;
    for (int u = F.tid; u < (LDS_BYTES - LDSCTL_OFF) / 4; u += NWAVES * 64) ((LAS unsigned*)(F.lds + LDSCTL_OFF))[u] = 0u;
    __syncthreads();
    XcdBarrier bar = xcd_barrier_post((unsigned*)(F.ctl + CW_BAR), F.MISC + 8);
    if (MK_TMASK && threadIdx.x == 0) { tm_set(F, __builtin_amdgcn_s_memrealtime(), 0ull, SG_PRO); }
#define TSEG(id) tm_seg(F, (id))
#define GRID_BAR(next) do { xcd_barrier(bar, F.wave == 0 && lane_id() == 0); TSEG(next); } while (0)
    const Args& A = args;
    if (PH(0)) phase_prologue_a(F, A);
    { Frame Fk = fresh(F); float* SWT = (float*)(Fk.ws + WS_SWT); for (int i = Fk.vcu * 512 + Fk.tid; i < M; i += Fk.G * 512) SWT[SH0 + i] = 1.0f; }
    GRID_BAR(SG_PROB);
    if (MK_MIXER && PH(1)) phase_prologue_b(F, A);
    for (int l = 0; l < DEPTH; ++l) {
        const bool last = (l == DEPTH - 1);
        if (l > 0 || MK_MIXER) GRID_BAR(MK_MIXER ? SG_INPROJ : SG_LN1);
        if (MK_MIXER) {
            {   Frame Fk = fresh(F); Frame& F = Fk;
                pg8::Gemm g{(const pg8::bf16_t*)(F.ws + WS_ABUF), (const pg8::bf16_t*)(F.ws + WS_WIN) + (size_t)l * PROJ * D, M, PROJ, D, 0};
                pg8::StaticOrder S; S.init(M, PROJ, F.G, (int)blockIdx.x);
                pg8::EpiBf16 E{(pg8::bf16_t*)(F.ws + WS_P), PROJ, nullptr, 1 << 30, 0, false};
                if (PH(2)) { pg8::gemm_phase<pg8::EpiBf16, pg8::StaticOrder, true, false, 1024>(F.lds + RING_OFF, g, S, E, F.wave); if (REP(2)) { pg8::gemm_phase<pg8::EpiBf16, pg8::StaticOrder, true, false, 1024>(F.lds + RING_OFF, g, S, E, F.wave); } }
                TSEG(16);
                if (PH(3)) { phase_prep(F, A, l, MK_MOE != 0, (MK_MIXER & 2) != 0); if (REP(3)) { phase_prep(F, A, l, MK_MOE != 0, (MK_MIXER & 2) != 0); } }
            }
            GRID_BAR(SG_POST1);
            if ((MK_MIXER & 1) && PH(4)) { phase_qkv_rows(F, A, l); if (REP(4)) { phase_qkv_rows(F, A, l); } }
            TSEG(13);
            if (MK_MIXER & 2) { if (PH(5)) { phase_hy_short(F, A, l); if (REP(5)) phase_hy_short(F, A, l); } TSEG(14); if (PH(6)) { phase_spectra(F, l); if (REP(6)) phase_spectra(F, l); } }
            TSEG(15);
            if ((MK_MIXER & 4) && PH(7)) { phase_rg<1>(F, A, l); if (REP(7)) { phase_rg<1>(F, A, l); } }
            GRID_BAR(SG_POST2);
            if (MK_MIXER & 4) { if (PH(8)) phase_rg<2>(F, A, l); } else zero_mix_cols(F, 768, 256);
            TSEG(11);
            if (MK_MIXER & 2) { if (PH(9)) phase_hyconv(F, A, l); } else zero_mix_cols(F, 0, 256);
            TSEG(12);
            if (MK_MIXER & 1) { lds_barrier(); if (PH(10)) { phase_attention(F, l); if (REP(10)) phase_attention(F, l); } } else zero_mix_cols(F, 256, 512);
            GRID_BAR(SG_OUTPROJ);
            {   Frame Fk = fresh(F); Frame& F = Fk;
                pg8::Gemm g{(const pg8::bf16_t*)(F.ws + WS_MIX), (const pg8::bf16_t*)(F.ws + WS_WOUT) + (size_t)l * D * D, M, D, D, 0};
                pg8::StaticOrder S; S.init(last ? ML : M, D, F.G, (int)blockIdx.x);
                pg8::EpiResid E{l == 0 ? A.in[I_X] : F.out, l == 0 ? A.in[I_CTX] : (const float*)(F.ws + WS_HC), (pg8::bf16_t*)(F.ws + WS_V), modv(F, l, 0, 2), 6144, ML / 256, DN_ALPHA};
                if (PH(11)) pg8::gemm_phase<pg8::EpiResid, pg8::StaticOrder, true, false, 1024>(F.lds + RING_OFF, g, S, E, F.wave);
            }
            GRID_BAR(SG_LN1);
        } else if (MK_MOE) {
            if (PH(3)) { phase_prep(F, A, l, true, false); if (REP(3)) { phase_prep(F, A, l, true, false); } }
        }
        if (PH(12)) phase_ln1(F, A, l, MK_MIXER == 0);
        GRID_BAR(MK_MOE ? SG_SORT : SG_LN2);
        if (MK_MOE) {
            if (PH(13)) { phase_sort(F, l); if (REP(13)) { phase_sort(F, l); } }
            GRID_BAR(SG_GU);
            {   const int ntiles = load_tiles(F); Frame Fk = fresh(F); Frame& F = Fk;
                pg8::Gemm g{(const pg8::bf16_t*)(F.ws + WS_ABUF), (const pg8::bf16_t*)(F.ws + WS_WGU), M, 512, D, (size_t)512 * D};
                pg8::MoeOrder S{(const LAS unsigned*)(F.lds + LTILES_OFF), ntiles, 2, F.G, F.vcu, (const int*)(F.ws + WS_STOK), SH0 / 256, (const LAS int*)(F.lds + RING_BYTES)};
                {
                    LAS int* LT = (LAS int*)(F.lds + RING_BYTES); pg8::Unit uu;
#pragma unroll 1
                    for (int i = 0; i < 24 && S.next(i, uu); ++i) if (F.tid < 256) LT[i * 256 + F.tid] = S.arow_g(uu, F.tid);
                    lds_barrier(); }
                pg8::EpiGU E{(unsigned char*)(F.ws + WS_HID), (const float*)(F.ws + WS_SWT)};
                if (PH(14)) { pg8::gemm_phase<pg8::EpiGU, pg8::MoeOrder, true, true, 1024, true>(F.lds + RING_OFF, g, S, E, F.wave); if (REP(14)) { pg8::gemm_phase<pg8::EpiGU, pg8::MoeOrder, true, true, 1024, true>(F.lds + RING_OFF, g, S, E, F.wave); } }
            }
            if (F.wave == 0) { __builtin_amdgcn_fence(__ATOMIC_ACQUIRE, "agent"); asm volatile("s_waitcnt vmcnt(0)" ::: "memory"); }
            __syncthreads(); TSEG(SG_DOWN);
            {   const int ntiles = load_tiles(F); Frame Fk = fresh(F); Frame& F = Fk;
                pg8::Gemm g{(const pg8::bf16_t*)(F.ws + WS_HID), (const pg8::bf16_t*)(F.ws + WS_WDN), HIDROWS, D, FF, (size_t)D * FF};
                pg8::MoeOrder S{(const LAS unsigned*)(F.lds + LTILES_OFF), ntiles, 4, F.G, F.vcu, (const int*)(F.ws + WS_STOK), SH0 / 256, nullptr};
                pg8::EpiF8 E{(unsigned char*)(F.ws + WS_Y2), D, (unsigned char*)(F.ws + WS_SHY), D, SH0 / 256, SH0 / 256, 16.0f};
                if (PH(15)) { pg8::gemm_phase<pg8::EpiF8, pg8::MoeOrder, false, false, 256, true, (MK_TMASK != 0)>(F.lds + RING_OFF, g, S, E, F.wave, F.MISC, SG_DOWN); if (REP(15)) { pg8::gemm_phase<pg8::EpiF8, pg8::MoeOrder, false, false, 256, true, (MK_TMASK != 0)>(F.lds + RING_OFF, g, S, E, F.wave, F.MISC, SG_DOWN); } }
            }
            GRID_BAR(SG_LN2);
        }
        if (PH(16)) phase_ln2(F, A, l, MK_MOE != 0);
    }
    if (MK_TMASK) {
        xcd_barrier(bar, F.wave == 0 && lane_id() == 0); TSEG(SG_PRO);
        if (blockIdx.x == 0 && F.wave == 0 && lane_id() == 0) { const unsigned long long t_acc = tm_acc(F); const unsigned long long t0 = __builtin_amdgcn_s_memrealtime(); while (__builtin_amdgcn_s_memrealtime() - t0 < t_acc * MK_TMULT) __builtin_amdgcn_s_sleep(32); }
    }
}

extern "C" void kernel_launch(void* const* d_in, const int* in_sizes, int n_in, void* d_out, int out_size, void* d_ws, size_t ws_size, hipStream_t stream) {
    static int grid = 0;
    if (grid == 0) {
        if (n_in != N_IN || in_sizes[0] != ML * D || out_size != ML * D || ws_size < WS_END) { fprintf(stderr, "kernel_launch: unexpected shapes (n_in %d in0 %d out %d ws %zu need %zu); nothing launched\n", n_in, n_in > 0 ? in_sizes[0] : -1, out_size, ws_size, (size_t)WS_END); grid = -1; return; }
        int dev = 0, cus = 0, per_cu = 0;
        if (hipGetDevice(&dev) != hipSuccess || hipDeviceGetAttribute(&cus, hipDeviceAttributeMultiprocessorCount, dev) != hipSuccess) { grid = -1; return; }
        if (hipFuncSetAttribute((const void*)mk_fwd, hipFuncAttributeMaxDynamicSharedMemorySize, LDS_BYTES) != hipSuccess) { fprintf(stderr, "kernel_launch: hipFuncSetAttribute failed\n"); grid = -1; return; }
        if (hipOccupancyMaxActiveBlocksPerMultiprocessor(&per_cu, (const void*)mk_fwd, NWAVES * 64, LDS_BYTES) != hipSuccess || per_cu < 1) { fprintf(stderr, "kernel_launch: occupancy query reports %d\n", per_cu); }
        (void)hipGetLastError();
        grid = cus;
    }
    if (grid < 0) return;
    if (hipMemsetAsync((char*)d_ws + WS_CTL, 0, CTL_ZERO_BYTES, stream) != hipSuccess) return;
    Args a{};
    for (int i = 0; i < N_IN; ++i) a.in[i] = (const float*)d_in[i];
    a.out = (float*)d_out; a.ws = (unsigned char*)d_ws;
    hipLaunchKernelGGL(mk_fwd, dim3(grid), dim3(NWAVES * 64), LDS_BYTES, stream, a);
}
```

```cpp
#include <hip/hip_runtime.h>
#include <hip/hip_bf16.h>
#include <cstdio>
#include <cstdint>
#include <cmath>
#ifndef MK_TMASK
#define MK_TMASK 0u
#endif
namespace pg8 {
#define PG8_LAS __attribute__((address_space(3)))
typedef unsigned short bf16_t;
typedef short bf16x8 __attribute__((ext_vector_type(8)));
typedef float f32x4 __attribute__((ext_vector_type(4)));
typedef unsigned u32x4 __attribute__((ext_vector_type(4)));
constexpr int BM = 256, BK = 64, HALF = 128, HTB = HALF * BK * 2  , STAGE_BYTES = 8 * HTB, NXCD = 8, WGM = 8;

__host__ __device__ __forceinline__ int lds_byte(int r, int c) { const int st = (r >> 4) * 2 + (c >> 5), rr = r & 15, cc = c & 31, ob = rr * 64 + cc * 2; return st * 1024 + (ob ^ (((ob >> 9) & 1) << 5)); }
__host__ __device__ __forceinline__ void stage_rc(int b, int& R, int& C) { const int st = b / 1024, sb = b % 1024, swz = sb ^ (((sb >> 9) & 1) << 5); R = (st >> 1) * 16 + swz / 64; C = (st & 1) * 32 + (swz % 64) / 2; }
__host__ __device__ __forceinline__ int perm32(int rho) { const int n = rho >> 4, i = rho & 15; return 8 * (i >> 2) + 4 * n + (i & 3); }

struct Unit { int pm, pn, e; };
struct Gemm { const bf16_t* A; const bf16_t* Bt; int M, N, K; size_t bstride; };

struct StaticOrder {
    int nM, nN, nwg, G, c;
    __host__ __device__ void init(int M, int N, int G_, int c_) { nM = M / BM; nN = N / BM; nwg = nM * nN; G = G_; c = c_; }
    __host__ __device__ bool next(int i, Unit& u) const {
        const long L = (long)i * G + c; if (L >= nwg) return false;
        int wgid = (int)L; { const int q = nwg / NXCD, r = nwg % NXCD, xcd = wgid % NXCD, off = wgid / NXCD; wgid = (xcd < r ? xcd * (q + 1) : r * (q + 1) + (xcd - r) * q) + off; }
        const int nig = WGM * nN, gid = wgid / nig, fm = gid * WGM, gsz = (nM - fm) < WGM ? (nM - fm) : WGM;
        u.pm = fm + ((wgid % nig) % gsz); u.pn = (wgid % nig) / gsz; u.e = 0; return true;
    }
    __device__ __forceinline__ void a_ready(const Unit&) const {}
    __device__ __forceinline__ void done(const Unit&) const {}
};

__device__ __forceinline__ unsigned cvt_pk_bf16(float lo, float hi) { unsigned r; asm volatile("v_cvt_pk_bf16_f32 %0, %1, %2" : "=v"(r) : "v"(lo), "v"(hi)); return r; }
typedef float f32x2 __attribute__((ext_vector_type(2)));
__device__ __forceinline__ unsigned pk4f8(float a, float b, float c, float d) { int w = 0; w = __builtin_amdgcn_cvt_pk_fp8_f32(a, b, w, false); w = __builtin_amdgcn_cvt_pk_fp8_f32(c, d, w, true); return (unsigned)w; }

struct EpiBf16 {
    static constexpr bool PERM = true;
    bf16_t* O; int ldc; bf16_t* O2; int pm_split; int pm_off2; bool nt;
    __device__ __forceinline__ void operator()(const f32x4 (&acc)[2][2][4][2], const Unit& u, int wr, int wc, int fr, int fq) const {
        bf16_t* base = O; int pm = u.pm; if (pm >= pm_split) { base = O2; pm -= pm_off2; }
        const int row0 = pm * BM + wr * 64 + fr; const int col0 = u.pn * BM + wc * 32 + 8 * fq;
#pragma unroll
        for (int ai = 0; ai < 2; ++ai)
#pragma unroll
            for (int m = 0; m < 4; ++m) { bf16_t* rowp = base + (size_t)(row0 + ai * HALF + m * 16) * ldc + col0;
#pragma unroll
                for (int bj = 0; bj < 2; ++bj) { const f32x4 v0 = acc[ai][bj][m][0], v1 = acc[ai][bj][m][1];
                    u32x4 w; w.x = cvt_pk_bf16(v0[0], v0[1]); w.y = cvt_pk_bf16(v0[2], v0[3]); w.z = cvt_pk_bf16(v1[0], v1[1]); w.w = cvt_pk_bf16(v1[2], v1[3]);
                    if (nt) __builtin_nontemporal_store(w, (u32x4*)(rowp + bj * HALF)); else *(u32x4*)(rowp + bj * HALF) = w; } }
    }
};
struct EpiF8 {
    static constexpr bool PERM = true;
    unsigned char* O; int ldc; unsigned char* O2; int ldc2; int pm_split; int pm_off2; float scale;
    __device__ __forceinline__ void operator()(const f32x4 (&acc)[2][2][4][2], const Unit& u, int wr, int wc, int fr, int fq) const {
        unsigned char* base = O; int pm = u.pm; int ld = ldc; if (pm >= pm_split) { base = O2; pm -= pm_off2; ld = ldc2; }
        const int row0 = pm * BM + wr * 64 + fr; const int col0 = u.pn * BM + wc * 32 + ((fq & 1) ? HALF + 8 * (fq - 1) : 8 * fq);
#pragma unroll
        for (int ai = 0; ai < 2; ++ai)
#pragma unroll
            for (int m = 0; m < 4; ++m) { unsigned char* rowp = base + (size_t)(row0 + ai * HALF + m * 16) * ld + col0;
                const f32x4 p0 = acc[ai][0][m][0] * scale, p1 = acc[ai][0][m][1] * scale, q0 = acc[ai][1][m][0] * scale, q1 = acc[ai][1][m][1] * scale;
                unsigned ax = pk4f8(p0[0], p0[1], p0[2], p0[3]), ay = pk4f8(p1[0], p1[1], p1[2], p1[3]), bx = pk4f8(q0[0], q0[1], q0[2], q0[3]), by = pk4f8(q1[0], q1[1], q1[2], q1[3]);
                { auto r = __builtin_amdgcn_permlane16_swap(ax, bx, false, false); ax = r[0]; bx = r[1]; }
                { auto r = __builtin_amdgcn_permlane16_swap(ay, by, false, false); ay = r[0]; by = r[1]; }
                u32x4 w; w.x = ax; w.y = ay; w.z = bx; w.w = by;
                *(u32x4*)rowp = w; }
    }
};
struct EpiResid {
    static constexpr bool PERM = true;
    const bf16_t* hs; bf16_t* V; const float* gate; int gate_stride; int ml_tiles; float alpha;
    __device__ __forceinline__ void operator()(const f32x4 (&acc)[2][2][4][2], const Unit& u, int wr, int wc, int fr, int fq) const {
        const bool lat = u.pm < ml_tiles;
        const int modrow = lat ? (u.pm >> 4) : 8;
        const int grow0 = u.pm * BM + wr * 64 + fr; const int col0 = u.pn * BM + wc * 32 + 8 * fq;
        f32x4 gv[2][2];
#pragma unroll
        for (int bj = 0; bj < 2; ++bj)
#pragma unroll
            for (int n = 0; n < 2; ++n) gv[bj][n] = *(const f32x4*)(gate + (size_t)modrow * gate_stride + col0 + bj * HALF + n * 4);
        u32x4 hv[2][2];
#pragma unroll
        for (int bj = 0; bj < 2; ++bj) hv[0][bj] = *(const u32x4*)(hs + (size_t)grow0 * 1024 + col0 + bj * HALF);
#pragma unroll
        for (int st = 0; st < 8; ++st) { const int ai = st >> 2, m = st & 3;
            if (st < 7) { const int ai2 = (st + 1) >> 2, m2 = (st + 1) & 3; const size_t off2 = (size_t)(grow0 + ai2 * HALF + m2 * 16) * 1024 + col0;
#pragma unroll
                for (int bj = 0; bj < 2; ++bj) hv[(st + 1) & 1][bj] = *(const u32x4*)(hs + off2 + bj * HALF); }
            bf16_t* vrow = V + (size_t)(grow0 + ai * HALF + m * 16) * 1024 + col0;
#pragma unroll
            for (int bj = 0; bj < 2; ++bj) { const u32x4 hw = hv[st & 1][bj];
                const f32x4 h0 = (f32x4){__builtin_bit_cast(float, hw.x << 16), __builtin_bit_cast(float, hw.x & 0xffff0000u), __builtin_bit_cast(float, hw.y << 16), __builtin_bit_cast(float, hw.y & 0xffff0000u)};
                const f32x4 h1 = (f32x4){__builtin_bit_cast(float, hw.z << 16), __builtin_bit_cast(float, hw.z & 0xffff0000u), __builtin_bit_cast(float, hw.w << 16), __builtin_bit_cast(float, hw.w & 0xffff0000u)};
                const f32x4 v0 = h0 * alpha + gv[bj][0] * acc[ai][bj][m][0], v1 = h1 * alpha + gv[bj][1] * acc[ai][bj][m][1];
                u32x4 w; w.x = cvt_pk_bf16(v0[0], v0[1]); w.y = cvt_pk_bf16(v0[2], v0[3]); w.z = cvt_pk_bf16(v1[0], v1[1]); w.w = cvt_pk_bf16(v1[2], v1[3]);
                *(u32x4*)(vrow + bj * HALF) = w; } }
    }
};
struct EpiGU {
    static constexpr bool PERM = true;
    unsigned char* H; const float* swt;
    __device__ __forceinline__ void operator()(const f32x4 (&acc)[2][2][4][2], const Unit& u, int wr, int wc, int fr, int fq) const {
        const int row0 = u.pm * BM + wr * 64 + fr; const int col0 = u.pn * HALF + wc * 32 + 8 * (fq & ~1);
#pragma unroll
        for (int ai = 0; ai < 2; ++ai)
#pragma unroll
            for (int mp = 0; mp < 4; mp += 2) { unsigned pk[2][2];
#pragma unroll
                for (int dm = 0; dm < 2; ++dm) { const int m = mp + dm; const int row = row0 + ai * HALF + m * 16; const float w = swt[row];
                    float h[8];
#pragma unroll
                    for (int n = 0; n < 2; ++n)
#pragma unroll
                        for (int j = 0; j < 4; ++j) { const float g = acc[ai][0][m][n][j], up = acc[ai][1][m][n][j];
                            const float s = g * __builtin_amdgcn_rcpf(1.0f + __builtin_amdgcn_exp2f(-1.4426950408889634f * g)); h[n * 4 + j] = s * up * w; }
                    pk[dm][0] = pk4f8(h[0], h[1], h[2], h[3]); pk[dm][1] = pk4f8(h[4], h[5], h[6], h[7]); }
                { auto r = __builtin_amdgcn_permlane16_swap(pk[0][0], pk[1][0], false, false); pk[0][0] = r[0]; pk[1][0] = r[1]; }
                { auto r = __builtin_amdgcn_permlane16_swap(pk[0][1], pk[1][1], false, false); pk[0][1] = r[0]; pk[1][1] = r[1]; }
                u32x4 o; o.x = pk[0][0]; o.y = pk[0][1]; o.z = pk[1][0]; o.w = pk[1][1];
                const int row = row0 + ai * HALF + (mp + (fq & 1)) * 16;
                *(u32x4*)(H + (size_t)row * 256 + col0) = o; }
    }
};
struct MoeOrder {
    const PG8_LAS unsigned* tiles; int ntiles, nN, G, c; const int* stok; int sh_pm0; const PG8_LAS int* ltok;
    __device__ __forceinline__ bool next(int i, Unit& u) const {
        const int t = (i / nN) * G + c; if (t >= ntiles) return false;
        u.pn = i % nN; const unsigned pk = (unsigned)__builtin_amdgcn_readfirstlane((int)tiles[t]); u.e = (int)(pk >> 16); u.pm = (int)(pk & 0xffffu); return true;
    }
    __device__ __forceinline__ int arow_g(const Unit& u, int r) const { return u.e >= 64 ? (u.pm - sh_pm0) * BM + r : stok[u.pm * BM + r]; }
    __device__ __forceinline__ int arow(int ui, int r) const { return ltok[ui * BM + r]; }
    __device__ __forceinline__ void a_ready(const Unit&) const {}
    __device__ __forceinline__ void done(const Unit&) const {}
};

typedef int v8i_t __attribute__((ext_vector_type(8)));
typedef int v4i_t __attribute__((ext_vector_type(4)));
template <class Sched> __device__ __forceinline__ unsigned gather_off(const Sched& S, int ui, int h, int i, int t, int KB) { asm volatile("" : "+v"(t)); int R, C; stage_rc(t * 16 + i * 8192, R, C); return (unsigned)(S.arow(ui, h * HALF + R) * KB + C * 2); }
__device__ __forceinline__ const char* uptr(const char* p) { const unsigned long long v = (unsigned long long)p; const unsigned lo = (unsigned)__builtin_amdgcn_readfirstlane((int)(unsigned)v), hi = (unsigned)__builtin_amdgcn_readfirstlane((int)(unsigned)(v >> 32)); return (const char*)(((unsigned long long)hi << 32) | lo); }
__device__ __forceinline__ void pg8_tm(volatile PG8_LAS unsigned* m, int wid, int lane, int id) {
    if (MK_TMASK && wid == 0 && lane == 0) { const unsigned long long now = __builtin_amdgcn_s_memrealtime(); const unsigned long long tp = (unsigned long long)m[16] | ((unsigned long long)m[17] << 32); unsigned long long ta = (unsigned long long)m[18] | ((unsigned long long)m[19] << 32);
        if ((MK_TMASK >> m[20]) & 1u) ta += now - tp; m[16] = (unsigned)now; m[17] = (unsigned)(now >> 32); m[18] = (unsigned)ta; m[19] = (unsigned)(ta >> 32); m[20] = (unsigned)id; }
}
template <class Epi, class Sched, bool ALIGN_EPI, bool GATHER, int KC, bool F8 = false, bool TIMED = false>
__device__ __forceinline__ void gemm_phase(PG8_LAS unsigned char* lds, const Gemm g, const Sched& S, const Epi& E, int wave_, volatile PG8_LAS unsigned* tmisc = nullptr, int tseg_after = 0) {
    int lane_ = (int)__builtin_amdgcn_mbcnt_hi(~0u, __builtin_amdgcn_mbcnt_lo(~0u, 0u)); asm volatile("" : "+s"(wave_), "+v"(lane_));
    const int tid_ = wave_ * 64 + lane_;
    const int tid = tid_, wid = wave_, lane = tid & 63, wr = wid >> 2, wc = wid & 3, fr = lane & 15, fq = lane >> 4;
    constexpr int K = KC, KB = F8 ? KC : KC * 2, nt = KB / (BK * 2);
    unsigned voffB[2];
    unsigned oc[2][2];
    const size_t hstep = (size_t)HALF * KB;
#pragma unroll
    for (int i = 0; i < 2; ++i) { int R, C; stage_rc(tid * 16 + i * 8192, R, C); const int Rb = Epi::PERM ? ((R & ~31) + perm32(R & 31)) : R;
        voffB[i] = (unsigned)(Rb * KB + C * 2);
        oc[0][i] = (unsigned)(R * KB + C * 2); oc[1][i] = oc[0][i] + (unsigned)hstep; }
    const size_t kstep = (size_t)(BK * 2);
    const size_t tstep = 2 * hstep;
    const unsigned ldsw = (unsigned)wid * 1024u;
    const int aoff = lds_byte(wr * 64 + fr, fq * 8), boff = lds_byte(wc * 32 + fr, fq * 8);
    const int a8 = lds_byte(wr * 64 + fr, fq * 16), b8 = lds_byte(wc * 32 + fr, fq * 16);
#define PG8_SA(b, h) (((b) * 2 + (h)) * HTB)
#define PG8_SB(b, h) ((4 + (b) * 2 + (h)) * HTB)
#define PG8_STAGE(bufoff, gbase, voff) do { _Pragma("unroll") for (int _i = 0; _i < 2; ++_i) \
        __builtin_amdgcn_global_load_lds((const unsigned*)((const char*)(gbase) + (voff)[_i]), (PG8_LAS unsigned*)(lds + (bufoff) + ldsw + _i * 8192), 16, 0, 0); } while (0)
#define PG8_STAGE_A(bufoff, gbase, OA, h) do { _Pragma("unroll") for (int _i = 0; _i < 2; ++_i) \
        __builtin_amdgcn_global_load_lds((const unsigned*)((const char*)(gbase) + (OA)[h][_i]), (PG8_LAS unsigned*)(lds + (bufoff) + ldsw + _i * 8192), 16, 0, 0); } while (0)
#define PG8_LD16(off) (*(const PG8_LAS v4i_t*)(lds + (off)))
#define PG8_LDA(dst, b, h) do { _Pragma("unroll") for (int m = 0; m < 4; ++m) { if constexpr (F8) dst[m].w8 = __builtin_shufflevector(PG8_LD16(PG8_SA(b, h) + a8 + m * 2048), PG8_LD16(PG8_SA(b, h) + a8 + 16 + m * 2048), 0, 1, 2, 3, 4, 5, 6, 7); \
        else { _Pragma("unroll") for (int k = 0; k < 2; ++k) dst[m].p16[k] = *(const PG8_LAS bf16x8*)(lds + PG8_SA(b, h) + aoff + m * 2048 + k * 1024); } } } while (0)
#define PG8_LDB(dst, b, h) do { _Pragma("unroll") for (int n = 0; n < 2; ++n) { if constexpr (F8) dst[n].w8 = __builtin_shufflevector(PG8_LD16(PG8_SB(b, h) + b8 + n * 2048), PG8_LD16(PG8_SB(b, h) + b8 + 16 + n * 2048), 0, 1, 2, 3, 4, 5, 6, 7); \
        else { _Pragma("unroll") for (int k = 0; k < 2; ++k) dst[n].p16[k] = *(const PG8_LAS bf16x8*)(lds + PG8_SB(b, h) + boff + n * 2048 + k * 1024); } } } while (0)
#define PG8_MMA(ai, bj, At, Bt) do { __builtin_amdgcn_s_setprio(1); _Pragma("unroll") for (int m = 0; m < 4; ++m) _Pragma("unroll") for (int n = 0; n < 2; ++n) { \
        if constexpr (F8) asm volatile("v_mfma_scale_f32_16x16x128_f8f6f4 %0, %1, %2, %0, %3, %4 op_sel_hi:[0,0,0]" : "+v"(acc[ai][bj][m][n]) : "v"(Bt[n].w8), "v"(At[m].w8), "v"(0x7B7B7B7B), "v"(0x7F7F7F7F)); \
        else { _Pragma("unroll") for (int k = 0; k < 2; ++k) acc[ai][bj][m][n] = __builtin_amdgcn_mfma_f32_16x16x32_bf16(Bt[n].p16[k], At[m].p16[k], acc[ai][bj][m][n], 0, 0, 0); } } __builtin_amdgcn_s_setprio(0); } while (0)
#define PG8_WAIT_V(n) asm volatile("s_waitcnt vmcnt(" #n ")" ::: "memory")
#define PG8_WAIT_L(n) asm volatile("s_waitcnt lgkmcnt(" #n ")" ::: "memory")
#define PG8_BAR __builtin_amdgcn_s_barrier()
#define PG8_SCHED __builtin_amdgcn_sched_barrier(0)
    Unit cur, nxt; int ui = 0;
    if (!S.next(0, cur)) return;
    if constexpr (TIMED) pg8_tm(tmisc, wid, lane, 27);
    f32x4 acc[2][2][4][2];
#pragma unroll
    for (int a = 0; a < 2; ++a)
#pragma unroll
        for (int b = 0; b < 2; ++b)
#pragma unroll
            for (int m = 0; m < 4; ++m)
#pragma unroll
                for (int n = 0; n < 2; ++n) acc[a][b][m][n] = (f32x4){0.f, 0.f, 0.f, 0.f};
    union Frag { v8i_t w8; bf16x8 p16[2]; };
    Frag At[4], B0[2], B1[2];
    const char* cA; const char* cB = uptr((const char*)g.Bt + (size_t)cur.e * g.bstride + (size_t)cur.pn * tstep);
    if constexpr (GATHER) { cA = (const char*)g.A;
#pragma unroll
        for (int h = 0; h < 2; ++h)
#pragma unroll
            for (int i = 0; i < 2; ++i) oc[h][i] = gather_off(S, 0, h, i, tid, KB);
    } else cA = uptr((const char*)g.A + (size_t)cur.pm * tstep);
    S.a_ready(cur);
    PG8_STAGE(PG8_SB(0, 0), cB, voffB); PG8_STAGE(PG8_SB(0, 1), cB + hstep, voffB); PG8_STAGE_A(PG8_SA(0, 0), cA, oc, 0); PG8_STAGE_A(PG8_SA(0, 1), cA, oc, 1);
    if (wr == 1) PG8_BAR;
    PG8_WAIT_V(2); PG8_BAR;
    PG8_STAGE(PG8_SB(1, 0), cB + kstep, voffB); PG8_STAGE_A(PG8_SA(1, 0), cA + kstep, oc, 0); PG8_STAGE(PG8_SB(1, 1), cB + hstep + kstep, voffB);
    PG8_WAIT_V(6); PG8_BAR;
    for (;;) {
        const bool has_next = S.next(ui + 1, nxt);
        const char* nA = cA; const char* nB = has_next ? uptr((const char*)g.Bt + (size_t)nxt.e * g.bstride + (size_t)nxt.pn * tstep) : cB;
        if constexpr (GATHER) {
        } else { if (has_next) nA = uptr((const char*)g.A + (size_t)nxt.pm * tstep); }
#pragma unroll 1
        for (int t = 0; t < nt; t += 2) {
            const bool last = (t == nt - 2);
            const char* a1 = cA + (size_t)(t + 1) * kstep;
            const char* a2 = last ? nA : cA + (size_t)(t + 2) * kstep; const char* b2 = last ? nB : cB + (size_t)(t + 2) * kstep;
            const char* a3 = a2 + kstep; const char* b3 = b2 + kstep;
            unsigned o2[2][2];
#pragma unroll
            for (int h = 0; h < 2; ++h)
#pragma unroll
                for (int i = 0; i < 2; ++i) o2[h][i] = oc[h][i];
            if constexpr (GATHER) { if (last && has_next) {
#pragma unroll
                for (int h = 0; h < 2; ++h)
#pragma unroll
                    for (int i = 0; i < 2; ++i) o2[h][i] = gather_off(S, ui + 1, h, i, tid, KB); } }
            if (last && has_next) S.a_ready(nxt);
            PG8_LDB(B0, 0, 0); PG8_LDB(B1, 0, 1); PG8_SCHED; PG8_LDA(At, 0, 0); PG8_STAGE_A(PG8_SA(1, 1), a1, oc, 1);
            PG8_WAIT_V(8); PG8_WAIT_L(0); PG8_BAR; PG8_MMA(0, 0, At, B0); PG8_MMA(0, 1, At, B1); PG8_BAR; PG8_SCHED;
            PG8_LDA(At, 0, 1); PG8_STAGE(PG8_SB(0, 0), b2, voffB); PG8_STAGE(PG8_SB(0, 1), b2 + hstep, voffB); PG8_STAGE_A(PG8_SA(0, 0), a2, o2, 0);
            PG8_WAIT_V(8); PG8_WAIT_L(0); PG8_BAR; PG8_MMA(1, 0, At, B0); PG8_MMA(1, 1, At, B1); PG8_BAR; PG8_SCHED;
            PG8_LDB(B0, 1, 0); PG8_LDB(B1, 1, 1); PG8_SCHED; PG8_LDA(At, 1, 0); PG8_STAGE_A(PG8_SA(0, 1), a2, o2, 1);
            PG8_WAIT_V(8); PG8_WAIT_L(0); PG8_BAR; PG8_MMA(0, 0, At, B0); PG8_MMA(0, 1, At, B1); PG8_BAR; PG8_SCHED;
            PG8_LDA(At, 1, 1); PG8_STAGE(PG8_SB(1, 0), b3, voffB); PG8_STAGE(PG8_SB(1, 1), b3 + hstep, voffB); PG8_STAGE_A(PG8_SA(1, 0), a3, o2, 0);
            PG8_WAIT_V(8); PG8_WAIT_L(0); PG8_BAR; PG8_MMA(1, 0, At, B0); PG8_MMA(1, 1, At, B1); PG8_BAR; PG8_SCHED;
        }
        if constexpr (ALIGN_EPI) { if (wr == 0) PG8_BAR; }
        if constexpr (TIMED) pg8_tm(tmisc, wid, lane, 28);
        { int le_ = (int)__builtin_amdgcn_mbcnt_hi(~0u, __builtin_amdgcn_mbcnt_lo(~0u, 0u)); asm volatile("" : "+v"(le_));
          E(acc, cur, wr, wc, le_ & 15, le_ >> 4); } S.done(cur);
        if constexpr (TIMED) pg8_tm(tmisc, wid, lane, has_next ? 27 : tseg_after);
        if (!has_next) break;
#pragma unroll
        for (int a = 0; a < 2; ++a)
#pragma unroll
            for (int b = 0; b < 2; ++b)
#pragma unroll
                for (int m = 0; m < 4; ++m)
#pragma unroll
                    for (int n = 0; n < 2; ++n) acc[a][b][m][n] = (f32x4){0.f, 0.f, 0.f, 0.f};
        cur = nxt; cA = nA; cB = nB; ++ui;
        if constexpr (GATHER) {
#pragma unroll
            for (int h = 0; h < 2; ++h)
#pragma unroll
                for (int i = 0; i < 2; ++i) oc[h][i] = gather_off(S, ui, h, i, tid, KB); }
        if constexpr (ALIGN_EPI) { if (wr == 1) PG8_BAR; }
    }
    PG8_WAIT_V(0);
    if constexpr (!ALIGN_EPI) { if (wr == 0) PG8_BAR; }
    PG8_BAR;
#undef PG8_SA
#undef PG8_SB
#undef PG8_STAGE
#undef PG8_STAGE_A
#undef PG8_LDA
#undef PG8_LDB
#undef PG8_MMA
#undef PG8_WAIT_V
#undef PG8_WAIT_L
#undef PG8_BAR
#undef PG8_SCHED
}
}
namespace attn_body {
using bf16=__hip_bfloat16;
using bf16x8=__attribute__((ext_vector_type(8)))short;
using s16x4=__attribute__((ext_vector_type(4)))short;
using f32x16=__attribute__((ext_vector_type(16)))float;
using u32x4=__attribute__((ext_vector_type(4)))unsigned;
constexpr int D=64,QP=512,KP=128,OP=1024;
constexpr int NW=8,QBLK=32,QB=QBLK*NW,KVBLK=64;
constexpr int ATTN_UNIT_ROWS=QB;
__device__ __forceinline__ int crow(int r,int hi){return (r&3)+8*(r>>2)+4*hi;}
#define SBAR() __builtin_amdgcn_sched_barrier(0)
__device__ __forceinline__ void cmask(f32x16&p0,f32x16&p1,int jb,int qrel,int hi){
  const float NEG=-INFINITY; int kb=64*jb+4*hi;
  #pragma unroll
  for(int r=0;r<16;++r){int kv=kb+(r&3)+8*(r>>2); if(kv>qrel)p0[r]=NEG; if(kv+32>qrel)p1[r]=NEG;}
}

constexpr int NSLOT=3, SLOTB=8192;
constexpr int LDS_K=0, LDS_V=NSLOT*SLOTB, LDS_WS=2*NSLOT*SLOTB, LDS_OST=LDS_WS+NW*64*4, LDS_BYTES=LDS_OST+NW*4096;
constexpr float C2=0.125f*1.4426950408889634f;
__device__ __forceinline__ void glds16(const void*gsrc,unsigned lds_dst){unsigned keep;
  asm volatile("s_mov_b32 %0, m0\n\ts_mov_b32 m0, %2\n\ts_nop 0\n\tglobal_load_lds_dwordx4 %1, off\n\ts_mov_b32 m0, %0":"=&s"(keep):"v"(gsrc),"s"(lds_dst):"memory");}
__device__ __forceinline__ float max3f(float a,float b,float c){float r;asm("v_max3_f32 %0, %1, %2, %3":"=v"(r):"v"(a),"v"(b),"v"(c));return r;}
__device__ __forceinline__ float max2f(float a,float b){float r;asm("v_max_f32_e32 %0, %1, %2":"=v"(r):"v"(a),"v"(b));return r;}
__device__ __forceinline__ float fadd_s(float a,float b){float r;asm("v_add_f32_e32 %0, %1, %2":"=v"(r):"v"(a),"v"(b));return r;}
__device__ __forceinline__ float fsub_s(float a,float b){float r;asm("v_sub_f32_e32 %0, %1, %2":"=v"(r):"v"(a),"v"(b));return r;}
typedef float f32x2_t __attribute__((ext_vector_type(2))); typedef __bf16 bf16x2_t __attribute__((ext_vector_type(2)));
__device__ __forceinline__ unsigned cvtpk_s(float lo,float hi){f32x2_t v={lo,hi};bf16x2_t b=__builtin_convertvector(v,bf16x2_t);return __builtin_bit_cast(unsigned,b);}
#define WAIT_BAR(N) asm volatile("s_waitcnt vmcnt(" #N ") lgkmcnt(0)\n\ts_barrier":::"memory")

__device__ __forceinline__ void qkt(f32x16&p0,f32x16&p1,const char*Kslot,const bf16x8*qr,const f32x16&negm,int r32,int hi){
  const char*kb=Kslot+hi*1024+r32*16;
  #pragma unroll
  for(int d0=0;d0<4;++d0){
    const bf16x8 b0=*reinterpret_cast<const bf16x8*>(kb+d0*2048);
    const bf16x8 b1=*reinterpret_cast<const bf16x8*>(kb+d0*2048+512);
    if(d0==0){p0=__builtin_amdgcn_mfma_f32_32x32x16_bf16(b0,qr[0],negm,0,0,0);p1=__builtin_amdgcn_mfma_f32_32x32x16_bf16(b1,qr[0],negm,0,0,0);}
    else{p0=__builtin_amdgcn_mfma_f32_32x32x16_bf16(b0,qr[d0],p0,0,0,0);p1=__builtin_amdgcn_mfma_f32_32x32x16_bf16(b1,qr[d0],p1,0,0,0);}}
}
typedef __attribute__((address_space(3))) const char* lds_cptr;
typedef short v4i16_t __attribute__((ext_vector_type(4)));
__device__ __forceinline__ void kload8(bf16x8*kf,lds_cptr kp){
  kf[0]=*(const __attribute__((address_space(3))) bf16x8*)(kp);      kf[1]=*(const __attribute__((address_space(3))) bf16x8*)(kp+512);
  kf[2]=*(const __attribute__((address_space(3))) bf16x8*)(kp+2048); kf[3]=*(const __attribute__((address_space(3))) bf16x8*)(kp+2560);
  kf[4]=*(const __attribute__((address_space(3))) bf16x8*)(kp+4096); kf[5]=*(const __attribute__((address_space(3))) bf16x8*)(kp+4608);
  kf[6]=*(const __attribute__((address_space(3))) bf16x8*)(kp+6144); kf[7]=*(const __attribute__((address_space(3))) bf16x8*)(kp+6656);
}
__device__ __forceinline__ void kload2(bf16x8*kf,lds_cptr kp,int j){ kf[2*j]=*(const __attribute__((address_space(3))) bf16x8*)(kp+j*2048); kf[2*j+1]=*(const __attribute__((address_space(3))) bf16x8*)(kp+j*2048+512); }
__device__ __forceinline__ s16x4 vtr(lds_cptr p){ return __builtin_bit_cast(s16x4,__builtin_amdgcn_ds_read_tr16_b64_v4i16((__attribute__((address_space(3))) v4i16_t*)p)); }
__device__ __forceinline__ float rowmax(const f32x16&p0,const f32x16&p1){
  float a=max3f(p0[0],p0[1],p1[0]),b=max3f(p0[2],p0[3],p1[1]);a=max3f(a,p1[2],p1[3]);
  #pragma unroll
  for(int r=4;r<16;r+=4){a=max3f(a,p0[r],p0[r+1]);b=max3f(b,p0[r+2],p0[r+3]);a=max3f(a,p1[r],p1[r+1]);b=max3f(b,p1[r+2],p1[r+3]);}
  const float m=max2f(a,b);
  auto rr=__builtin_amdgcn_permlane32_swap(__float_as_uint(m),__float_as_uint(m),false,false);
  return max2f(__uint_as_float(rr[0]),__uint_as_float(rr[1]));
}
__device__ __forceinline__ void pv(f32x16*o,int vb,bf16x8 pa0,bf16x8 pa1,bf16x8 pa2,bf16x8 pa3){
  #pragma unroll
  for(int d0=0;d0<2;++d0){s16x4 lo[4],hi[4];
    #pragma unroll
    for(int ks=0;ks<4;++ks){
      asm volatile("ds_read_b64_tr_b16 %0,%1 offset:%c2":"=&v"(lo[ks]):"v"(vb),"i"(d0*4096+ks*1024):"memory");
      asm volatile("ds_read_b64_tr_b16 %0,%1 offset:%c2":"=&v"(hi[ks]):"v"(vb),"i"(d0*4096+ks*1024+512):"memory");}
    asm volatile("s_waitcnt lgkmcnt(0)":::"memory");SBAR();
    #define PK(k) (bf16x8){lo[k][0],lo[k][1],lo[k][2],lo[k][3],hi[k][0],hi[k][1],hi[k][2],hi[k][3]}
    o[d0]=__builtin_amdgcn_mfma_f32_32x32x16_bf16(pa0,PK(0),o[d0],0,0,0);
    o[d0]=__builtin_amdgcn_mfma_f32_32x32x16_bf16(pa1,PK(1),o[d0],0,0,0);
    o[d0]=__builtin_amdgcn_mfma_f32_32x32x16_bf16(pa2,PK(2),o[d0],0,0,0);
    o[d0]=__builtin_amdgcn_mfma_f32_32x32x16_bf16(pa3,PK(3),o[d0],0,0,0);
    #undef PK
  }
}

#ifndef ATTN_STORE16
#define ATTN_STORE16(p,v) (*(u32x4*)(p)=(v))
#endif
template<int THRL> __device__ __forceinline__ void attn_unit(long qrow0,int qcol,long kvrow0,int kvcol,int NT,long orow0,int ocol,const bf16*Q,const bf16* K,const bf16* V,bf16*O,char*shm,int wave_){
  int lane_=(int)__builtin_amdgcn_mbcnt_hi(~0u,__builtin_amdgcn_mbcnt_lo(~0u,0u)); asm volatile("":"+s"(wave_),"+v"(lane_)); const int wid=wave_; const int lane=lane_,tid=wid*64+lane,r32=lane&31,hi=lane>>5;
  const bf16*Qw=Q+(qrow0+wid*QBLK)*QP+qcol;
  const bf16*Kh=K+kvrow0*KP+kvcol,*Vh=V+kvrow0*KP+kvcol;
  const unsigned lds0=(unsigned)(uintptr_t)shm;
  float*wsf=(float*)(shm+LDS_WS)+wid*64;
  const bf16*ksrc=Kh+(long)lane*KP+wid*8;
  const bf16*vsrc=Vh+(long)(16*(wid&3)+(lane>>2))*KP+(wid>>2)*32+(lane&3)*8;
  const unsigned kdst=lds0+LDS_K+wid*1024, vdst=lds0+LDS_V+wid*1024;
  #define DMA_K(t,slot) glds16(ksrc+(long)(t)*KVBLK*KP,(unsigned)__builtin_amdgcn_readfirstlane(kdst+(slot)))
  #define DMA_V(t,slot) glds16(vsrc+(long)(t)*KVBLK*KP,(unsigned)__builtin_amdgcn_readfirstlane(vdst+(slot)))
  const int vb0=(int)(lds0+LDS_V)+((lane>>4)&1)*32+(lane&3)*8+(4*hi+((lane&15)>>2))*64;
  const char*Kbase=shm+LDS_K; bf16x8 kf[8];
  const lds_cptr shm3=(lds_cptr)shm; const lds_cptr kp0=shm3+LDS_K+hi*1024+r32*16; const lds_cptr vp0=shm3+LDS_V+((lane>>4)&1)*32+(lane&3)*8+(4*hi+((lane&15)>>2))*64;
  DMA_K(0,0);DMA_V(0,0);DMA_K(1,SLOTB);
  bf16x8 qr[4];
  #pragma unroll
  for(int d0=0;d0<4;++d0)qr[d0]=*reinterpret_cast<const bf16x8*>(&Qw[(long)r32*QP+d0*16+hi*8]);
  float mhat=0.f,l_reg=0.f;f32x16 o[2];{float z_=0.f;asm volatile("":"+v"(z_));
    _Pragma("unroll") for(int r=0;r<16;++r){o[0][r]=z_;o[1][r]=z_;}}f32x16 negm=o[0];asm volatile("":"+v"(negm));
  #define CMASK(P0,P1,t) do{}while(0)
  bool resc=false;
  #define START(P0,P1) do{ const float rm=rowmax(P0,P1); resc=false; \
    { const float dl=rm; mhat=fadd_s(mhat,dl); \
      _Pragma("unroll") for(int r=0;r<16;++r){P0[r]=fsub_s(P0[r],dl);P1[r]=fsub_s(P1[r],dl);} \
      _Pragma("unroll") for(int r=0;r<16;++r)negm[r]=-mhat; asm volatile("":"+v"(negm)); } \
    _Pragma("unroll") for(int r=0;r<16;++r)P0[r]=__builtin_amdgcn_exp2f(P0[r]); }while(0)
  #define RESC() do{ if(resc){ asm volatile("s_waitcnt lgkmcnt(0)":::"memory"); \
      _Pragma("unroll") for(int d_=0;d_<2;++d_) _Pragma("unroll") for(int r=0;r<16;++r)o[d_][r]*=wsf[crow(r,hi)]; } }while(0)
  f32x16 pA0,pA1,pB0,pB1;
  int sl_prev=0,sl_cur=0,sl_next=SLOTB;
  #define ROT() do{sl_prev=sl_cur;sl_cur=sl_next;sl_next=(sl_next==(NSLOT-1)*SLOTB)?0:sl_next+SLOTB;}while(0)
  DMA_K(2,2*SLOTB);
  WAIT_BAR(3);
  qkt(pA0,pA1,Kbase,qr,negm,r32,hi);asm volatile("s_nop 15\n\ts_nop 7":"+v"(pA0),"+v"(pA1));CMASK(pA0,pA1,0);
  START(pA0,pA1);
  _Pragma("unroll") for(int r=0;r<16;++r)pA1[r]=__builtin_amdgcn_exp2f(pA1[r]);
  WAIT_BAR(0);
  DMA_K(3,0);DMA_V(1,SLOTB);
  ROT();
  kload8(kf,kp0+sl_cur);
  WAIT_BAR(2);
  s16x4 vlo[8],vhi[8]; u32x4 pw0,pw1,pw2,pw3;
  #define PKW(P,B) cvtpk_s(P[B],P[B+1])
  #define PAF(k) __builtin_bit_cast(bf16x8,pw##k)
  #define VFR(i) (bf16x8){vlo[i][0],vlo[i][1],vlo[i][2],vlo[i][3],vhi[i][0],vhi[i][1],vhi[i][2],vhi[i][3]}
  #define PIN(x) asm volatile("":"+v"(x))
  #define MX3(a,b,c) __builtin_fmaxf(__builtin_fmaxf((a),(b)),(c))
  #define GAPA(MF,A0,A1,A2,A3,W0,W1,PW) do{ MF; sacc+=A0; sacc+=A1; sacc+=A2; sacc+=A3; PIN(sacc); W0; W1; PIN(PW); SBAR(); }while(0)
  #define EX(v) __builtin_amdgcn_exp2f(v)
  #define GAPB(MF,X,B) do{ MF; X[B]=EX(X[B]); X[B+1]=EX(X[B+1]); X[B+2]=EX(X[B+2]); X[B+3]=EX(X[B+3]); PIN(X); SBAR(); }while(0)
  #define VRD(i) do{ vlo[i]=vtr(vp_+(((i)>>2)*4096+((i)&3)*1024)); vhi[i]=vtr(vp_+(((i)>>2)*4096+((i)&3)*1024+512)); }while(0)
  #define KRD(G,j) do{ if(G){ kload2(kf,kp0+sl_next,j); SBAR(); } }while(0)
  #define STEP(C0,C1,P0,P1,t,GK,GV,GL) do{ SBAR(); \
    const lds_cptr vp_=vp0+sl_prev; \
    VRD(0); SBAR(); float sacc=(P0[0]+P0[1]); \
    GAPA(C0=__builtin_amdgcn_mfma_f32_32x32x16_bf16(kf[0],qr[0],negm,0,0,0), P0[2],P0[3],P0[4],P0[5],     pw0[0]=PKW(P0,0), pw0[1]=PKW(P0,2), pw0); \
    VRD(4); SBAR(); GAPA(C1=__builtin_amdgcn_mfma_f32_32x32x16_bf16(kf[1],qr[0],negm,0,0,0), P0[6],P0[7],P0[8],P0[9],     pw0[2]=PKW(P0,4), pw0[3]=PKW(P0,6), pw0); \
    VRD(1); SBAR(); GAPA(C0=__builtin_amdgcn_mfma_f32_32x32x16_bf16(kf[2],qr[1],C0,0,0,0),   P0[10],P0[11],P0[12],P0[13], pw1[0]=PKW(P0,8), pw1[1]=PKW(P0,10), pw1); \
    VRD(5); SBAR(); GAPA(C1=__builtin_amdgcn_mfma_f32_32x32x16_bf16(kf[3],qr[1],C1,0,0,0),   P0[14],P0[15],P1[0],P1[1],   pw1[2]=PKW(P0,12),pw1[3]=PKW(P0,14), pw1); \
    VRD(2); SBAR(); GAPA(C0=__builtin_amdgcn_mfma_f32_32x32x16_bf16(kf[4],qr[2],C0,0,0,0),   P1[2],P1[3],P1[4],P1[5],     pw2[0]=PKW(P1,0), pw2[1]=PKW(P1,2), pw2); \
    VRD(6); SBAR(); GAPA(C1=__builtin_amdgcn_mfma_f32_32x32x16_bf16(kf[5],qr[2],C1,0,0,0),   P1[6],P1[7],P1[8],P1[9],     pw2[2]=PKW(P1,4), pw2[3]=PKW(P1,6), pw2); \
    VRD(3); SBAR(); GAPA(C0=__builtin_amdgcn_mfma_f32_32x32x16_bf16(kf[6],qr[3],C0,0,0,0),   P1[10],P1[11],P1[12],P1[13], pw3[0]=PKW(P1,8), pw3[1]=PKW(P1,10), pw3); \
    VRD(7); SBAR(); GAPA(C1=__builtin_amdgcn_mfma_f32_32x32x16_bf16(kf[7],qr[3],C1,0,0,0),   P1[14],P1[15],0.f,0.f,       pw3[2]=PKW(P1,12),pw3[3]=PKW(P1,14), pw3); \
    l_reg+=sacc; \
    if(GK){DMA_K((t)+3,sl_cur);} if(GV){DMA_V((t)+1,sl_next);} \
    CMASK(C0,C1,t); \
    { float a=MX3(C0[0],C0[1],C1[0]),b=MX3(C0[2],C0[3],C1[1]); a=MX3(a,C1[2],C1[3]); \
      _Pragma("unroll") for(int r=4;r<16;r+=4){a=MX3(a,C0[r],C0[r+1]);b=MX3(b,C0[r+2],C0[r+3]);a=MX3(a,C1[r],C1[r+1]);b=MX3(b,C1[r+2],C1[r+3]);} \
      float rm=__builtin_fmaxf(a,b); { auto rr=__builtin_amdgcn_permlane32_swap(__float_as_uint(rm),__float_as_uint(rm),false,false); rm=__builtin_fmaxf(__uint_as_float(rr[0]),__uint_as_float(rr[1])); } \
      resc=false; \
      if(__builtin_expect(__any(rm>(float)THRL),0)){ const float dl=__builtin_fmaxf(rm,0.f); mhat+=dl; \
        _Pragma("unroll") for(int r=0;r<16;++r){C0[r]-=dl;C1[r]-=dl;} \
        _Pragma("unroll") for(int r=0;r<16;++r)negm[r]=-mhat; asm volatile("":"+v"(negm)); \
        const float f=__builtin_amdgcn_exp2f(-dl); l_reg*=f; if(hi==0)wsf[r32]=f; resc=true; } } \
    SBAR(); \
    GAPB(o[0]=__builtin_amdgcn_mfma_f32_32x32x16_bf16(PAF(0),VFR(0),o[0],0,0,0), C0,0); \
    GAPB(o[1]=__builtin_amdgcn_mfma_f32_32x32x16_bf16(PAF(0),VFR(4),o[1],0,0,0), C0,4); \
    KRD(GL,0); GAPB(o[0]=__builtin_amdgcn_mfma_f32_32x32x16_bf16(PAF(1),VFR(1),o[0],0,0,0), C0,8); \
    KRD(GL,1); GAPB(o[1]=__builtin_amdgcn_mfma_f32_32x32x16_bf16(PAF(1),VFR(5),o[1],0,0,0), C0,12); \
    KRD(GL,2); GAPB(o[0]=__builtin_amdgcn_mfma_f32_32x32x16_bf16(PAF(2),VFR(2),o[0],0,0,0), C1,0); \
    KRD(GL,3); GAPB(o[1]=__builtin_amdgcn_mfma_f32_32x32x16_bf16(PAF(2),VFR(6),o[1],0,0,0), C1,4); \
    GAPB(o[0]=__builtin_amdgcn_mfma_f32_32x32x16_bf16(PAF(3),VFR(3),o[0],0,0,0), C1,8); \
    GAPB(o[1]=__builtin_amdgcn_mfma_f32_32x32x16_bf16(PAF(3),VFR(7),o[1],0,0,0), C1,12); \
    }while(0)
  int t=1;
  for(;t+5<NT;t+=2){
    STEP(pB0,pB1,pA0,pA1,t,true,true,true);     WAIT_BAR(2); RESC(); ROT();
    STEP(pA0,pA1,pB0,pB1,t+1,true,true,true);   WAIT_BAR(2); RESC(); ROT();
  }
  #define ENDW(tt) do{ if((tt)+3<NT){WAIT_BAR(2);} else if((tt)+2<NT){WAIT_BAR(1);} else {WAIT_BAR(0);} }while(0)
  for(;t+1<NT;t+=2){
    STEP(pB0,pB1,pA0,pA1,t,(t+3<NT),(t+1<NT),(t+1<NT));       ENDW(t);   RESC(); ROT();
    STEP(pA0,pA1,pB0,pB1,t+1,(t+4<NT),(t+2<NT),(t+2<NT));     ENDW(t+1); RESC(); ROT();
  }
  STEP(pB0,pB1,pA0,pA1,NT-1,false,false,false); RESC();
  { float sacc=pB0[0]+pB0[1]; _Pragma("unroll") for(int r=2;r<16;++r)sacc+=pB0[r]; _Pragma("unroll") for(int r=0;r<16;++r)sacc+=pB1[r]; l_reg+=sacc;
    pw0=(u32x4){PKW(pB0,0),PKW(pB0,2),PKW(pB0,4),PKW(pB0,6)};pw1=(u32x4){PKW(pB0,8),PKW(pB0,10),PKW(pB0,12),PKW(pB0,14)};pw2=(u32x4){PKW(pB1,0),PKW(pB1,2),PKW(pB1,4),PKW(pB1,6)};pw3=(u32x4){PKW(pB1,8),PKW(pB1,10),PKW(pB1,12),PKW(pB1,14)};
    SBAR(); pv(o,vb0+sl_cur,PAF(0),PAF(1),PAF(2),PAF(3)); }
  #undef PKW
  #undef PAF
  #undef VFR
  #undef PIN
  #undef MX3
  #undef GAPA
  #undef GAPB
  #undef EX
  #undef VRD
  #undef KRD
  #undef STEP
  #undef ENDW
  {auto rr=__builtin_amdgcn_permlane32_swap(__float_as_uint(l_reg),__float_as_uint(l_reg),false,false);l_reg=__uint_as_float(rr[0])+__uint_as_float(rr[1]);}
  if(hi==0)wsf[32+r32]=l_reg;asm volatile("s_waitcnt lgkmcnt(0)":::"memory");
  float rli[16];
  #pragma unroll
  for(int r=0;r<16;++r)rli[r]=__builtin_amdgcn_rcpf(wsf[32+crow(r,hi)]);
  bf16*Ow=O+(orow0+wid*QBLK)*OP+ocol;
  { bf16*stg=(bf16*)(shm+LDS_OST)+wid*2048;
    #pragma unroll
    for(int r=0;r<16;++r){const int orow=crow(r,hi);
      #pragma unroll
      for(int d0=0;d0<2;++d0)stg[orow*64+d0*32+r32]=__float2bfloat16(o[d0][r]*rli[r]);}
    asm volatile("s_waitcnt lgkmcnt(0)":::"memory");
    #pragma unroll
    for(int i=0;i<4;++i){const int row=i*8+(lane>>3),ch=lane&7; const u32x4 v=*(const u32x4*)(stg+row*64+ch*8); ATTN_STORE16(Ow+(long)row*OP+ch*8,v);} }
  asm volatile("s_waitcnt lgkmcnt(0)\n\ts_barrier":::"memory");
  #undef DMA_K
  #undef DMA_V
  #undef CMASK
  #undef START
  #undef RESC
  #undef ROT
}
constexpr int ATTN_LDS_BYTES=LDS_BYTES;
#undef SBAR
#undef WAIT_BAR
}
constexpr int NB = 8, T = 4096, D = 1024, DEPTH = 4, LC = 256;
constexpr int ML = NB * T, MC = NB * LC, M = ML + MC;
constexpr int PROJ = 2048, SKV = T + LC;
constexpr int C_HY = 0, C_Q = 768, C_K = 1280, C_V = 1408, C_RGX = 1536, C_RGG = 1792;
constexpr int NEXP = 64, TOPK = 8, FF = 256;
constexpr int SH0 = M * TOPK + NEXP * 256;
constexpr int HIDROWS = SH0 + M;
constexpr float LN_EPS = 1e-6f, QK_EPS = 1e-6f;
constexpr float DN_ALPHA = 1.681792830507429f;
constexpr float ROUTED_SCALE = 2.5f;
constexpr int NWAVES = 8;
enum { I_X = 0, I_C, I_CTX, I_CCTX, I_WMOD, I_BMOD, I_LN1G, I_LN1B, I_LN2G, I_LN2B, I_WIN, I_WOUT, I_HYSW, I_HYSB, I_HYW1, I_HYB1, I_HYFREQ, I_HYW2, I_HYB2, I_HYW3, I_HYSKIP,
       I_QN, I_KN, I_RGCW, I_RGCB, I_RGLAM, I_RGWA, I_RGBA, I_RGWX, I_RGBX, I_WR, I_BR, I_WG, I_WU, I_WD, I_WSG, I_WSU, I_WSD, N_IN };

constexpr size_t MiB = 1u << 20;
constexpr size_t WS_CTL = 0, CTL_ZERO_BYTES = 1 * MiB;
constexpr size_t WS_MODV = 1 * MiB;
constexpr size_t WS_TW = 2 * MiB;
constexpr size_t WS_ROPE = 3 * MiB;
constexpr size_t WS_RTHI = 4 * MiB, WS_RTLO = 4 * MiB + 512 * 1024;
constexpr size_t WS_RGW = 5 * MiB;
constexpr size_t WS_IDX = 6 * MiB, WS_WT = 8 * MiB, WS_POS = 10 * MiB;
constexpr size_t WS_HIST = 12 * MiB;
constexpr size_t WS_TILES = 12 * MiB + 512 * 1024;
constexpr size_t WS_STOK = 13 * MiB;
constexpr size_t WS_SWT = 15 * MiB;
constexpr size_t WS_HC = 18 * MiB;
constexpr size_t WS_WIN = 26 * MiB;
constexpr size_t WS_WOUT = 42 * MiB;
constexpr size_t WS_WGU = 50 * MiB;
constexpr size_t WS_WDN = 115 * MiB;
constexpr size_t WS_ABUF = 148 * MiB;
constexpr size_t WS_FILT = 216 * MiB;
constexpr size_t WS_FILTC = WS_FILT + 16 * MiB;
constexpr size_t WS_BIG = 234 * MiB;
constexpr size_t WS_HID = WS_BIG;
constexpr size_t WS_Y2 = WS_BIG + 162 * MiB;
constexpr size_t WS_END_MOE = WS_Y2 + (size_t)SH0 * 2048;
constexpr size_t WS_SHY = WS_BIG + 452 * MiB;
constexpr size_t WS_P = WS_BIG;
constexpr size_t WS_V = WS_BIG;
constexpr size_t WS_QB = WS_BIG + 136 * MiB;
constexpr size_t WS_KB = WS_BIG + 170 * MiB;
constexpr size_t WS_VB = WS_BIG + 179 * MiB;
constexpr size_t WS_HT = WS_BIG + 188 * MiB;
constexpr size_t WS_HTC = WS_BIG + 284 * MiB;
constexpr size_t WS_SPEC = WS_BIG + 290 * MiB;
constexpr size_t WS_SPECC = WS_BIG + 322 * MiB;
constexpr size_t WS_RGA = WS_BIG + 324 * MiB;
constexpr size_t WS_RGB = WS_BIG + 392 * MiB;
constexpr size_t WS_MIX = WS_BIG + 460 * MiB;
constexpr size_t WS_HB = WS_BIG + 530 * MiB;
constexpr size_t WS_END = WS_END_MOE;
static_assert(WS_MIX + (size_t)M * 2048 <= WS_HB && WS_SHY + (size_t)M * 1024 <= WS_HB && WS_HB + (size_t)M * 2048 <= WS_END && WS_HID + (size_t)HIDROWS * 512 <= WS_Y2, "ws map");
constexpr int CW_BAR = 4096;
constexpr int RING_OFF = 0, RING_BYTES = 131072, SCRATCH_BYTES = 155648;
constexpr int LDSCTL_OFF = SCRATCH_BYTES, MISC_OFF = LDSCTL_OFF + 320;
constexpr int LTILES_OFF = LDSCTL_OFF + 1024;
constexpr int LDS_BYTES = 163840;
static_assert(LTILES_OFF + 1536 * 4 <= LDS_BYTES, "LDS map");

#define GAS __attribute__((address_space(1)))
#define LAS __attribute__((address_space(3)))
typedef unsigned short bf16;
typedef unsigned v4u __attribute__((ext_vector_type(4)));
typedef unsigned v2u __attribute__((ext_vector_type(2)));
typedef float f32x4 __attribute__((ext_vector_type(4)));
typedef float f32x2v __attribute__((ext_vector_type(2)));
typedef short bf16x8 __attribute__((ext_vector_type(8)));
typedef GAS unsigned gu32;
#define RLX_AGENT __ATOMIC_RELAXED, __HIP_MEMORY_SCOPE_AGENT
#define LDS_WAIT() asm volatile("s_waitcnt lgkmcnt(0)" ::: "memory")
#define VM_WAIT() asm volatile("s_waitcnt vmcnt(0)" ::: "memory")
typedef float f32x2cv __attribute__((ext_vector_type(2))); typedef __bf16 bf16x2cv __attribute__((ext_vector_type(2)));
__device__ __forceinline__ unsigned pk2(float lo, float hi) { const f32x2cv v = {lo, hi}; return __builtin_bit_cast(unsigned, __builtin_convertvector(v, bf16x2cv)); }
__device__ __forceinline__ unsigned f2bf(float f) { return pk2(f, 0.f); }
__device__ __forceinline__ float bf2f(unsigned b) { return __builtin_bit_cast(float, b << 16); }
__device__ __forceinline__ float bflo(unsigned w) { return __builtin_bit_cast(float, w << 16); }
__device__ __forceinline__ float bfhi(unsigned w) { return __builtin_bit_cast(float, w & 0xffff0000u); }

#define XB_TMO      128
#define XB_XCNT(j)  (256  + 64 * (j))
#define XB_XSUB(j)  (1280 + 64 * (j))
#define XB_XGEN(j)  (2304 + 64 * (j))
#define XB_TOP      3328
#define XB_TOPGEN   3392
#define XCD_BAR_WORDS 3456
#define XB_SPIN_CAP (1u << 20)
__device__ __forceinline__ unsigned xb_ld(unsigned* p)              { return __hip_atomic_load(p, __ATOMIC_RELAXED, __HIP_MEMORY_SCOPE_AGENT); }
__device__ __forceinline__ unsigned xb_add(unsigned* p, unsigned v) { return __hip_atomic_fetch_add(p, v, __ATOMIC_RELAXED, __HIP_MEMORY_SCOPE_AGENT); }
__device__ __forceinline__ unsigned xb_xcc_id() { return (unsigned)__builtin_amdgcn_s_getreg((3 << 11) | 20) & 0xFu; }
#define XB_SPIN(cond, bar) do { unsigned _sp = 0; while (cond) { __builtin_amdgcn_s_sleep(1); \
    if ((++_sp & 255u) == 0u) { if (xb_ld(&(bar)[XB_TMO])) break; if (_sp > XB_SPIN_CAP) { atomicAdd(&(bar)[XB_TMO], 1u); break; } } } } while (0)
struct XcdBarrier { unsigned* bar; unsigned x; volatile LAS unsigned* st; };
__device__ __forceinline__ XcdBarrier xcd_barrier_post(unsigned* bar, volatile LAS unsigned* st) {
    XcdBarrier b; b.bar = bar; b.x = xb_xcc_id(); b.st = st;
    if (threadIdx.x == 0) (void)xb_add(&bar[XB_XCNT(b.x)], 1u);
    return b;
}
__device__ __forceinline__ void xcd_barrier_complete(unsigned* bar, unsigned x, unsigned& nloc, unsigned& nx) {
    const unsigned G = gridDim.x * gridDim.y * gridDim.z;
    unsigned sum, cnt, mine, sp = 0u;
    for (;;) {
        sum = 0u; cnt = 0u; mine = 0u;
#pragma unroll
        for (unsigned j = 0; j < 16; ++j) { const unsigned c = xb_ld(&bar[XB_XCNT(j)]); sum += c; cnt += (c > 0u) ? 1u : 0u; mine = (j == x) ? c : mine; }
        if (sum == G) break;
        __builtin_amdgcn_s_sleep(1);
        if ((++sp & 255u) == 0u) { if (xb_ld(&bar[XB_TMO])) break; if (sp > XB_SPIN_CAP) { atomicAdd(&bar[XB_TMO], 1u); break; } }
    }
    nloc = mine > 0u ? mine : 1u; nx = cnt > 0u ? cnt : 1u;
}
__device__ __forceinline__ int lane_id() { return (int)__builtin_amdgcn_mbcnt_hi(~0u, __builtin_amdgcn_mbcnt_lo(~0u, 0u)); }
__device__ __forceinline__ void xcd_barrier(const XcdBarrier& b, bool leader) {
    asm volatile("s_waitcnt vmcnt(0)" ::: "memory");
    __syncthreads();
    if (leader) {
        unsigned long long z_ = 0; asm volatile("" : "+s"(z_));
        unsigned* bar = b.bar + z_;
        __builtin_amdgcn_s_waitcnt(0);
        unsigned nloc = b.st[0], nx = b.st[1];
        if (nloc == 0u) { xcd_barrier_complete(bar, b.x, nloc, nx); b.st[0] = nloc; b.st[1] = nx; }
        const unsigned old = xb_add(&bar[XB_XSUB(b.x)], 1u);
        const unsigned gen = old / nloc;
        if (old + 1u == (gen + 1u) * nloc) {
            __builtin_amdgcn_fence(__ATOMIC_RELEASE, "agent");
            asm volatile("s_waitcnt vmcnt(0)" ::: "memory");
            const unsigned og = xb_add(&bar[XB_TOP], 1u);
            const unsigned tg = og / nx;
            if (og + 1u == (tg + 1u) * nx) xb_add(&bar[XB_TOPGEN], 1u);
            else XB_SPIN(xb_ld(&bar[XB_TOPGEN]) == tg, bar);
            __builtin_amdgcn_fence(__ATOMIC_ACQUIRE, "agent");
            xb_add(&bar[XB_XGEN(b.x)], 1u);
            asm volatile("s_waitcnt vmcnt(0)" ::: "memory");
        } else {
            XB_SPIN(xb_ld(&bar[XB_XGEN(b.x)]) == gen, bar);
            __builtin_amdgcn_fence(__ATOMIC_ACQUIRE, "agent");
            asm volatile("s_waitcnt vmcnt(0)" ::: "memory");
        }
    }
    __syncthreads();
}

__device__ __forceinline__ void lds_barrier() { asm volatile("s_waitcnt lgkmcnt(0)" ::: "memory"); __builtin_amdgcn_s_barrier(); asm volatile("" ::: "memory"); }
struct Args { const float* in[N_IN]; float* out; unsigned char* ws; };
struct Frame {
    LAS unsigned char* lds; char* ldsg; volatile LAS unsigned* MISC; gu32* ctl; unsigned char* ws; float* out;
    int tid, lane, wave, vcu, G, z;
};
__device__ __forceinline__ Frame fresh(const Frame& F0) {
    Frame F = F0; int w = F0.wave, ln = lane_id(); asm volatile("" : "+s"(w), "+v"(ln)); F.wave = w; F.lane = ln; F.tid = w * 64 + ln;
    unsigned long long z = 0; asm volatile("" : "+s"(z)); F.ws = F0.ws + z; F.out = F0.out + z; F.z = (int)z; return F;
}
__device__ __forceinline__ void tm_set(const Frame& F, unsigned long long tp, unsigned long long ta, int seg) { F.MISC[16] = (unsigned)tp; F.MISC[17] = (unsigned)(tp >> 32); F.MISC[18] = (unsigned)ta; F.MISC[19] = (unsigned)(ta >> 32); F.MISC[20] = (unsigned)seg; }
__device__ __forceinline__ unsigned long long tm_acc(const Frame& F) { return (unsigned long long)F.MISC[18] | ((unsigned long long)F.MISC[19] << 32); }
__device__ __forceinline__ void tm_seg(const Frame& F, int id) {
    if (MK_TMASK && F.wave == 0 && lane_id() == 0) { const unsigned long long now = __builtin_amdgcn_s_memrealtime(); const unsigned long long tp = (unsigned long long)F.MISC[16] | ((unsigned long long)F.MISC[17] << 32); unsigned long long ta = tm_acc(F);
        if ((MK_TMASK >> F.MISC[20]) & 1u) ta += now - tp; tm_set(F, now, ta, id); }
}
template <int CTRL, int RMASK> __device__ __forceinline__ float dpp0(float x) { return __builtin_bit_cast(float, __builtin_amdgcn_update_dpp(0, __builtin_bit_cast(int, x), CTRL, RMASK, 0xF, false)); }
__device__ __forceinline__ float wave_sum(float v) {
    v += dpp0<0x111, 0xF>(v); v += dpp0<0x112, 0xF>(v); v += dpp0<0x114, 0xF>(v); v += dpp0<0x118, 0xF>(v);
    v += dpp0<0x142, 0xA>(v); v += dpp0<0x143, 0xC>(v);
    return __builtin_bit_cast(float, __builtin_amdgcn_readlane(__builtin_bit_cast(int, v), 63));
}
template <int CTRL> __device__ __forceinline__ float dppx(float x) { return __builtin_bit_cast(float, __builtin_amdgcn_update_dpp(__builtin_bit_cast(int, x), __builtin_bit_cast(int, x), CTRL, 0xF, 0xF, false)); }
__device__ __forceinline__ float sum8(float v) {
    v += dppx<0xB1>(v);
    v += dppx<0x4E>(v);
    v += dppx<0x141>(v);
    return v;
}
__device__ __forceinline__ float sum32(float v) {
    v = sum8(v); v += dppx<0x140>(v);
    auto rr = __builtin_amdgcn_permlane16_swap(__float_as_uint(v), __float_as_uint(v), false, false);
    return __uint_as_float(rr[0]) + __uint_as_float(rr[1]);
}
__device__ __forceinline__ float sigmoidf_(float x) { return 1.0f / (1.0f + __expf(-x)); }
__device__ __forceinline__ float siluf_(float x) { return x / (1.0f + __expf(-x)); }
__device__ __forceinline__ const float* modv(const Frame& F, int l, int r, int k) { return (const float*)(F.ws + WS_MODV) + ((size_t)(l * 9 + r) * 6 + k) * 1024; }
__device__ __forceinline__ int modrow_of(int R) { return R < ML ? (R >> 12) : 8; }
constexpr int TSCR = 16896;
__device__ __forceinline__ void transpose_item(const float* W, int N, bf16* WT, int Kdst, int k0, int n0, int drow0, LAS float* scr, int lane) {
    const int rg = lane >> 4, c4 = (lane & 15) * 4;
    f32x4 v[16];
#pragma unroll
    for (int i = 0; i < 16; ++i) v[i] = __builtin_nontemporal_load((const f32x4*)(W + (size_t)(k0 + 4 * i + rg) * N + n0 + c4));
#pragma unroll
    for (int i = 0; i < 16; ++i) { LAS float* d = scr + (4 * i + rg) * 65 + c4; d[0] = v[i].x; d[1] = v[i].y; d[2] = v[i].z; d[3] = v[i].w; }
    LDS_WAIT(); asm volatile("" ::: "memory");
    const int kc = (lane & 7) * 8;
#pragma unroll
    for (int j = 0; j < 8; ++j) { const int n = (lane >> 3) + 8 * j; const LAS float* s = scr + kc * 65 + n;
        v4u o; o.x = pk2(s[0 * 65], s[1 * 65]); o.y = pk2(s[2 * 65], s[3 * 65]); o.z = pk2(s[4 * 65], s[5 * 65]); o.w = pk2(s[6 * 65], s[7 * 65]);
        __builtin_nontemporal_store(o, (GAS v4u*)(WT + (size_t)(drow0 + n) * Kdst + k0 + kc)); }
    LDS_WAIT(); asm volatile("" ::: "memory");
}

__device__ __forceinline__ unsigned pk4_fp8(float a, float b, float c, float d) { int w = 0; w = __builtin_amdgcn_cvt_pk_fp8_f32(a, b, w, false); w = __builtin_amdgcn_cvt_pk_fp8_f32(c, d, w, true); return (unsigned)w; }
__device__ __forceinline__ void transpose_item8(const float* W, int N, unsigned char* WT, int Kdst, int k0, int n0, int drow0, LAS float* scr, int lane, float scale) {
    const int rg = lane >> 4, c4 = (lane & 15) * 4;
    f32x4 v[16];
#pragma unroll
    for (int i = 0; i < 16; ++i) v[i] = __builtin_nontemporal_load((const f32x4*)(W + (size_t)(k0 + 4 * i + rg) * N + n0 + c4));
#pragma unroll
    for (int i = 0; i < 16; ++i) { LAS float* d = scr + (4 * i + rg) * 65 + c4; d[0] = v[i].x * scale; d[1] = v[i].y * scale; d[2] = v[i].z * scale; d[3] = v[i].w * scale; }
    LDS_WAIT(); asm volatile("" ::: "memory");
    const int kc = (lane & 7) * 8;
#pragma unroll
    for (int j = 0; j < 8; ++j) { const int n = (lane >> 3) + 8 * j; const LAS float* s = scr + kc * 65 + n;
        v2u o; o.x = pk4_fp8(s[0 * 65], s[1 * 65], s[2 * 65], s[3 * 65]); o.y = pk4_fp8(s[4 * 65], s[5 * 65], s[6 * 65], s[7 * 65]);
        __builtin_nontemporal_store(o, (GAS v2u*)(WT + (size_t)(drow0 + n) * Kdst + k0 + kc)); }
    LDS_WAIT(); asm volatile("" ::: "memory");
}

__device__ __forceinline__ void phase_prologue_a(Frame& F0, const Args& A) {
    Frame F = fresh(F0);
    const int gw = F.vcu * NWAVES + F.wave, NGW = F.G * NWAVES;
    const int gt = F.vcu * 512 + F.tid, NGT = F.G * 512;
    {
        LAS float* sc = (LAS float*)(F.lds);
        LAS float* red = (LAS float*)(F.lds + 40960);
        for (int i = F.tid; i < 9 * 1024; i += 512) { const int r = i >> 10, k = i & 1023; const float v = r < 8 ? A.in[I_C + F.z][r * 1024 + k] : A.in[I_CCTX + F.z][k]; sc[i] = siluf_(v); }
        lds_barrier();
        const int col4 = (F.tid & 7) * 4, ks = F.tid >> 3;
        for (int u = F.vcu; u < 4 * 192; u += F.G) {
            const int l = u / 192, j0 = (u % 192) * 32;
            const float* W = A.in[I_WMOD + F.z] + (size_t)l * 1024 * 6144 + j0 + col4;
            f32x4 acc[9];
#pragma unroll
            for (int r = 0; r < 9; ++r) acc[r] = (f32x4){0.f, 0.f, 0.f, 0.f};
            f32x4 wv[16];
#pragma unroll
            for (int kk = 0; kk < 16; ++kk) wv[kk] = __builtin_nontemporal_load((const f32x4*)(W + (size_t)(ks * 16 + kk) * 6144));
#pragma unroll
            for (int kk = 0; kk < 16; ++kk) { const int k = ks * 16 + kk;
#pragma unroll
                for (int r = 0; r < 9; ++r) acc[r] += wv[kk] * sc[r * 1024 + k]; }
#pragma unroll
            for (int r = 0; r < 9; ++r) *(LAS f32x4*)(red + (ks * 9 + r) * 32 + col4) = acc[r];
            lds_barrier();
            if (F.tid < 288) { const int r = F.tid >> 5, c = F.tid & 31; float s = A.in[I_BMOD + F.z][l * 6144 + j0 + c];
#pragma unroll 8
                for (int q = 0; q < 64; ++q) s += red[(q * 9 + r) * 32 + c];
                ((float*)(F.ws + WS_MODV))[((size_t)(l * 9 + r)) * 6144 + j0 + c] = s; }
            lds_barrier();
        }
    }
    {
        LAS float* scr = (LAS float*)(F.lds + F.wave * TSCR);
        constexpr int I_IN = (D / 64) * (PROJ / 64), I_OUT = (D / 64) * (D / 64);
        for (int it = gw; it < DEPTH * (I_IN + I_OUT); it += NGW) {
            const int l = it / (I_IN + I_OUT); int r = it % (I_IN + I_OUT);
            if (r < I_IN) { const int kb = r / (PROJ / 64), nb = r % (PROJ / 64);
                transpose_item(A.in[I_WIN + F.z] + (size_t)l * D * PROJ, PROJ, (bf16*)(F.ws + WS_WIN) + (size_t)l * PROJ * D, D, kb * 64, nb * 64, nb * 64, scr, F.lane); }
            else { r -= I_IN; const int kb = r / (D / 64), nb = r % (D / 64);
                transpose_item(A.in[I_WOUT + F.z] + (size_t)l * D * D, D, (bf16*)(F.ws + WS_WOUT) + (size_t)l * D * D, D, kb * 64, nb * 64, nb * 64, scr, F.lane); }
        }
    }
    for (int i = gt; i < DEPTH * NEXP * D; i += NGT) { const int l = i >> 16, e = (i >> 10) & 63, k = i & 1023;
        const float v = A.in[I_WR + F.z][((size_t)l * D + k) * NEXP + e]; const unsigned h = f2bf(v); const float lo = v - bf2f(h);
        ((bf16*)(F.ws + WS_RTHI))[i] = (bf16)h; ((bf16*)(F.ws + WS_RTLO))[i] = (bf16)f2bf(lo); }
    for (int i = gt; i < DEPTH * 2 * 2 * 4 * 64 * 64; i += NGT) { const int k = i & 63, n = (i >> 6) & 63, blk = (i >> 12) & 3, gate = (i >> 14) & 1, d = (i >> 15) & 1, l = i >> 16;
        const float* src = gate ? A.in[I_RGWX + F.z] : A.in[I_RGWA + F.z];
        ((bf16*)(F.ws + WS_RGW))[i] = (bf16)f2bf(src[((((size_t)l * 2 + d) * 4 + blk) * 64 + k) * 64 + n]); }
    for (int i = gt; i < 4096; i += NGT) { float s, c; sincospif(-(float)i * (1.0f / 4096.0f), &s, &c); ((f32x2v*)(F.ws + WS_TW))[i] = (f32x2v){c, s}; }
    for (int i = gt; i < T * 32; i += NGT) { const int t = i >> 5, p = i & 31; const float pos = (float)(p < 16 ? (t >> 6) : (t & 63));
        const float invf = __builtin_amdgcn_exp2f(-(float)(p & 15) * (13.287712379549449f / 16.0f));     const float ang = pos * invf; float s, c; sincosf(ang, &s, &c); ((f32x2v*)(F.ws + WS_ROPE))[i] = (f32x2v){c, s}; }
}

__device__ __forceinline__ void modulate_row_bf16(const Frame& F, const float* hrow, const float* sh, const float* sc, bf16* orow, bf16* hbrow) {
    const GAS f32x4* xr = (const GAS f32x4*)hrow + F.lane; const f32x4* shv = (const f32x4*)sh + F.lane; const f32x4* scv = (const f32x4*)sc + F.lane;
    GAS v2u* o8 = (GAS v2u*)orow + F.lane; GAS v2u* h8 = (GAS v2u*)hbrow + F.lane;
#pragma unroll
    for (int j = 0; j < 4; ++j) { const f32x4 v = __builtin_nontemporal_load((const f32x4*)hrow + F.lane + 64 * j)  , a = shv[64 * j], b = scv[64 * j]; const f32x4 y = v * (b + 1.0f) + a; v2u o; o.x = pk2(y.x, y.y); o.y = pk2(y.z, y.w); o8[64 * j] = o;
        v2u hq; hq.x = pk2(v.x, v.y); hq.y = pk2(v.z, v.w); h8[64 * j] = hq; }
}
__device__ __forceinline__ void phase_prologue_b(Frame& F0, const Args& A) {
    Frame F = fresh(F0);
    const int gw = F.vcu * NWAVES + F.wave, NGW = F.G * NWAVES;
    for (int R = gw; R < M; R += NGW) { const int mr = modrow_of(R);
        const float* src = R < ML ? A.in[I_X + F.z] + (size_t)R * D : A.in[I_CTX + F.z] + (size_t)(R - ML) * D;
        modulate_row_bf16(F, src, modv(F, 0, mr, 0), modv(F, 0, mr, 1), (bf16*)(F.ws + WS_ABUF) + (size_t)R * D, (bf16*)(F.ws + WS_HB) + (size_t)R * D); }
}

__device__ __forceinline__ void phase_prep(Frame& F0, const Args& A, int l, bool do_moe, bool do_hy, int deal = 0) {
    Frame F = fresh(F0);
    const int gw = F.vcu * NWAVES + F.wave, NGW = F.G * NWAVES;
    if (do_moe) {
        LAS float* scr = (LAS float*)(F.lds + F.wave * TSCR);
        bf16* WGU = (bf16*)(F.ws + WS_WGU); bf16* WDN = (bf16*)(F.ws + WS_WDN);
        constexpr int NIT = 65 * 192, PREP_A = 16, PREP_B = 24; int it0, it1;
        const int nA = (F.G == 256 && deal != 0) ? 192 * PREP_A : 0;
        const int nB = (F.G == 256 && deal != 0 && l < DEPTH - 1) ? 224 * PREP_B : 0;
        if (deal == 1) { const int b = (int)blockIdx.x; const bool on = nA != 0 && b >= 64; it0 = on ? (b - 64) * PREP_A : 0; it1 = on ? it0 + PREP_A : 0; }
        else if (deal == 3) { const int b = (int)blockIdx.x; const bool on = nB != 0 && b >= 32; it0 = on ? nA + (b - 32) * PREP_B : 0; it1 = on ? it0 + PREP_B : 0; }
        else if (deal == 4 && F.G == 256 && l < DEPTH - 1) {
            constexpr int PREP_LO = 10; const int n0 = nA + nB, base = n0 + 128 * PREP_LO, rem = NIT - base;
            if (F.vcu < 128) { it0 = n0 + F.vcu * PREP_LO; it1 = it0 + PREP_LO; } else { it0 = base + (int)(((long)(F.vcu - 128) * rem) / 128); it1 = base + (int)(((long)(F.vcu - 127) * rem) / 128); } }
        else { const int n0 = nA + nB; it0 = n0 + (int)(((long)F.vcu * (NIT - n0)) / F.G); it1 = n0 + (int)(((long)(F.vcu + 1) * (NIT - n0)) / F.G); }
        struct T8 { const float* W; unsigned char* WT; int N, Kdst, k0, n0, drow0; };
        auto decode = [&](int it) { T8 t; const int e = it / 192; int r = it % 192; const int which = r >> 6; r &= 63;
            if (which < 2) { t.W = e < 64 ? (which == 0 ? A.in[I_WG + F.z] : A.in[I_WU + F.z]) + ((size_t)l * 64 + e) * (D * FF) : (which == 0 ? A.in[I_WSG + F.z] : A.in[I_WSU + F.z]) + (size_t)l * (D * FF);
                const int kb = r >> 2, nb = r & 3, n0 = nb * 64; t.N = FF; t.WT = (unsigned char*)WGU + (size_t)e * 512 * D; t.Kdst = D; t.k0 = kb * 64; t.n0 = n0; t.drow0 = (n0 >> 7) * 256 + which * 128 + (n0 & 127); }
            else { t.W = e < 64 ? A.in[I_WD + F.z] + ((size_t)l * 64 + e) * (FF * D) : A.in[I_WSD + F.z] + (size_t)l * (FF * D);
                const int kb = r >> 4, nb = r & 15; t.N = D; t.WT = (unsigned char*)WDN + (size_t)e * D * FF; t.Kdst = FF; t.k0 = kb * 64; t.n0 = nb * 64; t.drow0 = nb * 64; }
            return t; };
        const int rg = F.lane >> 4, c4 = (F.lane & 15) * 4, kc = (F.lane & 7) * 8;
        f32x4 vc[16], vn[16];
        int it = it0 + F.wave;
        if (it < it1) { const T8 t = decode(it);
#pragma unroll
            for (int i = 0; i < 16; ++i) vc[i] = __builtin_nontemporal_load((const f32x4*)(t.W + (size_t)(t.k0 + 4 * i + rg) * t.N + t.n0 + c4)); }
        for (; it < it1; it += NWAVES) {
            const T8 t = decode(it); const bool more = it + NWAVES < it1;
            if (more) { const T8 tn = decode(it + NWAVES);
#pragma unroll
                for (int i = 0; i < 16; ++i) vn[i] = __builtin_nontemporal_load((const f32x4*)(tn.W + (size_t)(tn.k0 + 4 * i + rg) * tn.N + tn.n0 + c4)); }
#pragma unroll
            for (int i = 0; i < 16; ++i) { LAS float* d = scr + (4 * i + rg) * 65 + c4; d[0] = vc[i].x * 16.0f; d[1] = vc[i].y * 16.0f; d[2] = vc[i].z * 16.0f; d[3] = vc[i].w * 16.0f; }
            LDS_WAIT(); asm volatile("" ::: "memory");
#pragma unroll
            for (int j = 0; j < 8; ++j) { const int n = (F.lane >> 3) + 8 * j; const LAS float* s = scr + kc * 65 + n;
                v2u o; o.x = pk4_fp8(s[0 * 65], s[1 * 65], s[2 * 65], s[3 * 65]); o.y = pk4_fp8(s[4 * 65], s[5 * 65], s[6 * 65], s[7 * 65]);
                __builtin_nontemporal_store(o, (GAS v2u*)(t.WT + (size_t)(t.drow0 + n) * t.Kdst + t.k0 + kc)); }
            LDS_WAIT(); asm volatile("" ::: "memory");
            if (more) {
#pragma unroll
                for (int i = 0; i < 16; ++i) vc[i] = vn[i]; }
        }
    }
    if (do_hy) {
        lds_barrier();
        LAS float* zb = (LAS float*)F.lds;
        LAS float* f1 = (LAS float*)(F.lds + 2048);
        LAS float* f2 = (LAS float*)(F.lds + 8192);
        const float* w1 = A.in[I_HYW1 + F.z] + (size_t)l * 17 * 64; const float* b1 = A.in[I_HYB1 + F.z] + l * 64; const float* fq = A.in[I_HYFREQ + F.z] + l * 64;
        const float* w2 = A.in[I_HYW2 + F.z] + (size_t)l * 64 * 64; const float* b2 = A.in[I_HYB2 + F.z] + l * 64; const float* w3 = A.in[I_HYW3 + F.z] + (size_t)l * 64 * 1024;
        const int nun = 256 + (l < DEPTH - 1 ? 16 : 0);
        for (int u = F.vcu; u >= 0 && u < nun; u = (F.G == 256) ? ((u < 256 && (int)blockIdx.x >= 64 && (int)blockIdx.x - 64 < nun - 256) ? 256 + (int)blockIdx.x - 64 : -1) : u + F.G) {
            const bool lat = u < 256; const int L = lat ? T : LC; const int n0 = (lat ? u : u - 256) * 16;
            float* FT = (float*)(F.ws + (lat ? WS_FILT : WS_FILTC));
            if (F.tid < 16 * 17) { const int p = F.tid / 17, i = F.tid % 17; const int n = n0 + p; float z;
                if (i == 0) z = (float)n / (float)(L - 1);
                else { const int bi = (i - 1) & 7; const float band = 1e-4f + (float)bi * ((7.0f - 1e-4f) / 7.0f); const float w = 6.283185307179586f * (float)n / (float)L; const float a = band * w;
                    z = (i <= 8) ? cosf(a) : -sinf(a); }
                zb[p * 17 + i] = z; }
            lds_barrier();
            for (int o = F.tid; o < 16 * 64; o += 512) { const int p = o >> 6, j = o & 63; float s = b1[j];
#pragma unroll
                for (int i = 0; i < 17; ++i) s += zb[p * 17 + i] * w1[i * 64 + j];
                f1[o] = sinf(fq[j] * s); }
            lds_barrier();
            for (int o = F.tid; o < 16 * 64; o += 512) { const int p = o >> 6, j = o & 63; float s = b2[j];
#pragma unroll 8
                for (int i = 0; i < 64; ++i) s += f1[p * 64 + i] * w2[i * 64 + j];
                f2[o] = sinf(fq[j] * s); }
            lds_barrier();
#pragma unroll
            for (int cc = 0; cc < 2; ++cc) { const int col = F.tid + cc * 512; float acc[16];
#pragma unroll
                for (int p = 0; p < 16; ++p) acc[p] = 0.f;
                for (int k = 0; k < 64; ++k) { const float w = w3[k * 1024 + col];
#pragma unroll
                    for (int p = 0; p < 16; ++p) acc[p] += f2[p * 64 + k] * w; }
                const int c = col & 255; const float delta = 3.0701134573253945f + (float)c * ((15.350567286626973f - 3.0701134573253945f) / 255.0f);
#pragma unroll
                for (int p4 = 0; p4 < 4; ++p4) { f32x4 o;
#pragma unroll
                    for (int q = 0; q < 4; ++q) { const int n = n0 + p4 * 4 + q; const float tt = (float)n / (float)(L - 1); o[q] = acc[p4 * 4 + q] * __expf(-tt * delta); }
                    *(f32x4*)(FT + (size_t)col * L + n0 + p4 * 4) = o; } }
            lds_barrier();
        }
    }
}
struct TwHalf { const LAS f32x2v* T; __device__ __forceinline__ f32x2v operator[](int k) const { const f32x2v w = T[k & 2047]; return (k & 2048) ? (f32x2v){w.y, -w.x} : w; } };
#define PADI(e) ((e) + (((e) >> 5) << 1))
template <int R, class XT, class TWT>
__device__ __forceinline__ void dif_task(XT X, TWT tw, int s, int task) {
    const int lgM = 13 - s, lgq = lgM - R, q = 1 << lgq;
    const int j0 = task & (q - 1), blk = task >> lgq, base = (blk << lgM) + j0;
    const int pb = PADI(base), qp = (q >= 32) ? q + (q >> 4) : q;
    f32x2v v[1 << R];
#pragma unroll
    for (int k = 0; k < (1 << R); ++k) v[k] = X[pb + k * qp];
#pragma unroll
    for (int r = 0; r < R; ++r) {
        const int pb = R - 1 - r;
#pragma unroll
        for (int k = 0; k < (1 << R); ++k) if (!((k >> pb) & 1)) {
            const int klo = k & ((1 << pb) - 1);
            const f32x2v w = tw[(j0 + (klo << lgq)) << (s + r)];
            const f32x2v a = v[k], b = v[k + (1 << pb)], d = a - b;
            v[k] = a + b; v[k + (1 << pb)] = (f32x2v){d.x * w.x - d.y * w.y, d.x * w.y + d.y * w.x};
        }
    }
#pragma unroll
    for (int k = 0; k < (1 << R); ++k) X[pb + k * qp] = v[k];
}
template <int R, class XT, class TWT>
__device__ __forceinline__ void dit_task(XT X, TWT tw, int s, int task) {
    const int lgM = 13 - s, lgq = lgM - R, q = 1 << lgq;
    const int j0 = task & (q - 1), blk = task >> lgq, base = (blk << lgM) + j0;
    const int pb = PADI(base), qp = (q >= 32) ? q + (q >> 4) : q;
    f32x2v v[1 << R];
#pragma unroll
    for (int k = 0; k < (1 << R); ++k) v[k] = X[pb + k * qp];
#pragma unroll
    for (int r = R - 1; r >= 0; --r) {
        const int pb = R - 1 - r;
#pragma unroll
        for (int k = 0; k < (1 << R); ++k) if (!((k >> pb) & 1)) {
            const int klo = k & ((1 << pb) - 1);
            const f32x2v w = tw[(j0 + (klo << lgq)) << (s + r)];
            const f32x2v a = v[k], qv = v[k + (1 << pb)]; const f32x2v b = (f32x2v){qv.x * w.x + qv.y * w.y, qv.y * w.x - qv.x * w.y};
            v[k] = a + b; v[k + (1 << pb)] = a - b;
        }
    }
#pragma unroll
    for (int k = 0; k < (1 << R); ++k) X[pb + k * qp] = v[k];
}

__device__ __forceinline__ void load_tw(Frame& F, LAS f32x2v* tw) { const f32x2v* g = (const f32x2v*)(F.ws + WS_TW); for (int i = F.tid; i < 2048; i += 512) tw[i] = g[i]; }
__device__ __forceinline__ void fft_fwd_upper(LAS f32x2v* X, TwHalf tw, int s0, int tid) {
    if (s0 == 0) { dif_task<4>(X, tw, 0, tid); lds_barrier(); }
    dif_task<4>(X, tw, 4, tid); lds_barrier();
    dif_task<4>(X, tw, 8, tid); lds_barrier();
}
__device__ __forceinline__ void fft_inv_upper(LAS f32x2v* X, TwHalf tw, int s0, int tid) {
    dit_task<4>(X, tw, 8, tid); lds_barrier();
    dit_task<4>(X, tw, 4, tid); lds_barrier();
    if (s0 == 0) { dit_task<4>(X, tw, 0, tid); lds_barrier(); }
}

__device__ __forceinline__ void phase_spectra(Frame& F0, int l) {
    Frame F = fresh(F0);
    LAS f32x2v* X = (LAS f32x2v*)F.lds; LAS f32x2v* twl = (LAS f32x2v*)(F.lds + 69632); const TwHalf tw{twl};
    lds_barrier(); load_tw(F, twl);
    const int nun = 512 + (l < DEPTH - 1 ? 32 : 0);
    for (int u = F.vcu; u < nun; u += F.G) {
        const bool lat = u < 512; const int L = lat ? T : LC, lgN = lat ? 13 : 9, N = 2 * L; const int col0 = lat ? u : (u - 512) * 16;
        const float* FT = (const float*)(F.ws + (lat ? WS_FILT : WS_FILTC));
        lds_barrier();
        { float vv[16];
#pragma unroll
            for (int r = 0; r < 16; ++r) { const int e = F.tid + 512 * r, seg = e >> lgN, n = e & (N - 1); const int oc = col0 + seg;
                float v = 0.f;
                if (n < L) v = FT[(size_t)oc * L + n]; else if (n > L) v = FT[(size_t)(512 + oc) * L + (N - n)];
                vv[r] = v; }
#pragma unroll
            for (int r = 0; r < 16; ++r) X[PADI(F.tid + 512 * r)] = (f32x2v){vv[r], 0.f}; }
        lds_barrier();
        fft_fwd_upper(X, tw, 13 - lgN, F.tid);
        f32x2v* SP = (f32x2v*)(F.ws + (lat ? WS_SPEC : WS_SPECC)) + (size_t)col0 * N; const float sc = 1.0f / (float)N;
#pragma unroll 2
        for (int r = 0; r < 8; ++r) { const int e = 2 * (F.tid + 512 * r); const f32x2v a = X[PADI(e)], b = X[PADI(e + 1)];
            *(f32x4*)(SP + e) = (f32x4){(a.x + b.x) * sc, (a.y + b.y) * sc, (a.x - b.x) * sc, (a.y - b.y) * sc}; }
    }
    lds_barrier();
}

template <bool LAT>
__device__ __forceinline__ void hyconv_unit(const Frame& F, LAS f32x2v* X, const TwHalf tw, LAS bf16* OUT, const float* skip, bf16* MIX, int u) {
    constexpr int L = LAT ? T : LC, lgN = LAT ? 13 : 9, N = 2 * L, NV = LAT ? 8 : 16;
    const int bp = LAT ? (u >> 6) : ((u - 256) >> 4), cbase = LAT ? (u & 63) * 4 : ((u - 256) & 15) * 16;
    bf16* H0 = (bf16*)(F.ws + (LAT ? WS_HT : WS_HTC)) + (size_t)(2 * bp) * 768 * L; bf16* H1 = H0 + (size_t)768 * L;
    const int rowb = LAT ? (2 * bp) * T : ML + (2 * bp) * LC;
    const bool act = LAT || F.tid < LC;
    const int n = LAT ? 0 : F.tid;
    constexpr int nci = LAT ? 4 : 1;
#pragma unroll 1
    for (int ci = 0; ci < nci; ++ci) {
        const int c0 = cbase + ci;
        const f32x2v* SPb = (const f32x2v*)(F.ws + (LAT ? WS_SPEC : WS_SPECC)) + (size_t)c0 * N;
        lds_barrier();
        if constexpr (LAT) {
            unsigned w0[4], w1[4]; const bf16* p0 = H0 + (size_t)(512 + c0) * L; const bf16* p1 = H1 + (size_t)(512 + c0) * L;
#pragma unroll
            for (int r = 0; r < 4; ++r) { const int pr = F.tid + 512 * r; w0[r] = *(const unsigned*)(p0 + 2 * pr); w1[r] = *(const unsigned*)(p1 + 2 * pr); }
#pragma unroll
            for (int r = 0; r < 8; ++r) { const int e = 2 * (F.tid + 512 * r); f32x4 xx = (f32x4){0.f, 0.f, 0.f, 0.f};
                if (r < 4) xx = (f32x4){bflo(w0[r]), bflo(w1[r]), bfhi(w0[r]), bfhi(w1[r])};
                *(LAS f32x4*)(X + PADI(e)) = xx; }
        } else {
            f32x2v v[16];
            { const bf16* p0 = H0 + (size_t)(512 + c0) * L + n; const bf16* p1 = H1 + (size_t)(512 + c0) * L + n;
#pragma unroll
              for (int r = 0; r < 16; ++r) { v[r] = (f32x2v){0.f, 0.f}; if (act) v[r] = (f32x2v){bf2f(p0[r * L]), bf2f(p1[r * L])}; } }
#pragma unroll
            for (int r = 0; r < 16; ++r) X[PADI(F.tid + 512 * r)] = v[r];
        }
        lds_barrier();
#pragma unroll 1
        for (int ord = 0; ord < 2; ++ord) {
            const f32x2v* SP = SPb + (size_t)ord * 256 * N;
            f32x4 kq[8];
#pragma unroll
            for (int r = 0; r < 8; ++r) kq[r] = *(const f32x4*)(SP + 2 * (F.tid + 512 * r));
            fft_fwd_upper(X, tw, 13 - lgN, F.tid);
#pragma unroll
            for (int r = 0; r < 8; ++r) { const int e = 2 * (F.tid + 512 * r);
                const f32x2v a = X[PADI(e)], b = X[PADI(e + 1)]; const f32x4 k = kq[r];
                const f32x2v p = a + b, q = a - b; const f32x2v pk = (f32x2v){p.x * k.x - p.y * k.y, p.x * k.y + p.y * k.x}, qk = (f32x2v){q.x * k.z - q.y * k.w, q.x * k.w + q.y * k.z};
                X[PADI(e)] = pk + qk; X[PADI(e + 1)] = pk - qk; }
            lds_barrier();
            if constexpr (LAT) {
                const float sk = skip[ord * 256 + c0];
                const bf16* g0 = H0 + (size_t)(ord * 256 + c0) * L; const bf16* g1 = H1 + (size_t)(ord * 256 + c0) * L; bf16* v0 = H0 + (size_t)(512 + c0) * L; bf16* v1 = H1 + (size_t)(512 + c0) * L;
                fft_inv_upper(X, tw, 13 - lgN, F.tid);
                unsigned ga[4], gb[4], za[4], zb[4];
#pragma unroll
                for (int r = 0; r < 4; ++r) { const int pr = F.tid + 512 * r; ga[r] = *(const unsigned*)(g0 + 2 * pr); gb[r] = *(const unsigned*)(g1 + 2 * pr); za[r] = *(const unsigned*)(v0 + 2 * pr); zb[r] = *(const unsigned*)(v1 + 2 * pr); }
#pragma unroll
                for (int r = 0; r < 8; ++r) { const int e = 2 * (F.tid + 512 * r); f32x4 zz = (f32x4){0.f, 0.f, 0.f, 0.f};
                    if (r < 4) { const f32x4 xx = *(const LAS f32x4*)(X + PADI(e));
                        zz.x = bflo(ga[r]) * (xx.x + bflo(za[r]) * sk); zz.y = bflo(gb[r]) * (xx.y + bflo(zb[r]) * sk); zz.z = bfhi(ga[r]) * (xx.z + bfhi(za[r]) * sk); zz.w = bfhi(gb[r]) * (xx.w + bfhi(zb[r]) * sk);
                        if (ord == 0) { *(unsigned*)(v0 + e) = pk2(zz.x, zz.z); *(unsigned*)(v1 + e) = pk2(zz.y, zz.w); }
                        else { OUT[e * 4 + ci] = (bf16)f2bf(zz.x); OUT[(e + 1) * 4 + ci] = (bf16)f2bf(zz.z); OUT[(T + e) * 4 + ci] = (bf16)f2bf(zz.y); OUT[(T + e + 1) * 4 + ci] = (bf16)f2bf(zz.w); } }
                    if (ord == 0) *(LAS f32x4*)(X + PADI(e)) = zz; }
            } else {
                fft_inv_upper(X, tw, 13 - lgN, F.tid);
                f32x2v g[16], zp[16];
                { const bf16* g0 = H0 + (size_t)(ord * 256 + c0) * L + n; const bf16* g1 = H1 + (size_t)(ord * 256 + c0) * L + n; const bf16* v0 = H0 + (size_t)(512 + c0) * L + n; const bf16* v1 = H1 + (size_t)(512 + c0) * L + n;
#pragma unroll
                  for (int r = 0; r < 16; ++r) { g[r] = (f32x2v){0.f, 0.f}; zp[r] = g[r]; if (act) { g[r] = (f32x2v){bf2f(g0[r * L]), bf2f(g1[r * L])}; zp[r] = (f32x2v){bf2f(v0[r * L]), bf2f(v1[r * L])}; } } }
                f32x2v z[16];
#pragma unroll
                for (int r = 0; r < 16; ++r) { z[r] = g[r] * (X[PADI(F.tid + 512 * r)] + zp[r] * skip[ord * 256 + c0 + r]); }
                if (ord == 0) { bf16* v0 = H0 + (size_t)(512 + c0) * L + n; bf16* v1 = H1 + (size_t)(512 + c0) * L + n;
#pragma unroll
                    for (int r = 0; r < 16; ++r) { if (act) { v0[r * L] = (bf16)f2bf(z[r].x); v1[r * L] = (bf16)f2bf(z[r].y); } X[PADI(F.tid + 512 * r)] = z[r]; } }
                else if (act) {
                    v4u oa, ob, oc, od;
                    oa.x = pk2(z[0].x, z[1].x); oa.y = pk2(z[2].x, z[3].x); oa.z = pk2(z[4].x, z[5].x); oa.w = pk2(z[6].x, z[7].x); ob.x = pk2(z[8].x, z[9].x); ob.y = pk2(z[10].x, z[11].x); ob.z = pk2(z[12].x, z[13].x); ob.w = pk2(z[14].x, z[15].x);
                    oc.x = pk2(z[0].y, z[1].y); oc.y = pk2(z[2].y, z[3].y); oc.z = pk2(z[4].y, z[5].y); oc.w = pk2(z[6].y, z[7].y); od.x = pk2(z[8].y, z[9].y); od.y = pk2(z[10].y, z[11].y); od.z = pk2(z[12].y, z[13].y); od.w = pk2(z[14].y, z[15].y);
                    bf16* m0 = MIX + (size_t)(rowb + n) * 1024 + c0; bf16* m1 = m0 + (size_t)L * 1024;
                    *(v4u*)m0 = oa; *(v4u*)(m0 + 8) = ob; *(v4u*)m1 = oc; *(v4u*)(m1 + 8) = od; }
            }
            lds_barrier();
        }
    }
    if (LAT) {
#pragma unroll 4
        for (int r = 0; r < 16; ++r) { const int rr = F.tid + 512 * r; const v2u o = *(const LAS v2u*)(OUT + rr * 4); *(v2u*)(MIX + (size_t)(rowb + rr) * 1024 + cbase) = o; }
    }
}
__device__ __forceinline__ void phase_hyconv(Frame& F0, const Args& A, int l) {
    Frame F = fresh(F0);
    LAS f32x2v* X = (LAS f32x2v*)F.lds; LAS f32x2v* twl = (LAS f32x2v*)(F.lds + 69632); const TwHalf tw{twl};
    LAS bf16* OUT = (LAS bf16*)(F.lds + 69632 + 16384);
    lds_barrier(); load_tw(F, twl);
    const float* skip = A.in[I_HYSKIP + F.z] + (size_t)l * 512;
    bf16* MIX = (bf16*)(F.ws + WS_MIX);
    for (int u = F.vcu; u < 256; u += F.G) hyconv_unit<true>(F, X, tw, OUT, skip, MIX, u);
    if (l < DEPTH - 1) { const int v = F.vcu - 64; if (v >= 0 && v < 64) hyconv_unit<false>(F, X, tw, OUT, skip, MIX, 256 + v); else if (F.G < 128) for (int u = 256 + F.vcu; u < 320; u += F.G) hyconv_unit<false>(F, X, tw, OUT, skip, MIX, u); }
    lds_barrier();
}
__device__ __forceinline__ void phase_qkv_rows(Frame& F0, const Args& A, int l) {
    Frame F = fresh(F0);
    const int gw = F.vcu * NWAVES + F.wave, NGW = F.G * NWAVES, lane = F.lane;
    const bf16* P = (const bf16*)(F.ws + WS_P); bf16* QB = (bf16*)(F.ws + WS_QB); bf16* KB = (bf16*)(F.ws + WS_KB); bf16* VB = (bf16*)(F.ws + WS_VB);
    const float* qg = A.in[I_QN + F.z] + l * 64; const float* kg = A.in[I_KN + F.z] + l * 64; const f32x2v* rope = (const f32x2v*)(F.ws + WS_ROPE);
    const bool last = (l == DEPTH - 1);
    float qgl[8]; { const int d0 = (8 * lane) & 63;
#pragma unroll
        for (int j = 0; j < 8; ++j) qgl[j] = qg[d0 + j]; }
    const float kg0 = kg[(2 * lane) & 63], kg1 = kg[((2 * lane) & 63) + 1];
    const int p0 = (4 * lane) & 31;
    for (int Rb = gw; Rb < M; Rb += 2 * NGW) {
        unsigned kw[2], vw[2]; v4u qw[2]; f32x2v kcs[2], qcs[2][4]; bool lat[2], doq[2], ok[2]; int tt[2]; long kvrow[2];
#pragma unroll
        for (int q = 0; q < 2; ++q) { const int R = Rb + q * NGW; ok[q] = R < M; const int Rc = ok[q] ? R : Rb;
            lat[q] = Rc < ML; const int b = lat[q] ? (Rc >> 12) : ((Rc - ML) >> 8); tt[q] = lat[q] ? (Rc & 4095) : ((Rc - ML) & 255);
            kvrow[q] = (long)b * SKV + (lat[q] ? tt[q] : T + tt[q]); doq[q] = lat[q] || !last;
            const bf16* pr = P + (size_t)Rc * PROJ;
            kw[q] = *(const unsigned*)(pr + C_K + 2 * lane); vw[q] = *(const unsigned*)(pr + C_V + 2 * lane); qw[q] = *(const v4u*)(pr + C_Q + 8 * lane);
            const int tr = lat[q] ? tt[q] : 0; kcs[q] = rope[tr * 32 + (lane & 31)];
#pragma unroll
            for (int j = 0; j < 4; ++j) qcs[q][j] = rope[tr * 32 + p0 + j]; }
#pragma unroll
        for (int q = 0; q < 2; ++q) { if (!ok[q]) continue; const int R = Rb + q * NGW;
            { float k0 = bflo(kw[q]), k1 = bfhi(kw[q]); float ss = k0 * k0 + k1 * k1;
                ss = sum32(ss);
                const float rs = 1.0f / sqrtf(ss * (1.0f / 64.0f) + QK_EPS); k0 = k0 * rs * kg0; k1 = k1 * rs * kg1;
                if (lat[q]) { const f32x2v cs = kcs[q]; const float r0 = k0 * cs.x - k1 * cs.y, r1 = k0 * cs.y + k1 * cs.x; k0 = r0; k1 = r1; }
                *(unsigned*)(KB + kvrow[q] * 128 + 2 * lane) = pk2(k0, k1); *(unsigned*)(VB + kvrow[q] * 128 + 2 * lane) = vw[q]; }
            if (doq[q]) { float qv[8];
                qv[0] = bflo(qw[q].x); qv[1] = bfhi(qw[q].x); qv[2] = bflo(qw[q].y); qv[3] = bfhi(qw[q].y); qv[4] = bflo(qw[q].z); qv[5] = bfhi(qw[q].z); qv[6] = bflo(qw[q].w); qv[7] = bfhi(qw[q].w);
                float ss = 0.f;
#pragma unroll
                for (int j = 0; j < 8; ++j) ss += qv[j] * qv[j];
                ss = sum8(ss);
                const float rs = 1.0f / sqrtf(ss * (1.0f / 64.0f) + QK_EPS);
#pragma unroll
                for (int j = 0; j < 8; ++j) qv[j] = qv[j] * rs * qgl[j];
                if (lat[q]) {
#pragma unroll
                    for (int j = 0; j < 4; ++j) { const f32x2v cs = qcs[q][j]; const float r0 = qv[2 * j] * cs.x - qv[2 * j + 1] * cs.y, r1 = qv[2 * j] * cs.y + qv[2 * j + 1] * cs.x; qv[2 * j] = r0; qv[2 * j + 1] = r1; } }
                constexpr float C2 = 0.125f * 1.4426950408889634f;
                v4u o; o.x = pk2(qv[0] * C2, qv[1] * C2); o.y = pk2(qv[2] * C2, qv[3] * C2); o.z = pk2(qv[4] * C2, qv[5] * C2); o.w = pk2(qv[6] * C2, qv[7] * C2);
                *(v4u*)(QB + (size_t)R * 512 + 8 * lane) = o; }
        }
    }
}

__device__ __forceinline__ void phase_hy_short(Frame& F0, const Args& A, int l) {
    Frame F = fresh(F0);
    const int gw = F.vcu * NWAVES + F.wave, NGW = F.G * NWAVES, lane = F.lane;
    LAS float* scr = (LAS float*)(F.lds + F.wave * 16384);
    const bf16* P = (const bf16*)(F.ws + WS_P);
    const float* sw = A.in[I_HYSW + F.z] + (size_t)l * 3 * 768; const float* sb = A.in[I_HYSB + F.z] + (size_t)l * 768;
    const int nlat = NB * 64 * 24, nctx = (l < DEPTH - 1) ? NB * 4 * 24 : 0;
    lds_barrier();
    for (int it = gw; it < nlat + nctx; it += NGW) {
        const bool lat = it < nlat; const int r = lat ? it : it - nlat; const int cb = r % 24; const int tb = (r / 24) % (lat ? 64 : 4); const int b = r / (24 * (lat ? 64 : 4));
        const int L = lat ? T : LC, t0 = tb * 64, c0 = cb * 32; const size_t row0 = lat ? (size_t)b * T : (size_t)ML + (size_t)b * LC;
        { v4u w[5]; const int cq = (lane & 3) * 8;
#pragma unroll
            for (int i = 0; i < 5; ++i) { const int rr = (lane >> 2) + 16 * i; const int t = t0 - 1 + rr; w[i] = (v4u){0u, 0u, 0u, 0u};
                if (rr < 66 && t >= 0 && t < L) w[i] = *(const v4u*)(P + (row0 + t) * PROJ + C_HY + c0 + cq); }
#pragma unroll
            for (int i = 0; i < 5; ++i) { const int rr = (lane >> 2) + 16 * i; if (rr < 66) { LAS float* d = scr + rr * 33 + cq;
                d[0] = bflo(w[i].x); d[1] = bfhi(w[i].x); d[2] = bflo(w[i].y); d[3] = bfhi(w[i].y); d[4] = bflo(w[i].z); d[5] = bfhi(w[i].z); d[6] = bflo(w[i].w); d[7] = bfhi(w[i].w); } } }
        LDS_WAIT(); asm volatile("" ::: "memory");
        { const int tg = lane & 7, cl = lane >> 3; bf16* HT = (bf16*)(F.ws + (lat ? WS_HT : WS_HTC)) + ((size_t)b * 768 + c0) * L + t0 + 8 * tg;
#pragma unroll
            for (int k = 0; k < 4; ++k) { const int cc = cl + 8 * k, ch = c0 + cc; const float w0 = sw[ch], w1 = sw[768 + ch], w2 = sw[1536 + ch], bb = sb[ch];
                float in[10];
#pragma unroll
                for (int i = 0; i < 10; ++i) in[i] = scr[(8 * tg + i) * 33 + cc];
                float o[8];
#pragma unroll
                for (int j = 0; j < 8; ++j) o[j] = in[j] * w0 + in[j + 1] * w1 + in[j + 2] * w2 + bb;
                v4u pk; pk.x = pk2(o[0], o[1]); pk.y = pk2(o[2], o[3]); pk.z = pk2(o[4], o[5]); pk.w = pk2(o[6], o[7]);
                *(v4u*)(HT + (size_t)cc * L) = pk; } }
        LDS_WAIT(); asm volatile("" ::: "memory");
    }
}

__device__ __forceinline__ float fsigmoid(float x) { return __builtin_amdgcn_rcpf(1.0f + __expf(-x)); }
__device__ __forceinline__ float bperm_f(int idx4, float x) { return __builtin_bit_cast(float, __builtin_amdgcn_ds_bpermute(idx4, __builtin_bit_cast(int, x))); }
template <int CTRL> __device__ __forceinline__ float dpp_f(float old, float src) { return __builtin_bit_cast(float, __builtin_amdgcn_update_dpp(__builtin_bit_cast(int, old), __builtin_bit_cast(int, src), CTRL, 0xF, 0xF, false)); }
template <bool REV, int S> __device__ __forceinline__ void rg_scan_step(float& Av, float& Bv) {
    const float Ap = dpp_f<(REV ? 0x100 : 0x110) + S>(1.0f, Av), Bp = dpp_f<(REV ? 0x100 : 0x110) + S>(0.0f, Bv);
    Bv = Av * Bp + Bv; Av = Ap * Av;
}
__device__ __forceinline__ int rg_chain_tile(int b, int dir, int p) { return p < 4 ? 512 + 4 * b + (dir ? 3 - p : p) : 64 * b + (dir ? 67 - p : p - 4); }
template <int PASS, bool REV>
__device__ __forceinline__ void rg_wave_body(const Frame& F, const LAS bf16* UB, const bf16* Wg, const LAS float* cst  , int blk, int R0, int u, int d,
                                             f32x2v* CAR, const LAS float* CIN, LAS float* HS, const bf16* P, bf16* MIX, bool emit, int ng_lo, int ng_hi) {
    const int lane = F.lane, fr = lane & 15, fq = lane >> 4;
    bf16x8 wcur[2][2];
#pragma unroll
    for (int gt = 0; gt < 2; ++gt)
#pragma unroll
        for (int kk = 0; kk < 2; ++kk) wcur[gt][kk] = *(const bf16x8*)(Wg + ((size_t)(gt * 4 + blk) * 64 + ng_lo * 16 + fr) * 64 + kk * 32 + fq * 8);
#pragma unroll 1
    for (int ng = ng_lo; ng < ng_hi; ++ng) {
        f32x4 aa[4], ax[4];
        v2u gwv[4];
#pragma unroll
        for (int tg = 0; tg < 4; ++tg) { aa[tg] = (f32x4){0.f, 0.f, 0.f, 0.f}; ax[tg] = (f32x4){0.f, 0.f, 0.f, 0.f}; }
#pragma unroll
        for (int kk = 0; kk < 2; ++kk) { const bf16x8 wa = wcur[0][kk], wx = wcur[1][kk]; bf16x8 uf[4][2];
#pragma unroll
            for (int tg = 0; tg < 4; ++tg) uf[tg][kk] = *(const LAS bf16x8*)(UB + (tg * 16 + fr) * 264 + blk * 64 + kk * 32 + fq * 8);
#pragma unroll
            for (int tg = 0; tg < 4; ++tg) { aa[tg] = __builtin_amdgcn_mfma_f32_16x16x32_bf16(wa, uf[tg][kk], aa[tg], 0, 0, 0); ax[tg] = __builtin_amdgcn_mfma_f32_16x16x32_bf16(wx, uf[tg][kk], ax[tg], 0, 0, 0); } }
        { const int ng1 = (ng + 1 < ng_hi) ? ng + 1 : ng_lo;
#pragma unroll
            for (int gt = 0; gt < 2; ++gt)
#pragma unroll
                for (int kk = 0; kk < 2; ++kk) wcur[gt][kk] = *(const bf16x8*)(Wg + ((size_t)(gt * 4 + blk) * 64 + ng1 * 16 + fr) * 64 + kk * 32 + fq * 8); }
        if (PASS == 2 && REV && emit) {
#pragma unroll
            for (int tg = 0; tg < 4; ++tg) gwv[tg] = *(const v2u*)(P + (size_t)(R0 + tg * 16 + fr) * PROJ + C_RGG + blk * 64 + ng * 16 + fq * 4); }
        const int ch = blk * 64 + ng * 16 + fq * 4; const f32x4 sp = *(const LAS f32x4*)(cst + ch), bav = *(const LAS f32x4*)(cst + 256 + ch), bxv = *(const LAS f32x4*)(cst + 512 + ch);
#pragma unroll
        for (int tg = 0; tg < 4; ++tg) { const v2u uw = *(const LAS v2u*)(UB + (tg * 16 + fr) * 264 + ch); const float uv[4] = {bflo(uw.x), bfhi(uw.x), bflo(uw.y), bfhi(uw.y)};
#pragma unroll
            for (int j = 0; j < 4; ++j) { const float r = fsigmoid(aa[tg][j] + bav[j]), ig = fsigmoid(ax[tg][j] + bxv[j]); const float la = -8.0f * r * sp[j];
                float Av = __expf(la); const float om = __builtin_fmaf(-Av, Av, 1.0f);
                float Bv = __builtin_amdgcn_sqrtf(om) * (ig * uv[j]);
                rg_scan_step<REV, 1>(Av, Bv); rg_scan_step<REV, 2>(Av, Bv); rg_scan_step<REV, 4>(Av, Bv); rg_scan_step<REV, 8>(Av, Bv);
                aa[tg][j] = Av; ax[tg][j] = Bv; } }
        const int lastl4 = ((lane & 48) | (REV ? 0 : 15)) << 2;
        if (PASS == 1) {
            f32x4 At = (f32x4){1.f, 1.f, 1.f, 1.f}, Bt = (f32x4){0.f, 0.f, 0.f, 0.f};
#pragma unroll
            for (int t4 = 0; t4 < 4; ++t4) { const int tg = REV ? 3 - t4 : t4;
#pragma unroll
                for (int j = 0; j < 4; ++j) { const float ta = bperm_f(lastl4, aa[tg][j]), tb = bperm_f(lastl4, ax[tg][j]); Bt[j] = ta * Bt[j] + tb; At[j] = At[j] * ta; } }
            if (fr == 0) { f32x4* cp = (f32x4*)(CAR + ((size_t)u * 2 + d) * 256 + ch); cp[0] = (f32x4){At[0], Bt[0], At[1], Bt[1]}; cp[1] = (f32x4){At[2], Bt[2], At[3], Bt[3]}; }
        } else {
            f32x4 hin = *(const LAS f32x4*)(CIN + d * 256 + ch);
#pragma unroll
            for (int t4 = 0; t4 < 4; ++t4) { const int tg = REV ? 3 - t4 : t4;
#pragma unroll
                for (int j = 0; j < 4; ++j) { const float h = aa[tg][j] * hin[j] + ax[tg][j]; ax[tg][j] = h; hin[j] = bperm_f(lastl4, h); } }
            LAS float* hs = HS + (ng & 1) * 4096;
            if (!REV) {
#pragma unroll
                for (int tg = 0; tg < 4; ++tg) *(LAS f32x4*)(hs + (tg * 16 + fr) * 64 + blk * 16 + fq * 4) = ax[tg];
            }
            lds_barrier();
            if (REV && emit) {
#pragma unroll
                for (int tp = 0; tp < 4; tp += 2) { unsigned pkk[2][2];
#pragma unroll
                    for (int dm = 0; dm < 2; ++dm) { const int tg = tp + dm; const int tok = tg * 16 + fr; const f32x4 hf = *(const LAS f32x4*)(hs + tok * 64 + blk * 16 + fq * 4);
                        const v2u gw = gwv[tg]; const float g[4] = {bflo(gw.x), bfhi(gw.x), bflo(gw.y), bfhi(gw.y)}; float y[4];
#pragma unroll
                        for (int j = 0; j < 4; ++j) { const float x = g[j]; const float u2 = 1.5957691216057308f * (x + 0.044715f * x * x * x); y[j] = (hf[j] + ax[tg][j]) * x * fsigmoid(u2); }
                        pkk[dm][0] = pk2(y[0], y[1]); pkk[dm][1] = pk2(y[2], y[3]); }
                    { auto r = __builtin_amdgcn_permlane16_swap(pkk[0][0], pkk[1][0], false, false); pkk[0][0] = r[0]; pkk[1][0] = r[1]; }
                    { auto r = __builtin_amdgcn_permlane16_swap(pkk[0][1], pkk[1][1], false, false); pkk[0][1] = r[0]; pkk[1][1] = r[1]; }
                    v4u o; o.x = pkk[0][0]; o.y = pkk[0][1]; o.z = pkk[1][0]; o.w = pkk[1][1];
                    const int tok = (tp + (fq & 1)) * 16 + fr;
                    *(v4u*)(MIX + (size_t)(R0 + tok) * 1024 + 768 + ch - (fq & 1) * 4) = o; }
            }
        }
    }
}
template <int PASS>
__device__ __forceinline__ void phase_rg(Frame& F0, const Args& A, int l) {
    Frame F = fresh(F0);
    LAS bf16* UB = (LAS bf16*)F.lds;
    LAS float* CIN = (LAS float*)(F.lds + 34816);
    LAS float* HS = (LAS float*)(F.lds + 36864);
    const bf16* P = (const bf16*)(F.ws + WS_P); bf16* MIX = (bf16*)(F.ws + WS_MIX);
    const float* cw = A.in[I_RGCW + F.z] + (size_t)l * 4 * 256; const float* cb = A.in[I_RGCB + F.z] + (size_t)l * 256;
    const int wave = F.wave, d = wave >> 2, blk = wave & 3;
    const bf16* Wg = (const bf16*)(F.ws + WS_RGW) + ((size_t)(l * 2 + d) * 2) * 4 * 4096;
    LAS float* CST = (LAS float*)(F.lds + 69632);
    lds_barrier();
    for (int i = F.tid; i < 2 * 3 * 256; i += 512) { const int dd = i / 768, k = (i / 256) % 3, c = i & 255; const size_t o = (size_t)(l * 2 + dd) * 256 + c; float v;
        if (k == 0) { const float x = -A.in[I_RGLAM + F.z][o]; const float ex = __expf(-fabsf(x)); const float l1p = ex < 0.03125f ? ex * (1.0f + ex * (-0.5f + ex * (0.33333334f + ex * -0.25f))) : __logf(1.0f + ex); v = fmaxf(x, 0.f) + l1p;     } else v = (k == 1 ? A.in[I_RGBA + F.z] : A.in[I_RGBX + F.z])[o];
        CST[i] = v; }
    LAS float* CW = CST + 1536;
    for (int i = F.tid; i < 1280; i += 512) CW[i] = i < 1024 ? cw[i] : cb[i - 1024];
    f32x2v* CAR = (f32x2v*)(F.ws + WS_RGA);
    const bool last = (l == DEPTH - 1);
    const int ntile = (PASS == 2 && last) ? ML / 64 : M / 64;
    const int nit = (F.G == 256) ? 3 : (ntile + F.G - 1) / F.G;
    for (int it = 0; it < nit; ++it) {
        int u = F.vcu + it * F.G, ng_lo = 0, ng_hi = 4;
        if (F.G == 256 && it == 2) { if (F.vcu >= 128) { const int pc = F.vcu - 128; u = 512 + (pc >> 2); ng_lo = pc & 3; ng_hi = ng_lo + 1; } else u = ntile; }
        if (u >= ntile) continue;
        const int R0 = u * 64; const bool lat = R0 < ML; const int L = lat ? T : LC; const int t0 = lat ? (R0 & 4095) : ((R0 - ML) & 255);
        lds_barrier(); tm_seg(F, 24);
        { const int tok = F.tid >> 3, cg = (F.tid & 7) * 32; const int t = t0 + tok;
#pragma unroll
            for (int c8 = 0; c8 < 4; ++c8) { const int ch = cg + c8 * 8; float acc[8];
#pragma unroll
                for (int j = 0; j < 8; ++j) acc[j] = CW[1024 + ch + j];
#pragma unroll
                for (int tap = 0; tap < 4; ++tap) { const int tt = t - 1 + tap;
                    if (tt >= 0 && tt < L) { const v4u w = *(const v4u*)(P + (size_t)(R0 + tok - 1 + tap) * PROJ + C_RGX + ch); const LAS float* cwp = CW + tap * 256 + ch;
                        acc[0] += bflo(w.x) * cwp[0]; acc[1] += bfhi(w.x) * cwp[1]; acc[2] += bflo(w.y) * cwp[2]; acc[3] += bfhi(w.y) * cwp[3];
                        acc[4] += bflo(w.z) * cwp[4]; acc[5] += bfhi(w.z) * cwp[5]; acc[6] += bflo(w.w) * cwp[6]; acc[7] += bfhi(w.w) * cwp[7]; } }
                v4u o; o.x = pk2(acc[0], acc[1]); o.y = pk2(acc[2], acc[3]); o.z = pk2(acc[4], acc[5]); o.w = pk2(acc[6], acc[7]);
                *(LAS v4u*)(UB + tok * 264 + ch) = o; } }
        tm_seg(F, 25);
        if (PASS == 2) {
            const int dir = F.tid >> 8, ch = F.tid & 255; const int b = lat ? (u >> 6) : ((u - 512) >> 2); const int i = lat ? (u & 63) : ((u - 512) & 3);
            const int pos = lat ? (dir ? 4 + 63 - i : 4 + i) : (dir ? 3 - i : i);
            float h = 0.f;
            for (int p0 = 0; p0 < pos; p0 += 17) { f32x2v cv[17];
#pragma unroll
                for (int j = 0; j < 17; ++j) { const int p = p0 + j; cv[j] = (f32x2v){1.f, 0.f}; if (p < pos) cv[j] = CAR[((size_t)rg_chain_tile(b, dir, p) * 2 + dir) * 256 + ch]; }
#pragma unroll
                for (int j = 0; j < 17; ++j) h = cv[j].x * h + cv[j].y; }
            CIN[dir * 256 + ch] = h;
        }
        lds_barrier(); tm_seg(F, 26);
        const bool emit = true;
        if (d == 0) rg_wave_body<PASS, false>(F, UB, Wg, CST, blk, R0, u, 0, CAR, CIN, HS, P, MIX, emit, ng_lo, ng_hi);
        else        rg_wave_body<PASS, true >(F, UB, Wg, CST + 768, blk, R0, u, 1, CAR, CIN, HS, P, MIX, emit, ng_lo, ng_hi);
    }
    lds_barrier(); tm_seg(F, PASS == 1 ? 15 : 11);
}

__device__ __forceinline__ void phase_attention(Frame& F0, int l) {
    Frame F = fresh(F0);
    const attn_body::bf16* Q = (const attn_body::bf16*)(F.ws + WS_QB); const attn_body::bf16* K = (const attn_body::bf16*)(F.ws + WS_KB); const attn_body::bf16* V = (const attn_body::bf16*)(F.ws + WS_VB);
    attn_body::bf16* O = (attn_body::bf16*)(F.ws + WS_MIX);
    char* shm = F.ldsg;
    for (int v = F.vcu; v < 256; v += F.G) { const int pair = v >> 4, qb = v & 15, b = pair >> 1, kvh = pair & 1;
        for (int g = 0; g < 4; ++g) { const int h = kvh * 4 + g;
            attn_body::attn_unit<8>((long)b * T + qb * 256, h * 64, (long)b * SKV, kvh * 64, SKV / 64, (long)b * T + qb * 256, 256 + h * 64, Q, K, V, O, shm, F.wave); } }
    if (l < DEPTH - 1) for (int v = F.vcu; v < 64; v += F.G) { const int b = v >> 3, h = v & 7;
        attn_body::attn_unit<8>((long)ML + b * LC, h * 64, (long)b * SKV + T, (h >> 2) * 64, LC / 64, (long)ML + b * LC, 256 + h * 64, Q, K, V, O, shm, F.wave); }
}
__device__ __forceinline__ bf16* hrow_ptr(const Frame& F, int R) { return (bf16*)(F.ws + WS_HB) + (size_t)R * D; }

__device__ __forceinline__ unsigned wave_max_u32(unsigned x) {
#define WMX_STEP(ctrl, rmask) { const unsigned y_ = (unsigned)__builtin_amdgcn_update_dpp((int)x, (int)x, ctrl, rmask, 0xF, false); x = x > y_ ? x : y_; }
    WMX_STEP(0x111, 0xF) WMX_STEP(0x112, 0xF) WMX_STEP(0x114, 0xF) WMX_STEP(0x118, 0xF) WMX_STEP(0x142, 0xA) WMX_STEP(0x143, 0xC)
#undef WMX_STEP
    return (unsigned)__builtin_amdgcn_readlane((int)x, 63);
}
__device__ __forceinline__ void phase_ln1(Frame& F0, const Args& A, int l, bool v_from_h) {
    Frame F = fresh(F0);
    const bool last = (l == DEPTH - 1); const int ngroups = (last ? ML : M) / 16;
    LAS bf16* MH = (LAS bf16*)F.lds;
    LAS bf16* MLo = (LAS bf16*)(F.lds + 33024);
    LAS float* PL = (LAS float*)(F.lds + 66048);
    LAS float* LOG = (LAS float*)(F.lds + 66048 + 32768);
    LAS int* lhist = (LAS int*)(F.lds + 66048 + 32768 + 4096);
    LAS unsigned* KEYS = (LAS unsigned*)(F.lds + 66048 + 32768 + 4096 + 256);
    const int lane = F.lane, wave = F.wave, fr = lane & 15, fq = lane >> 4;
    const float* lg = A.in[I_LN1G + F.z] + l * D; const float* lb = A.in[I_LN1B + F.z] + l * D; const float* brt = A.in[I_BR + F.z] + l * NEXP;
    const bf16* RH = (const bf16*)(F.ws + WS_RTHI) + (size_t)l * NEXP * D; const bf16* RL = (const bf16*)(F.ws + WS_RTLO) + (size_t)l * NEXP * D;
    int* IDX = (int*)(F.ws + WS_IDX); float* WT = (float*)(F.ws + WS_WT); bf16* ABUF = (bf16*)(F.ws + WS_ABUF);
    lds_barrier();
    if (F.tid < 64) lhist[F.tid] = 0;
    v2u nvb[2][4];
    const bf16* VB16 = v_from_h ? (const bf16*)(F.ws + WS_HB) : (const bf16*)(F.ws + WS_V);
#define LN1_PREFETCH(g_) do { _Pragma("unroll") for (int rr = 0; rr < 2; ++rr) { const int R_ = (g_) * 16 + 2 * wave + rr; \
        _Pragma("unroll") for (int j = 0; j < 4; ++j) nvb[rr][j] = __builtin_nontemporal_load((const v2u*)(VB16 + (size_t)R_ * D + 4 * lane + 256 * j)); } } while (0)
#define LN1_ROWPART(g_, gn_) do { \
        f32x4 cv[2][4]; _Pragma("unroll") for (int rr = 0; rr < 2; ++rr) _Pragma("unroll") for (int j = 0; j < 4; ++j) cv[rr][j] = (f32x4){bflo(nvb[rr][j].x), bfhi(nvb[rr][j].x), bflo(nvb[rr][j].y), bfhi(nvb[rr][j].y)}; \
        const int mr = modrow_of((g_) * 16); f32x4 sc2v[4], sh2v[4], gv[4], bv[4]; \
        { const float* sh2 = modv(F, l, mr, 3); const float* sc2 = modv(F, l, mr, 4); \
          _Pragma("unroll") for (int j = 0; j < 4; ++j) { sc2v[j] = *(const f32x4*)(sc2 + 4 * lane + 256 * j); sh2v[j] = *(const f32x4*)(sh2 + 4 * lane + 256 * j); gv[j] = *(const f32x4*)(lg + 4 * lane + 256 * j); bv[j] = *(const f32x4*)(lb + 4 * lane + 256 * j); } } \
        if ((gn_) < ngroups) LN1_PREFETCH(gn_); \
        const float vs = v_from_h ? DN_ALPHA : 1.0f; \
        _Pragma("unroll") for (int rr = 0; rr < 2; ++rr) { const int tok = 2 * wave + rr, R = (g_) * 16 + tok; bf16* hp = hrow_ptr(F, R); f32x4 v[4]; float s = 0.f; \
            _Pragma("unroll") for (int j = 0; j < 4; ++j) { v[j] = cv[rr][j] * vs; s += (v[j].x + v[j].y) + (v[j].z + v[j].w); } \
            const float mean = wave_sum(s) * (1.f / D); float s2 = 0.f; \
            _Pragma("unroll") for (int j = 0; j < 4; ++j) { v[j] = v[j] - mean; s2 += (v[j].x * v[j].x + v[j].y * v[j].y) + (v[j].z * v[j].z + v[j].w * v[j].w); } \
            const float rstd = 1.f / sqrtf(wave_sum(s2) * (1.f / D) + LN_EPS); \
            _Pragma("unroll") for (int j = 0; j < 4; ++j) { const f32x4 h = v[j] * rstd * gv[j] + bv[j]; { v2u hq_; hq_.x = pk2(h.x, h.y); hq_.y = pk2(h.z, h.w); *(v2u*)(hp + 4 * lane + 256 * j) = hq_; } \
                const f32x4 m = h * (sc2v[j] + 1.0f) + sh2v[j]; \
                v2u hi; hi.x = pk2(m.x, m.y); hi.y = pk2(m.z, m.w); \
                v2u lo; lo.x = pk2(m.x - bflo(hi.x), m.y - bfhi(hi.x)); lo.y = pk2(m.z - bflo(hi.y), m.w - bfhi(hi.y)); \
                *(unsigned*)((unsigned char*)ABUF + (size_t)R * D + 4 * lane + 256 * j) = pk4_fp8(m.x, m.y, m.z, m.w); \
                *(LAS v2u*)(MH + tok * 1032 + 4 * lane + 256 * j) = hi; *(LAS v2u*)(MLo + tok * 1032 + 4 * lane + 256 * j) = lo; } } } while (0)
    if (F.vcu < ngroups) { LN1_PREFETCH(F.vcu); LN1_ROWPART(F.vcu, F.vcu + F.G); }
    bf16x8 wh[4][4], wl[4][4];
    const unsigned wloff = (unsigned)(fr * D + fq * 8) * 2u;
    const char* rhb[4]; const char* rlb[4];
#pragma unroll
    for (int eg = 0; eg < 4; ++eg) { rhb[eg] = (const char*)(RH + wave * 128) + eg * 16 * D * 2; rlb[eg] = (const char*)(RL + wave * 128) + eg * 16 * D * 2; }
#define LN1_GLDK(KK) do { asm volatile("s_nop 4" ::: "memory"); _Pragma("unroll") for (int eg = 0; eg < 4; ++eg) { \
        asm volatile("global_load_dwordx4 %0, %1, %2 offset:%3" : "=v"(wh[KK][eg]) : "v"(wloff), "s"(rhb[eg]), "i"((KK) * 64) : "memory"); \
        asm volatile("global_load_dwordx4 %0, %1, %2 offset:%3" : "=v"(wl[KK][eg]) : "v"(wloff), "s"(rlb[eg]), "i"((KK) * 64) : "memory"); } } while (0)
#define LN1_WAITK(N, KK) asm volatile("s_waitcnt vmcnt(" #N ")" : "+v"(wh[KK][0]), "+v"(wh[KK][1]), "+v"(wh[KK][2]), "+v"(wh[KK][3]), "+v"(wl[KK][0]), "+v"(wl[KK][1]), "+v"(wl[KK][2]), "+v"(wl[KK][3]) :: "memory")
    LN1_GLDK(0); LN1_GLDK(1);
    int pend_r[2] = {-1, -1}; float pend_w[2] = {0.f, 0.f};
#define LN1_FLUSH(g_) do { _Pragma("unroll") for (int rr = 0; rr < 2; ++rr) { const int R_ = (g_) * 16 + 2 * wave + rr; if (pend_r[rr] >= 0) { IDX[(size_t)R_ * 8 + pend_r[rr]] = lane; WT[(size_t)R_ * 8 + pend_r[rr]] = pend_w[rr]; } } } while (0)
    const float brl = brt[lane];
    lds_barrier();
    for (int g = F.vcu; g < ngroups; g += F.G) {
        tm_seg(F, 21);
        {   LN1_GLDK(2); LN1_GLDK(3);
            f32x4 acc[4];
#pragma unroll
            for (int eg = 0; eg < 4; ++eg) acc[eg] = (f32x4){0.f, 0.f, 0.f, 0.f};
#define LN1_KSTEP(N, KK) do { const int k0 = wave * 128 + (KK) * 32 + fq * 8; \
                const bf16x8 ah = *(const LAS bf16x8*)(MH + fr * 1032 + k0), al = *(const LAS bf16x8*)(MLo + fr * 1032 + k0); \
                LN1_WAITK(N, KK); \
                _Pragma("unroll") for (int eg = 0; eg < 4; ++eg) { \
                    acc[eg] = __builtin_amdgcn_mfma_f32_16x16x32_bf16(wh[KK][eg], ah, acc[eg], 0, 0, 0); \
                    acc[eg] = __builtin_amdgcn_mfma_f32_16x16x32_bf16(wl[KK][eg], ah, acc[eg], 0, 0, 0); \
                    acc[eg] = __builtin_amdgcn_mfma_f32_16x16x32_bf16(wh[KK][eg], al, acc[eg], 0, 0, 0); } } while (0)
            LN1_KSTEP(24, 0); LN1_KSTEP(16, 1); LN1_KSTEP(8, 2); LN1_KSTEP(0, 3);
#undef LN1_KSTEP
#pragma unroll
            for (int eg = 0; eg < 4; ++eg) *(LAS f32x4*)(PL + (wave * 16 + fr) * 64 + eg * 16 + fq * 4) = acc[eg]; }
        lds_barrier(); tm_seg(F, 20);
        if (g + F.G < ngroups) LN1_ROWPART(g + F.G, g + 2 * F.G);
        tm_seg(F, 22);
        { const int o = F.tid * 2; float s0 = 0.f, s1 = 0.f;
#pragma unroll
            for (int w = 0; w < 8; ++w) { const f32x2v p = *(const LAS f32x2v*)(PL + w * 1024 + o); s0 += p.x; s1 += p.y; }
            *(LAS f32x2v*)(LOG + o) = (f32x2v){s0, s1}; }
        if (g != F.vcu) LN1_FLUSH(g - F.G);
        lds_barrier(); tm_seg(F, 23);
        if (g + F.G < ngroups) { LN1_GLDK(0); LN1_GLDK(1); }
        {
            float score[2]; unsigned key[2]; int rank[2] = {0, 0};
#pragma unroll
            for (int rr = 0; rr < 2; ++rr) { score[rr] = __builtin_amdgcn_rcpf(1.0f + __expf(-LOG[(2 * wave + rr) * 64 + lane]));
                key[rr] = (__float_as_uint(score[rr] + brl + 2.0f) & ~63u) | (unsigned)(63 - lane);
                KEYS[(2 * wave + rr) * 64 + lane] = key[rr]; }
#pragma unroll
            for (int i = 0; i < 16; ++i) {
#pragma unroll
                for (int rr = 0; rr < 2; ++rr) { const v4u kq = *(const LAS v4u*)(KEYS + (2 * wave + rr) * 64 + 4 * i);
                    rank[rr] += (int)(kq.x > key[rr]) + (int)(kq.y > key[rr]) + (int)(kq.z > key[rr]) + (int)(kq.w > key[rr]); } }
#pragma unroll
            for (int rr = 0; rr < 2; ++rr) { const bool sel = rank[rr] < 8; const float ssum = wave_sum(sel ? score[rr] : 0.f);
                pend_r[rr] = sel ? rank[rr] : -1; pend_w[rr] = score[rr] / ssum * ROUTED_SCALE; if (sel) atomicAdd((int*)&lhist[lane], 1); }
        }
    }
    { const int mygroups = (ngroups - F.vcu + F.G - 1) / F.G; if (mygroups > 0) LN1_FLUSH(F.vcu + (mygroups - 1) * F.G); }
#undef LN1_ROWPART
#undef LN1_GLDK
#undef LN1_WAITK
#undef LN1_FLUSH
#undef LN1_PREFETCH
    lds_barrier(); tm_seg(F, 6  );
    if (F.tid < 64) ((int*)(F.ws + WS_HIST))[F.vcu * 64 + F.tid] = lhist[F.tid];
}

__device__ __forceinline__ void phase_sort(Frame& F0, int l) {
    Frame F = fresh(F0);
    const bool last = (l == DEPTH - 1); const int ngroups = (last ? ML : M) / 16;
    LAS int* pa = (LAS int*)F.lds;
    LAS int* pb = pa + 512;
    LAS int* tot = pb + 512;
    LAS int* mybase = tot + 64;
    LAS int* segbase = mybase + 64;
    LAS int* tpre = segbase + 80;
    LAS int* lcnt = tpre + 80;
    const int* HIST = (const int*)(F.ws + WS_HIST);
    lds_barrier();
    { const int e = F.tid & 63, part = F.tid >> 6; int sa = 0, sb = 0;
        for (int w = part * 32; w < part * 32 + 32; ++w) if (w < F.G) { const int h = HIST[w * 64 + e]; sa += h; if (w < F.vcu) sb += h; }
        pa[part * 64 + e] = sa; pb[part * 64 + e] = sb; }
    lds_barrier();
    if (F.tid < 64) { int sa = 0, sb = 0;
#pragma unroll
        for (int p = 0; p < 8; ++p) { sa += pa[p * 64 + F.tid]; sb += pb[p * 64 + F.tid]; }
        tot[F.tid] = sa; mybase[F.tid] = sb; lcnt[F.tid] = 0; }
    lds_barrier();
    if (F.tid == 0) { int s = 0, tp = 0; for (int e = 0; e < 64; ++e) { segbase[e] = s; tpre[e] = tp; const int nt = (tot[e] + 255) >> 8; s += nt * 256; tp += nt; }
        segbase[64] = s; tpre[64] = tp; tpre[65] = tp + (last ? ML : M) / 256; }
    lds_barrier();
    const int* IDX = (const int*)(F.ws + WS_IDX); const float* WT = (const float*)(F.ws + WS_WT);
    int* POS = (int*)(F.ws + WS_POS); int* STOK = (int*)(F.ws + WS_STOK); float* SWT = (float*)(F.ws + WS_SWT);
    const int mygroups = (ngroups - F.vcu + F.G - 1) / F.G;
    for (int idx = F.tid; idx < mygroups * 128; idx += 512) { const int gi = idx >> 7, w = idx & 127; const int R = (F.vcu + F.G * gi) * 16 + (w >> 3), k = w & 7;
        const int e = IDX[(size_t)R * 8 + k]; const int rank = atomicAdd((int*)&lcnt[e], 1); const int pos = segbase[e] + mybase[e] + rank;
        POS[(size_t)R * 8 + k] = pos; STOK[pos] = R; SWT[pos] = WT[(size_t)R * 8 + k]; }
    for (int e = (F.G >= 64 ? F.vcu - (F.G - 64) : F.vcu); e < 64; e += F.G) { if (e < 0) continue; const int lo = segbase[e] + tot[e], hi = segbase[e + 1];        for (int p = lo + F.tid; p < hi; p += 512) { STOK[p] = 0; SWT[p] = 0.f; } }
    if (F.vcu == F.G - 1) { unsigned* TL = (unsigned*)(F.ws + WS_TILES); const int ntot = tpre[65];
        for (int i = F.tid; i < ntot; i += 512) { int e = 0; while (e < 64 && i >= tpre[e + 1]) ++e;
            TL[i] = ((unsigned)e << 16) | (unsigned)(e < 64 ? (segbase[e] >> 8) + (i - tpre[e]) : (SH0 >> 8) + (i - tpre[64])); }
        if (F.tid == 0) TL[1536] = (unsigned)ntot; }
    lds_barrier();
}

__device__ __forceinline__ int load_tiles(Frame& F0) {
    Frame F = fresh(F0);
    const unsigned* TL = (const unsigned*)(F.ws + WS_TILES); LAS unsigned* LT = (LAS unsigned*)(F.lds + LTILES_OFF);
    lds_barrier();
    const int ntot = (int)__hip_atomic_load(TL + 1536, RLX_AGENT);
    for (int i = F.tid; i < ntot && i < 1536; i += 512) LT[i] = TL[i];
    lds_barrier();
    return __builtin_amdgcn_readfirstlane(ntot);
}

__device__ __forceinline__ void add_f8x16(f32x4 (&f)[4], const v4u w) {
    typedef float f2 __attribute__((ext_vector_type(2)));
    const unsigned ww[4] = {w.x, w.y, w.z, w.w};
#pragma unroll
    for (int i = 0; i < 4; ++i) { const f2 lo = __builtin_amdgcn_cvt_pk_f32_fp8((int)ww[i], false), hi = __builtin_amdgcn_cvt_pk_f32_fp8((int)ww[i], true); f[i] += (f32x4){lo.x, lo.y, hi.x, hi.y}; }
}
__device__ __forceinline__ void phase_ln2(Frame& F0, const Args& A, int l, bool have_moe) {
    Frame F = fresh(F0);
    const bool last = (l == DEPTH - 1); const int nrows = last ? ML : M;
    const int gw = F.vcu * NWAVES + F.wave, NGW = F.G * NWAVES, lane = F.lane;
    const float* lg = A.in[I_LN2G + F.z] + l * D; const float* lb = A.in[I_LN2B + F.z] + l * D;
    const unsigned char* Y2 = (const unsigned char*)(F.ws + WS_Y2); const unsigned char* SHY = (const unsigned char*)(F.ws + WS_SHY); unsigned char* AB8 = (unsigned char*)(F.ws + WS_ABUF); bf16* ABUF = (bf16*)(F.ws + WS_ABUF); const int* POS = (const int*)(F.ws + WS_POS);
    const unsigned c0 = 16u * (unsigned)lane;
    LAS float* MV = (LAS float*)F.lds; LAS float* LG = MV + 27 * 1024; LAS float* LB = LG + 1024;
    lds_barrier();
    for (int i = F.tid; i < 27 * 256; i += 512) { const int r = i / 768, k = (i / 256) % 3, c = (i & 255) * 4;
        const f32x4 v = (k == 0) ? *(const f32x4*)(modv(F, l, r, 5) + c) : (last ? (f32x4){0.f, 0.f, 0.f, 0.f} : *(const f32x4*)(modv(F, l + 1, r, k == 1 ? 1 : 0) + c));
        *(LAS f32x4*)(MV + (r * 3 + k) * 1024 + c) = v; }
    for (int i = F.tid; i < 256; i += 512) { *(LAS f32x4*)(LG + i * 4) = *(const f32x4*)(lg + i * 4); *(LAS f32x4*)(LB + i * 4) = *(const f32x4*)(lb + i * 4); }
    lds_barrier();
    const bool tailmode = (nrows == M) && (NGW * 16 == ML) && (M - ML == NGW);
    const int nk = tailmode ? 9 : ((nrows - 2 * gw + 2 * NGW - 1) / (2 * NGW));
#define LN2_ROWS(k_, r0_, r1_) do { if (tailmode && (k_) == 8) { r0_ = ML + gw; r1_ = -1; } else { r0_ = 2 * gw + (k_) * 2 * NGW; r1_ = r0_ + 1; } } while (0)
    int pkn[2] = {0, 0}; int rn0 = 0, rn1 = -1;
    if (nk > 0) { LN2_ROWS(0, rn0, rn1); if (have_moe && lane < 8) { pkn[0] = POS[rn0 * 8 + lane]; if (rn1 >= 0) pkn[1] = POS[rn1 * 8 + lane]; } }
    for (int kr = 0; kr < nk; ++kr) {
        const int Rr[2] = {rn0, rn1}; const int nq = rn1 >= 0 ? 2 : 1;
        int pk[2] = {pkn[0], pkn[1]};
        if (kr + 1 < nk) { LN2_ROWS(kr + 1, rn0, rn1); if (have_moe && lane < 8) { pkn[0] = POS[rn0 * 8 + lane]; if (rn1 >= 0) pkn[1] = POS[rn1 * 8 + lane]; } }
        v4u w[2][9]; v4u hb[2][2];
#pragma unroll
        for (int q = 0; q < 2; ++q) { if (q >= nq) continue; const bf16* hp = hrow_ptr(F, Rr[q]);
#pragma unroll
            for (int j = 0; j < 2; ++j) hb[q][j] = *(const v4u*)(hp + c0 + 8 * j);
            if (have_moe) { w[q][8] = __builtin_nontemporal_load((const v4u*)(SHY + (size_t)Rr[q] * D + c0));
#pragma unroll
                for (int k = 0; k < 8; ++k) { const int p = __builtin_amdgcn_readlane(pk[q], k); w[q][k] = __builtin_nontemporal_load((const v4u*)(Y2 + (size_t)p * D + c0)); } } }
#pragma unroll
        for (int q = 0; q < 2; ++q) { if (q >= nq) continue; const int Rq = Rr[q]; const int mr = modrow_of(Rq); bf16* hp = hrow_ptr(F, Rq); const LAS float* mv = MV + mr * 3 * 1024;
            const f32x4 hv4[4] = {(f32x4){bflo(hb[q][0].x), bfhi(hb[q][0].x), bflo(hb[q][0].y), bfhi(hb[q][0].y)}, (f32x4){bflo(hb[q][0].z), bfhi(hb[q][0].z), bflo(hb[q][0].w), bfhi(hb[q][0].w)},
                                  (f32x4){bflo(hb[q][1].x), bfhi(hb[q][1].x), bflo(hb[q][1].y), bfhi(hb[q][1].y)}, (f32x4){bflo(hb[q][1].z), bfhi(hb[q][1].z), bflo(hb[q][1].w), bfhi(hb[q][1].w)}};
            f32x4 f[4];
#pragma unroll
            for (int j = 0; j < 4; ++j) f[j] = (f32x4){0.f, 0.f, 0.f, 0.f};
            if (have_moe) {
#pragma unroll
                for (int k = 0; k < 9; ++k) add_f8x16(f, w[q][k]); }
            f32x4 v[4]; float s = 0.f;
#pragma unroll
            for (int j = 0; j < 4; ++j) { const unsigned col = c0 + 4 * j; v[j] = hv4[j] * DN_ALPHA + *(const LAS f32x4*)(mv + col) * (f[j] * (1.0f / 16.0f)); s += (v[j].x + v[j].y) + (v[j].z + v[j].w); }
            const float mean = wave_sum(s) * (1.f / D); float s2 = 0.f;
#pragma unroll
            for (int j = 0; j < 4; ++j) { v[j] = v[j] - mean; s2 += (v[j].x * v[j].x + v[j].y * v[j].y) + (v[j].z * v[j].z + v[j].w * v[j].w); }
            const float rstd = 1.f / sqrtf(wave_sum(s2) * (1.f / D) + LN_EPS);
            f32x4 a[4], hh4[4];
#pragma unroll
            for (int j = 0; j < 4; ++j) { const unsigned col = c0 + 4 * j; const f32x4 h = v[j] * rstd * *(const LAS f32x4*)(LG + col) + *(const LAS f32x4*)(LB + col); hh4[j] = h;
                if (last) *(f32x4*)(F.out + (size_t)Rq * D + col) = h;
                else a[j] = h * (*(const LAS f32x4*)(mv + 1024 + col) + 1.0f) + *(const LAS f32x4*)(mv + 2048 + col); }
            if (!last) {
#pragma unroll
                for (int hh = 0; hh < 2; ++hh) { v4u o; o.x = pk2(hh4[2 * hh].x, hh4[2 * hh].y); o.y = pk2(hh4[2 * hh].z, hh4[2 * hh].w); o.z = pk2(hh4[2 * hh + 1].x, hh4[2 * hh + 1].y); o.w = pk2(hh4[2 * hh + 1].z, hh4[2 * hh + 1].w);
                    *(v4u*)(hp + c0 + 8 * hh) = o; } }
            if (!last) {
#pragma unroll
                for (int hh = 0; hh < 2; ++hh) { v4u o; o.x = pk2(a[2 * hh].x, a[2 * hh].y); o.y = pk2(a[2 * hh].z, a[2 * hh].w); o.z = pk2(a[2 * hh + 1].x, a[2 * hh + 1].y); o.w = pk2(a[2 * hh + 1].z, a[2 * hh + 1].w);
                    *(v4u*)(ABUF + (size_t)Rq * D + c0 + 8 * hh) = o; } }
        }
    }
}
#ifndef MK_MIXER
#define MK_MIXER 7
#endif
#ifndef MK_MOE
#define MK_MOE 1
#endif
#ifndef MK_PHASES
#define MK_PHASES 0xFFFFFFFFu
#endif
#define PH(n) ((MK_PHASES >> (n)) & 1u)
#ifndef MK_TMULT
#define MK_TMULT 1
#endif
enum { SG_PRO = 0, SG_PROB = 1, SG_INPROJ = 2, SG_POST1 = 3, SG_POST2 = 4, SG_OUTPROJ = 5, SG_LN1 = 6, SG_SORT = 7, SG_GU = 8, SG_DOWN = 9, SG_LN2 = 10 };
#ifndef MK_REP
#define MK_REP 0u
#endif
#define REP(n) ((MK_REP >> (n)) & 1u)
__device__ __forceinline__ void zero_mix_cols(Frame& F, int c0, int ncols) {
    bf16* MIX = (bf16*)(F.ws + WS_MIX); const int per = ncols / 8; const size_t tot = (size_t)M * per;
    for (size_t i = (size_t)F.vcu * 512 + F.tid; i < tot; i += (size_t)F.G * 512) { const size_t R = i / per; const int c = (int)(i % per) * 8; *(v4u*)(MIX + R * 1024 + c0 + c) = (v4u){0u, 0u, 0u, 0u}; }
}
__global__ void __launch_bounds__(NWAVES * 64, 2) mk_fwd(Args args) {
    extern __shared__ __attribute__((aligned(16))) unsigned char lds[];
    Frame F;
    F.lds = (LAS unsigned char*)lds; F.ldsg = (char*)lds;
    F.MISC = (volatile LAS unsigned*)(F.lds + MISC_OFF);
    F.tid = threadIdx.x; F.lane = F.tid & 63; F.wave = __builtin_amdgcn_readfirstlane(F.tid >> 6);
    F.G = gridDim.x; { const int bx = blockIdx.x; F.vcu = (F.G % 8 == 0) ? (bx % 8) * (F.G / 8) + bx / 8 : bx; }
    F.ws = args.ws; F.out = args.out; F.ctl = (gu32*)(args.ws + WS_CTL); F.z = 0;
    for (int u = F.tid; u < (LDS_BYTES - LDSCTL_OFF) / 4; u += NWAVES * 64) ((LAS unsigned*)(F.lds + LDSCTL_OFF))[u] = 0u;
    __syncthreads();
    XcdBarrier bar = xcd_barrier_post((unsigned*)(F.ctl + CW_BAR), F.MISC + 8);
    if (MK_TMASK && threadIdx.x == 0) { tm_set(F, __builtin_amdgcn_s_memrealtime(), 0ull, SG_PRO); }
#define TSEG(id) tm_seg(F, (id))
#define GRID_BAR(next) do { xcd_barrier(bar, F.wave == 0 && lane_id() == 0); TSEG(next); } while (0)
    const Args& A = args;
    if (PH(0)) phase_prologue_a(F, A);
    { Frame Fk = fresh(F); float* SWT = (float*)(Fk.ws + WS_SWT); for (int i = Fk.vcu * 512 + Fk.tid; i < M; i += Fk.G * 512) SWT[SH0 + i] = 1.0f; }
    GRID_BAR(SG_PROB);
    if (MK_MIXER && PH(1)) phase_prologue_b(F, A);
    for (int l = 0; l < DEPTH; ++l) {
        const bool last = (l == DEPTH - 1);
        if (l > 0 || MK_MIXER) GRID_BAR(MK_MIXER ? SG_INPROJ : SG_LN1);
        if (MK_MIXER) {
            {   Frame Fk = fresh(F); Frame& F = Fk;
                pg8::Gemm g{(const pg8::bf16_t*)(F.ws + WS_ABUF), (const pg8::bf16_t*)(F.ws + WS_WIN) + (size_t)l * PROJ * D, M, PROJ, D, 0};
                pg8::StaticOrder S; S.init(M, PROJ, F.G, (int)blockIdx.x);
                pg8::EpiBf16 E{(pg8::bf16_t*)(F.ws + WS_P), PROJ, nullptr, 1 << 30, 0, false};
                if (PH(2)) { pg8::gemm_phase<pg8::EpiBf16, pg8::StaticOrder, true, false, 1024>(F.lds + RING_OFF, g, S, E, F.wave); if (REP(2)) { pg8::gemm_phase<pg8::EpiBf16, pg8::StaticOrder, true, false, 1024>(F.lds + RING_OFF, g, S, E, F.wave); } }
                TSEG(16);
                if (PH(3)) { phase_prep(F, A, l, MK_MOE != 0, (MK_MIXER & 2) != 0, 1); }
            }
            GRID_BAR(SG_POST1);
            if ((MK_MIXER & 1) && PH(4)) { phase_qkv_rows(F, A, l); if (REP(4)) { phase_qkv_rows(F, A, l); } }
            TSEG(13);
            if (MK_MIXER & 2) { if (PH(5)) { phase_hy_short(F, A, l); if (REP(5)) phase_hy_short(F, A, l); } TSEG(14); if (PH(6)) { phase_spectra(F, l); if (REP(6)) phase_spectra(F, l); } }
            TSEG(15);
            if ((MK_MIXER & 4) && PH(7)) { phase_rg<1>(F, A, l); if (REP(7)) { phase_rg<1>(F, A, l); } }
            GRID_BAR(SG_POST2);
            if (MK_MIXER & 4) { if (PH(8)) phase_rg<2>(F, A, l); } else zero_mix_cols(F, 768, 256);
            TSEG(11);
            if (MK_MIXER & 2) { if (PH(9)) phase_hyconv(F, A, l); } else zero_mix_cols(F, 0, 256);
            TSEG(12);
            if (MK_MIXER & 1) { lds_barrier(); if (PH(10)) { phase_attention(F, l); if (REP(10)) phase_attention(F, l); } } else zero_mix_cols(F, 256, 512);
            GRID_BAR(SG_OUTPROJ);
            {   Frame Fk = fresh(F); Frame& F = Fk;
                pg8::Gemm g{(const pg8::bf16_t*)(F.ws + WS_MIX), (const pg8::bf16_t*)(F.ws + WS_WOUT) + (size_t)l * D * D, M, D, D, 0};
                pg8::StaticOrder S; S.init(last ? ML : M, D, F.G, (int)blockIdx.x);
                pg8::EpiResid E{(const pg8::bf16_t*)(F.ws + WS_HB), (pg8::bf16_t*)(F.ws + WS_V), modv(F, l, 0, 2), 6144, ML / 256, DN_ALPHA};
                if (PH(11)) pg8::gemm_phase<pg8::EpiResid, pg8::StaticOrder, true, false, 1024>(F.lds + RING_OFF, g, S, E, F.wave);
                if (MK_MOE) { lds_barrier(); if (PH(3)) phase_prep(F, A, l, true, false, 3); }
            }
            GRID_BAR(SG_LN1);
        } else if (MK_MOE) {
            if (PH(3)) { phase_prep(F, A, l, true, false); if (REP(3)) { phase_prep(F, A, l, true, false); } }
        }
        {   const bool prep_first = MK_MIXER && MK_MOE && ((((int)blockIdx.x >> 3) & 1) != 0);
            if (prep_first) { if (PH(3)) phase_prep(F, A, l, true, false, 4); lds_barrier(); }
            if (PH(12)) phase_ln1(F, A, l, MK_MIXER == 0);
            if (MK_MIXER && MK_MOE && !prep_first) { lds_barrier(); if (PH(3)) phase_prep(F, A, l, true, false, 4); }
        }
        GRID_BAR(MK_MOE ? SG_SORT : SG_LN2);
        if (MK_MOE) {
            if (PH(13)) { phase_sort(F, l); if (REP(13)) { phase_sort(F, l); } }
            GRID_BAR(SG_GU);
            {   const int ntiles = load_tiles(F); Frame Fk = fresh(F); Frame& F = Fk;
                pg8::Gemm g{(const pg8::bf16_t*)(F.ws + WS_ABUF), (const pg8::bf16_t*)(F.ws + WS_WGU), M, 512, D, (size_t)512 * D};
                pg8::MoeOrder S{(const LAS unsigned*)(F.lds + LTILES_OFF), ntiles, 2, F.G, F.vcu, (const int*)(F.ws + WS_STOK), SH0 / 256, (const LAS int*)(F.lds + RING_BYTES)};
                {
                    LAS int* LT = (LAS int*)(F.lds + RING_BYTES); pg8::Unit uu;
#pragma unroll 1
                    for (int i = 0; i < 24 && S.next(i, uu); ++i) if (F.tid < 256) LT[i * 256 + F.tid] = S.arow_g(uu, F.tid);
                    lds_barrier(); }
                pg8::EpiGU E{(unsigned char*)(F.ws + WS_HID), (const float*)(F.ws + WS_SWT)};
                if (PH(14)) { pg8::gemm_phase<pg8::EpiGU, pg8::MoeOrder, true, true, 1024, true>(F.lds + RING_OFF, g, S, E, F.wave); if (REP(14)) { pg8::gemm_phase<pg8::EpiGU, pg8::MoeOrder, true, true, 1024, true>(F.lds + RING_OFF, g, S, E, F.wave); } }
            }
            if (F.wave == 0) { __builtin_amdgcn_fence(__ATOMIC_ACQUIRE, "agent"); asm volatile("s_waitcnt vmcnt(0)" ::: "memory"); }
            __syncthreads(); TSEG(SG_DOWN);
            {   const int ntiles = load_tiles(F); Frame Fk = fresh(F); Frame& F = Fk;
                pg8::Gemm g{(const pg8::bf16_t*)(F.ws + WS_HID), (const pg8::bf16_t*)(F.ws + WS_WDN), HIDROWS, D, FF, (size_t)D * FF};
                pg8::MoeOrder S{(const LAS unsigned*)(F.lds + LTILES_OFF), ntiles, 4, F.G, F.vcu, (const int*)(F.ws + WS_STOK), SH0 / 256, nullptr};
                pg8::EpiF8 E{(unsigned char*)(F.ws + WS_Y2), D, (unsigned char*)(F.ws + WS_SHY), D, SH0 / 256, SH0 / 256, 16.0f};
                if (PH(15)) { pg8::gemm_phase<pg8::EpiF8, pg8::MoeOrder, false, false, 256, true, (MK_TMASK != 0)>(F.lds + RING_OFF, g, S, E, F.wave, F.MISC, SG_DOWN); if (REP(15)) { pg8::gemm_phase<pg8::EpiF8, pg8::MoeOrder, false, false, 256, true, (MK_TMASK != 0)>(F.lds + RING_OFF, g, S, E, F.wave, F.MISC, SG_DOWN); } }
            }
            GRID_BAR(SG_LN2);
        }
        if (PH(16)) phase_ln2(F, A, l, MK_MOE != 0);
    }
    if (MK_TMASK) {
        xcd_barrier(bar, F.wave == 0 && lane_id() == 0); TSEG(SG_PRO);
        if (blockIdx.x == 0 && F.wave == 0 && lane_id() == 0) { const unsigned long long t_acc = tm_acc(F); const unsigned long long t0 = __builtin_amdgcn_s_memrealtime(); while (__builtin_amdgcn_s_memrealtime() - t0 < t_acc * MK_TMULT) __builtin_amdgcn_s_sleep(32); }
    }
}

extern "C" void kernel_launch(void* const* d_in, const int* in_sizes, int n_in, void* d_out, int out_size, void* d_ws, size_t ws_size, hipStream_t stream) {
    static int grid = 0;
    if (grid == 0) {
        if (n_in != N_IN || in_sizes[0] != ML * D || out_size != ML * D || ws_size < WS_END) { fprintf(stderr, "kernel_launch: unexpected shapes (n_in %d in0 %d out %d ws %zu need %zu); nothing launched\n", n_in, n_in > 0 ? in_sizes[0] : -1, out_size, ws_size, (size_t)WS_END); grid = -1; return; }
        int dev = 0, cus = 0, per_cu = 0;
        if (hipGetDevice(&dev) != hipSuccess || hipDeviceGetAttribute(&cus, hipDeviceAttributeMultiprocessorCount, dev) != hipSuccess) { grid = -1; return; }
        if (hipFuncSetAttribute((const void*)mk_fwd, hipFuncAttributeMaxDynamicSharedMemorySize, LDS_BYTES) != hipSuccess) { fprintf(stderr, "kernel_launch: hipFuncSetAttribute failed\n"); grid = -1; return; }
        if (hipOccupancyMaxActiveBlocksPerMultiprocessor(&per_cu, (const void*)mk_fwd, NWAVES * 64, LDS_BYTES) != hipSuccess || per_cu < 1) { fprintf(stderr, "kernel_launch: occupancy query reports %d\n", per_cu); }
        (void)hipGetLastError();
        grid = cus;
    }
    if (grid < 0) return;
    if (hipMemsetAsync((char*)d_ws + WS_CTL, 0, CTL_ZERO_BYTES, stream) != hipSuccess) return;
    Args a{};
    for (int i = 0; i < N_IN; ++i) a.in[i] = (const float*)d_in[i];
    a.out = (float*)d_out; a.ws = (unsigned char*)d_ws;
    hipLaunchKernelGGL(mk_fwd, dim3(grid), dim3(NWAVES * 64), LDS_BYTES, stream, a);
}
```
